# Optimizing an MI355X kernel written in HIP

```python
import jax
import jax.numpy as jnp
from jax import lax
import numpy as np

D_MODEL = 1024
BATCH = 2
SEQ = 8192
DEPTH = 1

GRID_W = 64
CTX_LEN = 256
RET_HEADS = 4
RET_DK = 128
RET_DV = 128
RET_CHUNK = 128
GLA_HEADS = 4
GLA_DK = 64
GLA_DV = 128
GLA_RANK = 16
GLA_TAU = 16.0
GLA_CHUNK = 64
RET_WIDTH = RET_HEADS * RET_DV
GLA_WIDTH = GLA_HEADS * GLA_DV
D_MIX = RET_WIDTH + GLA_WIDTH
D_FF = 2816
N_MOD = 9
ROPE_BASE = 10000.0
EPS = 1e-6
IN_WIDTHS = (RET_HEADS * RET_DK, RET_HEADS * RET_DK, RET_WIDTH, RET_WIDTH,
             GLA_HEADS * GLA_DK, GLA_HEADS * GLA_DK, GLA_WIDTH, GLA_WIDTH, GLA_RANK, GLA_RANK)
IN_COLS = sum(IN_WIDTHS)
IN_SPLITS = tuple(int(v) for v in np.cumsum(IN_WIDTHS)[:-1])

kernel_name = "hybrid_retention_gla_macaron_dit"


def rms_norm(x, w):
    xf = x.astype(jnp.float32)
    y = xf * lax.rsqrt(jnp.mean(xf * xf, axis=-1, keepdims=True) + EPS)
    return (y * w.astype(jnp.float32)).astype(x.dtype)


def modulate(h, shift, scale):
    return h * (1.0 + scale[:, None, :]) + shift[:, None, :]


def swiglu(h, w1, w3, w2):
    return (jax.nn.silu(h @ w1) * (h @ w3)) @ w2


def split_heads(t, n_heads):
    b, n, _ = t.shape
    return t.reshape(b, n, n_heads, -1).transpose(0, 2, 1, 3).astype(jnp.float32)


def merge_heads(t):
    b, h, n, d = t.shape
    return t.transpose(0, 2, 1, 3).reshape(b, n, h * d)


def rotate(x, ang):
    x1, x2 = jnp.split(x, 2, axis=-1)
    cos, sin = jnp.cos(ang), jnp.sin(ang)
    return jnp.concatenate([x1 * cos - x2 * sin, x1 * sin + x2 * cos], axis=-1)


def grid_rope(x, n_tok):
    rows = n_tok // GRID_W
    row = jnp.repeat(jnp.arange(rows, dtype=jnp.float32), GRID_W)
    col = jnp.tile(jnp.arange(GRID_W, dtype=jnp.float32), rows)
    n_freq = x.shape[-1] // 4
    freqs = ROPE_BASE ** (-jnp.arange(n_freq, dtype=jnp.float32) / n_freq)
    xr, xc = jnp.split(x, 2, axis=-1)
    return jnp.concatenate([rotate(xr, row[:, None] * freqs), rotate(xc, col[:, None] * freqs)], axis=-1)


def to_chunks(t, c):
    b, h, n, d = t.shape
    return t.reshape(b, h, n // c, c, d).transpose(2, 0, 1, 3, 4)


def from_chunks(t):
    nc, b, h, c, d = t.shape
    return t.transpose(1, 2, 0, 3, 4).reshape(b, h, nc * c, d)


def retention_chunked(q, k, v, s0, log_gamma):
    c = RET_CHUNK
    pos = jnp.arange(c, dtype=jnp.float32)
    diff = pos[:, None] - pos[None, :]
    lg = log_gamma[:, None, None]
    decay = jnp.exp(jnp.where(diff >= 0, diff * lg, -jnp.inf))
    q_dec = jnp.exp((pos + 1.0) * log_gamma[:, None])[..., None]
    k_dec = jnp.exp((c - 1.0 - pos) * log_gamma[:, None])[..., None]
    chunk_dec = jnp.exp(c * log_gamma)[:, None, None]

    def step(s, xs):
        qc, kc, vc = xs
        scores = jnp.einsum('bhid,bhjd->bhij', qc, kc) * decay
        o = jnp.einsum('bhij,bhje->bhie', scores, vc) + jnp.einsum('bhid,bhde->bhie', qc * q_dec, s)
        s = chunk_dec * s + jnp.einsum('bhjd,bhje->bhde', kc * k_dec, vc)
        return s, o

    s_fin, o = lax.scan(step, s0, (to_chunks(q, c), to_chunks(k, c), to_chunks(v, c)))
    return from_chunks(o), s_fin


def gla_chunked(q, k, v, g, s0):
    c = GLA_CHUNK
    tri = jnp.tril(jnp.ones((c, c), dtype=bool))

    def step(s, xs):
        qc, kc, vc, gc = xs
        b = jnp.cumsum(gc, axis=-2)
        rel = b[:, :, :, None, :] - b[:, :, None, :, :]
        rel = jnp.exp(jnp.where(tri[:, :, None], rel, -jnp.inf))
        scores = jnp.einsum('bhid,bhjd,bhijd->bhij', qc, kc, rel)
        o = jnp.einsum('bhij,bhje->bhie', scores, vc) + jnp.einsum('bhid,bhde->bhie', qc * jnp.exp(b), s)
        b_last = b[:, :, -1:, :]
        s = jnp.exp(b_last[:, :, 0, :])[..., None] * s + jnp.einsum('bhjd,bhje->bhde', kc * jnp.exp(b_last - b), vc)
        return s, o

    s_fin, o = lax.scan(step, s0, (to_chunks(q, c), to_chunks(k, c), to_chunks(v, c), to_chunks(g, c)))
    return from_chunks(o), s_fin


def bidir_prefix(scan_f, scan_b, lat_f, lat_b, ctx_f, ctx_b):
    flip = lambda ts: tuple(t[:, :, ::-1] for t in ts)
    q0, v0 = ctx_f[0], ctx_f[2]
    s0 = jnp.zeros(q0.shape[:2] + (q0.shape[-1], v0.shape[-1]), jnp.float32)
    o_cf, s_f = scan_f(*ctx_f, s0)
    o_cb, s_b = scan_b(*flip(ctx_b), s0)
    o_lf, _ = scan_f(*lat_f, s_f)
    o_lb, _ = scan_b(*flip(lat_b), s_b)
    return o_lf + o_lb[:, :, ::-1], o_cf + o_cb[:, :, ::-1]


def retention_inputs(p, n_tok):
    q = split_heads(p[0], RET_HEADS) * (RET_DK ** -0.5)
    k = split_heads(p[1], RET_HEADS)
    if n_tok is not None:
        q, k = grid_rope(q, n_tok), grid_rope(k, n_tok)
    return (q, k, split_heads(p[2], RET_HEADS))


def gla_inputs(p, w_f, b_f, w_b, b_b):
    q = split_heads(p[4], GLA_HEADS) * (GLA_DK ** -0.5)
    k = split_heads(p[5], GLA_HEADS)
    v = split_heads(p[6], GLA_HEADS)
    g_f = split_heads(jax.nn.log_sigmoid((p[8] @ w_f + b_f).astype(jnp.float32)), GLA_HEADS) / GLA_TAU
    g_b = split_heads(jax.nn.log_sigmoid((p[9] @ w_b + b_b).astype(jnp.float32)), GLA_HEADS) / GLA_TAU
    return (q, k, v, g_f), (q, k, v, g_b)


def merge_outputs(o_ret, o_gla, p, ret_norm_w, gla_norm_w, w_out, dtype):
    mu = jnp.mean(o_ret, axis=-1, keepdims=True)
    var = jnp.mean(jnp.square(o_ret - mu), axis=-1, keepdims=True)
    r = merge_heads((o_ret - mu) * lax.rsqrt(var + EPS)) * ret_norm_w * jax.nn.silu(p[3].astype(jnp.float32))
    gl = merge_heads(o_gla * lax.rsqrt(jnp.mean(o_gla * o_gla, axis=-1, keepdims=True) + EPS))
    gl = gl * gla_norm_w * jax.nn.silu(p[7].astype(jnp.float32))
    return jnp.concatenate([r, gl], axis=-1).astype(dtype) @ w_out


def token_mixing(h_lat, h_ctx, w_in, ret_decay_f, ret_decay_b, ret_norm_w,
                 gla_gate_w_f, gla_gate_b_f, gla_gate_w_b, gla_gate_b_b, gla_norm_w, w_out, with_ctx):
    n_lat = h_lat.shape[1]
    p_lat = jnp.split(h_lat @ w_in, IN_SPLITS, axis=-1)
    p_ctx = jnp.split(h_ctx @ w_in, IN_SPLITS, axis=-1)
    lg_f = jax.nn.log_sigmoid(ret_decay_f.astype(jnp.float32))
    lg_b = jax.nn.log_sigmoid(ret_decay_b.astype(jnp.float32))
    ret_lat = retention_inputs(p_lat, n_lat)
    ret_ctx = retention_inputs(p_ctx, None)
    o_ret_l, o_ret_c = bidir_prefix(lambda q, k, v, s: retention_chunked(q, k, v, s, lg_f),
                                    lambda q, k, v, s: retention_chunked(q, k, v, s, lg_b),
                                    ret_lat, ret_lat, ret_ctx, ret_ctx)
    gla_lat_f, gla_lat_b = gla_inputs(p_lat, gla_gate_w_f, gla_gate_b_f, gla_gate_w_b, gla_gate_b_b)
    gla_ctx_f, gla_ctx_b = gla_inputs(p_ctx, gla_gate_w_f, gla_gate_b_f, gla_gate_w_b, gla_gate_b_b)
    o_gla_l, o_gla_c = bidir_prefix(gla_chunked, gla_chunked, gla_lat_f, gla_lat_b, gla_ctx_f, gla_ctx_b)
    y_lat = merge_outputs(o_ret_l, o_gla_l, p_lat, ret_norm_w, gla_norm_w, w_out, h_lat.dtype)
    y_ctx = None
    if with_ctx:
        y_ctx = merge_outputs(o_ret_c, o_gla_c, p_ctx, ret_norm_w, gla_norm_w, w_out, h_ctx.dtype)
    return y_lat, y_ctx


def setup_inputs(seed: int = 0) -> dict:
    key = jax.random.key(seed)
    ks = jax.random.split(key, 32)
    f32 = jnp.float32

    def nrm(k, shape, scale):
        return jax.random.normal(k, shape, f32) * scale

    def gain(k, shape):
        return 1.0 + 0.05 * jax.random.normal(k, shape, f32)

    decay_logit = jnp.log(2.0 ** (5.0 + jnp.arange(RET_HEADS, dtype=f32)) - 1.0)
    return {
        "x": nrm(ks[0], (BATCH, SEQ, D_MODEL), 1.0),
        "c": nrm(ks[1], (BATCH, D_MODEL), 1.0),
        "ctx": nrm(ks[2], (BATCH, CTX_LEN, D_MODEL), 1.0),
        "c_ctx": nrm(ks[3], (D_MODEL,), 1.0),
        "ada_w": nrm(ks[4], (DEPTH, D_MODEL, N_MOD * D_MODEL), 0.5 * D_MODEL ** -0.5),
        "ada_b": nrm(ks[5], (DEPTH, N_MOD * D_MODEL), 0.02),
        "norm1_w": gain(ks[6], (DEPTH, D_MODEL)),
        "ffn1_w1": nrm(ks[7], (DEPTH, D_MODEL, D_FF), D_MODEL ** -0.5),
        "ffn1_w3": nrm(ks[8], (DEPTH, D_MODEL, D_FF), D_MODEL ** -0.5),
        "ffn1_w2": nrm(ks[9], (DEPTH, D_FF, D_MODEL), D_FF ** -0.5),
        "norm2_w": gain(ks[10], (DEPTH, D_MODEL)),
        "w_in": nrm(ks[11], (DEPTH, D_MODEL, IN_COLS), D_MODEL ** -0.5),
        "ret_decay_f": decay_logit + 0.1 * jax.random.normal(ks[12], (DEPTH, RET_HEADS), f32),
        "ret_decay_b": decay_logit + 0.1 * jax.random.normal(ks[13], (DEPTH, RET_HEADS), f32),
        "ret_norm_w": gain(ks[14], (DEPTH, RET_WIDTH)),
        "gla_gate_w_f": nrm(ks[15], (DEPTH, GLA_RANK, GLA_HEADS * GLA_DK), GLA_RANK ** -0.5),
        "gla_gate_b_f": 1.0 + 0.5 * jax.random.normal(ks[16], (DEPTH, GLA_HEADS * GLA_DK), f32),
        "gla_gate_w_b": nrm(ks[17], (DEPTH, GLA_RANK, GLA_HEADS * GLA_DK), GLA_RANK ** -0.5),
        "gla_gate_b_b": 1.0 + 0.5 * jax.random.normal(ks[18], (DEPTH, GLA_HEADS * GLA_DK), f32),
        "gla_norm_w": gain(ks[19], (DEPTH, GLA_WIDTH)),
        "w_out": nrm(ks[20], (DEPTH, D_MIX, D_MODEL), D_MIX ** -0.5),
        "norm3_w": gain(ks[21], (DEPTH, D_MODEL)),
        "ffn2_w1": nrm(ks[22], (DEPTH, D_MODEL, D_FF), D_MODEL ** -0.5),
        "ffn2_w3": nrm(ks[23], (DEPTH, D_MODEL, D_FF), D_MODEL ** -0.5),
        "ffn2_w2": nrm(ks[24], (DEPTH, D_FF, D_MODEL), D_FF ** -0.5),
        "final_norm_w": gain(ks[25], (D_MODEL,)),
    }


def reference(x, c, ctx, c_ctx, ada_w, ada_b, norm1_w, ffn1_w1, ffn1_w3, ffn1_w2, norm2_w, w_in,
              ret_decay_f, ret_decay_b, ret_norm_w, gla_gate_w_f, gla_gate_b_f, gla_gate_w_b, gla_gate_b_b,
              gla_norm_w, w_out, norm3_w, ffn2_w1, ffn2_w3, ffn2_w2, final_norm_w):
    cond_lat = jax.nn.silu(c)
    cond_ctx = jax.nn.silu(c_ctx)[None, :]
    for i in range(DEPTH):
        update_ctx = i < DEPTH - 1
        m_l = jnp.split(cond_lat @ ada_w[i] + ada_b[i], N_MOD, axis=-1)
        m_c = jnp.split(cond_ctx @ ada_w[i] + ada_b[i], N_MOD, axis=-1)
        x = x + 0.5 * m_l[2][:, None, :] * swiglu(modulate(rms_norm(x, norm1_w[i]), m_l[0], m_l[1]),
                                                    ffn1_w1[i], ffn1_w3[i], ffn1_w2[i])
        ctx = ctx + 0.5 * m_c[2][:, None, :] * swiglu(modulate(rms_norm(ctx, norm1_w[i]), m_c[0], m_c[1]),
                                                        ffn1_w1[i], ffn1_w3[i], ffn1_w2[i])
        y_l, y_c = token_mixing(modulate(rms_norm(x, norm2_w[i]), m_l[3], m_l[4]),
                                modulate(rms_norm(ctx, norm2_w[i]), m_c[3], m_c[4]),
                                w_in[i], ret_decay_f[i], ret_decay_b[i], ret_norm_w[i],
                                gla_gate_w_f[i], gla_gate_b_f[i], gla_gate_w_b[i], gla_gate_b_b[i],
                                gla_norm_w[i], w_out[i], update_ctx)
        x = x + m_l[5][:, None, :] * y_l
        x = x + 0.5 * m_l[8][:, None, :] * swiglu(modulate(rms_norm(x, norm3_w[i]), m_l[6], m_l[7]),
                                                    ffn2_w1[i], ffn2_w3[i], ffn2_w2[i])
        if update_ctx:
            ctx = ctx + m_c[5][:, None, :] * y_c
            ctx = ctx + 0.5 * m_c[8][:, None, :] * swiglu(modulate(rms_norm(ctx, norm3_w[i]), m_c[6], m_c[7]),
                                                            ffn2_w1[i], ffn2_w3[i], ffn2_w2[i])
    return rms_norm(x, final_norm_w)
```

```cpp
#include <hip/hip_runtime.h>
#include <hip/hip_cooperative_groups.h>
#include <cstdio>
#include <cstdint>
namespace cg = cooperative_groups;
namespace pg8 {
#define PG8_LAS __attribute__((address_space(3)))
typedef unsigned short bf16_t;
typedef short bf16x8 __attribute__((ext_vector_type(8)));
typedef float f32x4 __attribute__((ext_vector_type(4)));
typedef unsigned u32x4 __attribute__((ext_vector_type(4)));
constexpr int BM = 256, BK = 64, HALF = 128, HTB = HALF * BK * 2  , STAGE_BYTES = 8 * HTB, NXCD = 8, WGM = 8;

__host__ __device__ __forceinline__ int lds_byte(int r, int c) { const int st = (r >> 4) * 2 + (c >> 5), rr = r & 15, cc = c & 31, ob = rr * 64 + cc * 2; return st * 1024 + (ob ^ (((ob >> 9) & 1) << 5)); }
__host__ __device__ __forceinline__ void stage_rc(int b, int& R, int& C) { const int st = b / 1024, sb = b % 1024, swz = sb ^ (((sb >> 9) & 1) << 5); R = (st >> 1) * 16 + swz / 64; C = (st & 1) * 32 + (swz % 64) / 2; }
__host__ __device__ __forceinline__ int perm32(int rho) { const int n = rho >> 4, i = rho & 15; return 8 * (i >> 2) + 4 * n + (i & 3); }

struct Unit { int pm, pn; };
struct Gemm { const bf16_t* A; const bf16_t* Bt; int M, N, K, KT; };

struct StaticOrder {
    int nM, nN, nwg, G, c;
    __host__ __device__ void init(int M, int N, int G_, int c_) { nM = M / BM; nN = N / BM; nwg = nM * nN; G = G_; c = c_; }
    __host__ __device__ bool next(int i, Unit& u) const {
        const long L = (long)i * G + c; if (L >= nwg) return false;
        int wgid = (int)L; { const int q = nwg / NXCD, r = nwg % NXCD, xcd = wgid % NXCD, off = wgid / NXCD; wgid = (xcd < r ? xcd * (q + 1) : r * (q + 1) + (xcd - r) * q) + off; }
        const int nig = WGM * nN, gid = wgid / nig, fm = gid * WGM, gsz = (nM - fm) < WGM ? (nM - fm) : WGM;
        u.pm = fm + ((wgid % nig) % gsz); u.pn = (wgid % nig) / gsz; return true;
    }
    __device__ __forceinline__ void a_ready(const Unit&) const {}
    __device__ __forceinline__ void done(const Unit&) const {}
};

__device__ __forceinline__ unsigned cvt_pk_bf16(float lo, float hi) { unsigned r; asm volatile("v_cvt_pk_bf16_f32 %0, %1, %2" : "=v"(r) : "v"(lo), "v"(hi)); return r; }
template <class Epi, class Sched, bool ALIGN_EPI = false, bool SP2 = false>
__device__ __forceinline__ void gemm_phase(PG8_LAS unsigned char* lds, const Gemm g, const Sched& S, const Epi& E) {
    const int tid = threadIdx.x, wid = __builtin_amdgcn_readfirstlane(tid >> 6), lane = tid & 63, wr = wid >> 2, wc = wid & 3, fr = lane & 15, fq = lane >> 4;
    const int K = g.K, nt = g.KT;
    unsigned voffA[2], voffB[2];
#pragma unroll
    for (int i = 0; i < 2; ++i) { int R, C; stage_rc(tid * 16 + i * 8192, R, C); const int Rb = Epi::PERM ? ((R & ~31) + perm32(R & 31)) : R;
        voffA[i] = (unsigned)(R * K + C) * 2u; voffB[i] = (unsigned)(Rb * K + C) * 2u; }
    const size_t kstep = (size_t)(BK * 2);
    const size_t hstep = (size_t)HALF * K * 2;
    const size_t tstep = 2 * hstep;
    const unsigned ldsw = (unsigned)wid * 1024u;
    const int aoff = lds_byte(wr * 64 + fr, fq * 8), boff = lds_byte(wc * 32 + fr, fq * 8);
#define PG8_SA(b, h) (((b) * 2 + (h)) * HTB)
#define PG8_SB(b, h) ((4 + (b) * 2 + (h)) * HTB)
#define PG8_STAGE(bufoff, gbase, voff) do { _Pragma("unroll") for (int _i = 0; _i < 2; ++_i) \
        __builtin_amdgcn_global_load_lds((const unsigned*)((const char*)(gbase) + (voff)[_i]), (PG8_LAS unsigned*)(lds + (bufoff) + ldsw + _i * 8192), 16, 0, 0); } while (0)
#define PG8_LDA(dst, b, h) do { _Pragma("unroll") for (int m = 0; m < 4; ++m) _Pragma("unroll") for (int k = 0; k < 2; ++k) dst[m][k] = *(const PG8_LAS bf16x8*)(lds + PG8_SA(b, h) + aoff + m * 2048 + k * 1024); } while (0)
#define PG8_LDB(dst, b, h) do { _Pragma("unroll") for (int n = 0; n < 2; ++n) _Pragma("unroll") for (int k = 0; k < 2; ++k) dst[n][k] = *(const PG8_LAS bf16x8*)(lds + PG8_SB(b, h) + boff + n * 2048 + k * 1024); } while (0)
#define PG8_MMA(ai, bj, At, Bt) do { __builtin_amdgcn_s_setprio(1); _Pragma("unroll") for (int m = 0; m < 4; ++m) _Pragma("unroll") for (int n = 0; n < 2; ++n) _Pragma("unroll") for (int k = 0; k < 2; ++k) \
        acc[ai][bj][m][n] = __builtin_amdgcn_mfma_f32_16x16x32_bf16(Bt[n][k], At[m][k], acc[ai][bj][m][n], 0, 0, 0); __builtin_amdgcn_s_setprio(0); } while (0)
#define PG8_WAIT_V(n) asm volatile("s_waitcnt vmcnt(" #n ")" ::: "memory")
#define PG8_WAIT_L(n) asm volatile("s_waitcnt lgkmcnt(" #n ")" ::: "memory")
#define PG8_BAR __builtin_amdgcn_s_barrier()
#define PG8_SCHED __builtin_amdgcn_sched_barrier(0)
    Unit cur, nxt; int ui = 0;
    if (!S.next(0, cur)) return;
    f32x4 acc[2][2][4][2];
#pragma unroll
    for (int a = 0; a < 2; ++a)
#pragma unroll
        for (int b = 0; b < 2; ++b)
#pragma unroll
            for (int m = 0; m < 4; ++m)
#pragma unroll
                for (int n = 0; n < 2; ++n) acc[a][b][m][n] = (f32x4){0.f, 0.f, 0.f, 0.f};
    bf16x8 At[4][2], B0[2][2], B1[2][2];
    const char* cA = (const char*)g.A + (size_t)cur.pm * tstep; const char* cB = (const char*)g.Bt + (size_t)cur.pn * tstep;
    S.a_ready(cur);
    if constexpr (SP2) {
        PG8_STAGE(PG8_SB(0, 0), cB, voffB); PG8_STAGE(PG8_SB(0, 1), cB + hstep, voffB); PG8_STAGE(PG8_SA(0, 0), cA, voffA); PG8_STAGE(PG8_SA(0, 1), cA + hstep, voffA);
        if (wr == 1) PG8_BAR;
        PG8_WAIT_V(2); PG8_BAR;
        PG8_STAGE(PG8_SB(1, 0), cB + kstep, voffB); PG8_STAGE(PG8_SA(1, 0), cA + kstep, voffA); PG8_STAGE(PG8_SB(1, 1), cB + hstep + kstep, voffB);
        PG8_WAIT_V(6); PG8_BAR;
    } else {
        PG8_STAGE(PG8_SB(0, 0), cB, voffB); PG8_STAGE(PG8_SA(0, 0), cA, voffA); PG8_STAGE(PG8_SB(0, 1), cB + hstep, voffB); PG8_STAGE(PG8_SA(0, 1), cA + hstep, voffA);
        if (wr == 1) PG8_BAR;
        PG8_WAIT_V(4); PG8_BAR;
        PG8_STAGE(PG8_SB(1, 0), cB + kstep, voffB); PG8_STAGE(PG8_SA(1, 0), cA + kstep, voffA); PG8_STAGE(PG8_SB(1, 1), cB + hstep + kstep, voffB);
        PG8_WAIT_V(6); PG8_BAR;
    }
    for (;;) {
        const bool has_next = S.next(ui + 1, nxt);
        const char* nA = has_next ? (const char*)g.A + (size_t)nxt.pm * tstep : cA; const char* nB = has_next ? (const char*)g.Bt + (size_t)nxt.pn * tstep : cB;
        for (int t = 0; t < nt; t += 2) {
            const bool last = (t == nt - 2);
            const char* a1 = cA + (size_t)(t + 1) * kstep;
            const char* a2 = last ? nA : cA + (size_t)(t + 2) * kstep; const char* b2 = last ? nB : cB + (size_t)(t + 2) * kstep;
            const char* a3 = a2 + kstep; const char* b3 = b2 + kstep;
            if (last && has_next) S.a_ready(nxt);
            if constexpr (SP2) {
            PG8_LDB(B0, 0, 0); PG8_LDB(B1, 0, 1); PG8_SCHED; PG8_LDA(At, 0, 0); PG8_STAGE(PG8_SA(1, 1), a1 + hstep, voffA);
            PG8_WAIT_V(8); PG8_WAIT_L(0); PG8_BAR; PG8_MMA(0, 0, At, B0); PG8_MMA(0, 1, At, B1); PG8_BAR; PG8_SCHED;
            PG8_LDA(At, 0, 1); PG8_STAGE(PG8_SB(0, 0), b2, voffB); PG8_STAGE(PG8_SB(0, 1), b2 + hstep, voffB); PG8_STAGE(PG8_SA(0, 0), a2, voffA);
            PG8_WAIT_V(8); PG8_WAIT_L(0); PG8_BAR; PG8_MMA(1, 0, At, B0); PG8_MMA(1, 1, At, B1); PG8_BAR; PG8_SCHED;
            PG8_LDB(B0, 1, 0); PG8_LDB(B1, 1, 1); PG8_SCHED; PG8_LDA(At, 1, 0); PG8_STAGE(PG8_SA(0, 1), a2 + hstep, voffA);
            PG8_WAIT_V(8); PG8_WAIT_L(0); PG8_BAR; PG8_MMA(0, 0, At, B0); PG8_MMA(0, 1, At, B1); PG8_BAR; PG8_SCHED;
            PG8_LDA(At, 1, 1); PG8_STAGE(PG8_SB(1, 0), b3, voffB); PG8_STAGE(PG8_SB(1, 1), b3 + hstep, voffB); PG8_STAGE(PG8_SA(1, 0), a3, voffA);
            PG8_WAIT_V(8); PG8_WAIT_L(0); PG8_BAR; PG8_MMA(1, 0, At, B0); PG8_MMA(1, 1, At, B1); PG8_BAR; PG8_SCHED;
            } else {
            PG8_LDB(B0, 0, 0); PG8_SCHED; PG8_LDA(At, 0, 0); PG8_STAGE(PG8_SA(1, 1), a1 + hstep, voffA);
            PG8_WAIT_L(8); PG8_BAR; PG8_WAIT_L(0); PG8_MMA(0, 0, At, B0); PG8_BAR; PG8_SCHED;
            PG8_LDB(B1, 0, 1); PG8_STAGE(PG8_SB(0, 0), b2, voffB);
            PG8_BAR; PG8_WAIT_L(0); PG8_MMA(0, 1, At, B1); PG8_BAR;
            PG8_LDA(At, 0, 1); PG8_STAGE(PG8_SA(0, 0), a2, voffA);
            PG8_BAR; PG8_WAIT_L(0); PG8_MMA(1, 0, At, B0); PG8_BAR; PG8_SCHED;
            PG8_STAGE(PG8_SB(0, 1), b2 + hstep, voffB);
            PG8_WAIT_V(6); PG8_BAR; PG8_MMA(1, 1, At, B1); PG8_BAR;
            PG8_LDB(B0, 1, 0); PG8_SCHED; PG8_LDA(At, 1, 0); PG8_STAGE(PG8_SA(0, 1), a2 + hstep, voffA);
            PG8_WAIT_L(8); PG8_BAR; PG8_WAIT_L(0); PG8_MMA(0, 0, At, B0); PG8_BAR; PG8_SCHED;
            PG8_LDB(B1, 1, 1); PG8_STAGE(PG8_SB(1, 0), b3, voffB);
            PG8_BAR; PG8_WAIT_L(0); PG8_MMA(0, 1, At, B1); PG8_BAR;
            PG8_LDA(At, 1, 1); PG8_STAGE(PG8_SA(1, 0), a3, voffA);
            PG8_BAR; PG8_WAIT_L(0); PG8_MMA(1, 0, At, B0); PG8_BAR; PG8_SCHED;
            PG8_STAGE(PG8_SB(1, 1), b3 + hstep, voffB);
            PG8_WAIT_V(6); PG8_BAR; PG8_MMA(1, 1, At, B1); PG8_BAR;
            }
        }
        if constexpr (ALIGN_EPI) { if (wr == 0) PG8_BAR; }
        if constexpr (!Epi::AFTER_DRAIN) { E(acc, cur, wr, wc, fr, fq); S.done(cur); }
        if (!has_next) break;
#pragma unroll
        for (int a = 0; a < 2; ++a)
#pragma unroll
            for (int b = 0; b < 2; ++b)
#pragma unroll
                for (int m = 0; m < 4; ++m)
#pragma unroll
                    for (int n = 0; n < 2; ++n) acc[a][b][m][n] = (f32x4){0.f, 0.f, 0.f, 0.f};
        cur = nxt; cA = nA; cB = nB; ++ui;
        if constexpr (ALIGN_EPI) { if (wr == 1) PG8_BAR; }
    }
    PG8_WAIT_V(0);
    if constexpr (!ALIGN_EPI) { if (wr == 0) PG8_BAR; }
    PG8_BAR;
    if constexpr (Epi::AFTER_DRAIN) { E.fused(acc, cur, wr, wc, fr, fq, lds, wid, lane); S.done(cur); }
#undef PG8_SA
#undef PG8_SB
#undef PG8_STAGE
#undef PG8_LDA
#undef PG8_LDB
#undef PG8_MMA
#undef PG8_WAIT_V
#undef PG8_WAIT_L
#undef PG8_BAR
#undef PG8_SCHED
}
}

#define LAS __attribute__((address_space(3)))
#ifndef PROBE
#define PROBE 0
#endif
typedef unsigned short bf16_t;
typedef short bf16x8 __attribute__((ext_vector_type(8)));
typedef float f32x4 __attribute__((ext_vector_type(4)));
typedef unsigned u32x4 __attribute__((ext_vector_type(4)));
typedef unsigned u32x2 __attribute__((ext_vector_type(2)));

constexpr int D = 1024, FF = 2816, NLAT = 16384, NCTX = 512, MROWS = NLAT + NCTX, NIN = 3616, NINP = 3840, PP = 3584  ;
constexpr int NMODS = 9 * D;
constexpr float EPS = 1e-6f;
constexpr int NTHREADS = 512;
constexpr int LDS_BYTES = 144 * 1024;

constexpr size_t MiB = 1u << 20;
constexpr size_t WS_PART = 0;
constexpr size_t WS_BAR  = WS_PART + 1792 * 1024;
constexpr size_t WS_CNT  = WS_BAR + 64 * 1024;
constexpr size_t WS_MODS = WS_PART + 2 * MiB;
constexpr size_t WS_LR   = WS_MODS + 128 * 1024;
constexpr size_t WS_X1C  = WS_LR + (size_t)MROWS * 32 * 4 + 0;
constexpr size_t WS_DG   = WS_X1C + 2 * MiB;
constexpr size_t WS_W13  = WS_DG + 1 * MiB;
constexpr size_t WS_W2   = WS_W13 + (size_t)2 * FF * D * 2;
constexpr size_t WS_WIN  = WS_W2 + (size_t)FF * D * 2;
constexpr size_t WS_WOUT = WS_WIN + (size_t)NINP * D * 2;
constexpr size_t WS_H    = WS_WOUT + (size_t)D * D * 2;
constexpr size_t WS_GP   = WS_H + (size_t)MROWS * D * 2;
constexpr size_t WS_SR   = WS_GP + (size_t)MROWS * PP * 2;
constexpr size_t WS_SG   = WS_SR + (size_t)16 * 66 * 16384 * 2;
constexpr size_t WS_END  = WS_SG + (size_t)16 * 132 * 8192 * 2;
static_assert(WS_END <= 256 * MiB, "workspace over 256 MiB");
static_assert(WS_LR % 256 == 0 && WS_X1C % 256 == 0 && WS_W13 % 256 == 0 && WS_H % 256 == 0 && WS_GP % 256 == 0 && WS_SR % 256 == 0 && WS_SG % 256 == 0, "align");

__device__ __forceinline__ unsigned f2bf(float f) { unsigned u = __builtin_bit_cast(unsigned, f); return (u + 0x7fffu + ((u >> 16) & 1u)) >> 16; }
__device__ __forceinline__ unsigned pk2(float lo, float hi) { return f2bf(lo) | (f2bf(hi) << 16); }
__device__ __forceinline__ unsigned cvtpk(float lo, float hi) { unsigned r; asm("v_cvt_pk_bf16_f32 %0, %1, %2" : "=v"(r) : "v"(lo), "v"(hi)); return r; }
__device__ __forceinline__ float bflo(unsigned u) { return __builtin_bit_cast(float, u << 16); }
__device__ __forceinline__ float bfhi(unsigned u) { return __builtin_bit_cast(float, u & 0xffff0000u); }
__device__ __forceinline__ float bf2f(bf16_t h) { return __builtin_bit_cast(float, (unsigned)h << 16); }
__device__ __forceinline__ float silu_f(float v) { return v * __builtin_amdgcn_rcpf(1.0f + __expf(-v)); }
__device__ __forceinline__ float wave_sum(float v) {
#pragma unroll
    for (int o = 1; o < 64; o <<= 1) v += __shfl_xor(v, o);
    return v;
}
#define LDS_WAIT() asm volatile("s_waitcnt lgkmcnt(0)" ::: "memory")

typedef float f32x2 __attribute__((ext_vector_type(2)));
__device__ __forceinline__ f32x2 swiglu2(f32x2 g, f32x2 u) {
    const f32x2 t = g * (-1.4426950408889634f);
    f32x2 e; e.x = __builtin_amdgcn_exp2f(t.x); e.y = __builtin_amdgcn_exp2f(t.y);
    const f32x2 dn = e + 1.0f;
    f32x2 r; r.x = __builtin_amdgcn_rcpf(dn.x); r.y = __builtin_amdgcn_rcpf(dn.y);
    return (g * u) * r;
}
struct EpiSwiglu {
    static constexpr bool PERM = true, AFTER_DRAIN = false;
    bf16_t* G;
    __device__ __forceinline__ void operator()(const f32x4 (&acc)[2][2][4][2], const pg8::Unit& u, int wr, int wc, int fr, int fq) const {
        const int row0 = u.pm * 256 + wr * 64 + fr, col0 = u.pn * 128 + wc * 32 + 8 * fq;
#pragma unroll
        for (int ai = 0; ai < 2; ++ai)
#pragma unroll
            for (int m = 0; m < 4; ++m) {
                bf16_t* p = G + (size_t)(row0 + ai * 128 + m * 16) * FF + col0;
                const f32x4 g0 = acc[ai][0][m][0], g1 = acc[ai][0][m][1], u0 = acc[ai][1][m][0], u1 = acc[ai][1][m][1];
                const f32x2 a = swiglu2((f32x2){g0[0], g0[1]}, (f32x2){u0[0], u0[1]}), b = swiglu2((f32x2){g0[2], g0[3]}, (f32x2){u0[2], u0[3]});
                const f32x2 c = swiglu2((f32x2){g1[0], g1[1]}, (f32x2){u1[0], u1[1]}), d = swiglu2((f32x2){g1[2], g1[3]}, (f32x2){u1[2], u1[3]});
                u32x4 w;
                w.x = pg8::cvt_pk_bf16(a.x, a.y); w.y = pg8::cvt_pk_bf16(b.x, b.y); w.z = pg8::cvt_pk_bf16(c.x, c.y); w.w = pg8::cvt_pk_bf16(d.x, d.y);
                *(u32x4*)p = w;
            }
    }
};
struct EpiResid {
    static constexpr bool PERM = false, AFTER_DRAIN = false;
    const float* src_lat; const float* src_ctx; float* dst_lat; float* dst_ctx; const float* mods; int midx; float scale;
    __device__ __forceinline__ void operator()(const f32x4 (&acc)[2][2][4][2], const pg8::Unit& u, int wr, int wc, int fr, int fq) const {
        const int cond = u.pm < 32 ? 0 : (u.pm < 64 ? 1 : 2);
        const int col0 = u.pn * 256 + wc * 32 + 4 * fq;
        const float* mrow = mods + cond * NMODS + midx * D + col0;
        f32x4 mv[2][2];
#pragma unroll
        for (int bj = 0; bj < 2; ++bj)
#pragma unroll
            for (int n = 0; n < 2; ++n) mv[bj][n] = *(const f32x4*)(mrow + bj * 128 + n * 16) * scale;
        const bool lat = u.pm < 64;
        const int rbase = (lat ? u.pm * 256 : (u.pm - 64) * 256) + wr * 64 + fr;
        const float* sb = lat ? src_lat : src_ctx; float* db = lat ? dst_lat : dst_ctx;
#pragma unroll
        for (int ai = 0; ai < 2; ++ai)
#pragma unroll
            for (int m = 0; m < 4; ++m) {
                const size_t ro = (size_t)(rbase + ai * 128 + m * 16) * D + col0;
#pragma unroll
                for (int bj = 0; bj < 2; ++bj)
#pragma unroll
                    for (int n = 0; n < 2; ++n) {
                        const f32x4 s = *(const f32x4*)(sb + ro + bj * 128 + n * 16);
                        *(f32x4*)(db + ro + bj * 128 + n * 16) = s + mv[bj][n] * acc[ai][bj][m][n];
                    }
                asm volatile("" ::: "memory");
            }
    }
};
struct EpiWin {
    static constexpr bool PERM = true, AFTER_DRAIN = false;
    bf16_t* P; float* LR;
    __device__ __forceinline__ void operator()(const f32x4 (&acc)[2][2][4][2], const pg8::Unit& u, int wr, int wc, int fr, int fq) const {
        const int pn = u.pn; const int rowb = u.pm * 256 + wr * 64 + fr;
        if (pn == 14) {
            if (wc == 0) {
#pragma unroll
                for (int ai = 0; ai < 2; ++ai)
#pragma unroll
                    for (int m = 0; m < 4; ++m) { float* p = LR + (size_t)(rowb + ai * 128 + m * 16) * 32 + 8 * fq; *(f32x4*)p = acc[ai][0][m][0]; *(f32x4*)(p + 4) = acc[ai][0][m][1]; }
            }
            return;
        }
        const bool rope = (pn < 4) && (u.pm < 64);
        const bool dosilu = (pn == 6) || (pn == 7) || (pn == 12) || (pn == 13);
        const float sc = pn < 2 ? 0.08838834764831845f : (pn == 8 ? 0.125f : 1.0f);
        const int col0 = pn * 256 + wc * 32 + 8 * fq;
        float frq[4];
#pragma unroll
        for (int j = 0; j < 4; ++j) frq[j] = exp2f(-(float)(16 * (wc & 1) + 4 * fq + j) * (13.287712379549449f / 32.0f));
#pragma unroll
        for (int ai = 0; ai < 2; ++ai)
#pragma unroll
            for (int m = 0; m < 4; ++m) {
                const int row = rowb + ai * 128 + m * 16;
                const int tok = row & 8191;
                const float pos = (float)((wc < 2) ? (tok >> 6) : (tok & 63));
#pragma unroll
                for (int bj = 0; bj < 2; ++bj) {
                    f32x4 v0 = acc[ai][bj][m][0] * sc, v1 = acc[ai][bj][m][1] * sc;
                    if (rope) {
#pragma unroll
                        for (int j = 0; j < 4; ++j) { const float ang = pos * frq[j]; const float sn = __sinf(ang), cs = __cosf(ang); const float a = v0[j], b = v1[j]; v0[j] = a * cs - b * sn; v1[j] = a * sn + b * cs; }
                    }
                    if (dosilu) {
#pragma unroll
                        for (int j = 0; j < 4; ++j) { v0[j] = silu_f(v0[j]); v1[j] = silu_f(v1[j]); }
                    }
                    u32x4 w; w.x = pg8::cvt_pk_bf16(v0[0], v0[1]); w.y = pg8::cvt_pk_bf16(v0[2], v0[3]); w.z = pg8::cvt_pk_bf16(v1[0], v1[1]); w.w = pg8::cvt_pk_bf16(v1[2], v1[3]);
                    *(u32x4*)(P + (size_t)row * PP + col0 + bj * 128) = w;
                }
            }
    }
};

struct CtxFirstOrder {
    int nN, nwg, G, c; unsigned* cnt; LAS unsigned* lcnt;
    __device__ void init(int G_, int c_, unsigned* cnt_, LAS unsigned* lcnt_) { nN = 22; nwg = 64 * 22; G = G_; c = c_; cnt = cnt_; lcnt = lcnt_; }
    __device__ bool next(int i, pg8::Unit& u) const {
        long L = (long)i * G + c;
        if (L < 44) { u.pm = 64 + (L >= 22 ? 1 : 0); u.pn = (int)(L % 22); return true; }
        L -= 44; if (L >= nwg) return false;
        int wgid = (int)L; { const int q = nwg / pg8::NXCD, r = nwg % pg8::NXCD, xcd = wgid % pg8::NXCD, off = wgid / pg8::NXCD; wgid = (xcd < r ? xcd * (q + 1) : r * (q + 1) + (xcd - r) * q) + off; }
        const int nig = pg8::WGM * nN, gid = wgid / nig, fm = gid * pg8::WGM, gsz = (64 - fm) < pg8::WGM ? (64 - fm) : pg8::WGM;
        u.pm = fm + ((wgid % nig) % gsz); u.pn = (wgid % nig) / gsz; return true;
    }
    __device__ __forceinline__ void a_ready(const pg8::Unit&) const {}
    __device__ __forceinline__ void done(const pg8::Unit& u) const {
        if (u.pm >= 64) {
            asm volatile("s_waitcnt vmcnt(0)" ::: "memory");
            unsigned old = 0u;
            if ((threadIdx.x & 63) == 0) old = __hip_atomic_fetch_add((LAS unsigned*)lcnt, 1u, __ATOMIC_RELAXED, __HIP_MEMORY_SCOPE_WORKGROUP);
            old = (unsigned)__builtin_amdgcn_readfirstlane((int)old);
            if ((old & 7u) == 7u) { __builtin_amdgcn_fence(__ATOMIC_RELEASE, "agent"); asm volatile("s_waitcnt vmcnt(0)" ::: "memory");
                if ((threadIdx.x & 63) == 0) __hip_atomic_fetch_add(cnt, 8u, __ATOMIC_RELAXED, __HIP_MEMORY_SCOPE_AGENT); }
        }
    }
};
struct OneUnit { int pm, pn;
    __device__ bool next(int i, pg8::Unit& u) const { if (i != 0) return false; u.pm = pm; u.pn = pn; return true; }
    __device__ __forceinline__ void a_ready(const pg8::Unit&) const {}
    __device__ __forceinline__ void done(const pg8::Unit&) const {}
};
struct EpiCtxAtomic {
    static constexpr bool PERM = false, AFTER_DRAIN = false;
    float* slab; const float* mods;
    __device__ __forceinline__ void operator()(const f32x4 (&acc)[2][2][4][2], const pg8::Unit& u, int wr, int wc, int fr, int fq) const {
        const int col0 = u.pn * 256 + wc * 32 + 4 * fq;
        const float* mrow = mods + 2 * NMODS + 2 * D + col0;
        f32x4 mv[2][2];
#pragma unroll
        for (int bj = 0; bj < 2; ++bj)
#pragma unroll
            for (int n = 0; n < 2; ++n) mv[bj][n] = *(const f32x4*)(mrow + bj * 128 + n * 16) * 0.5f;
#pragma unroll
        for (int ai = 0; ai < 2; ++ai)
#pragma unroll
            for (int m = 0; m < 4; ++m) {
                float* rp = slab + (size_t)(u.pm * 256 + ai * 128 + wr * 64 + m * 16 + fr) * D + col0;
#pragma unroll
                for (int bj = 0; bj < 2; ++bj)
#pragma unroll
                    for (int n = 0; n < 2; ++n) *(f32x4*)(rp + bj * 128 + n * 16) = mv[bj][n] * acc[ai][bj][m][n];
            }
    }
};

template <int MODE> struct EpiResidNorm {
    static constexpr bool PERM = false, AFTER_DRAIN = true;
    static constexpr int RMIDX = MODE == 0 ? 8 : (MODE == 1 ? 2 : 5), SH = MODE == 1 ? 3 : 6, SC = MODE == 1 ? 4 : 7, NWI = MODE == 0 ? 25 : (MODE == 1 ? 10 : 21);
    static constexpr float scale = MODE == 2 ? 1.0f : 0.5f;
    __device__ __forceinline__ void operator()(const f32x4 (&)[2][2][4][2], const pg8::Unit&, int, int, int, int) const {}
    __device__ __forceinline__ void fused(f32x4 (&acc)[2][2][4][2], const pg8::Unit& u, int wr, int wc, int fr, int fq, PG8_LAS unsigned char* lds, int wid, int lane) const {
        const __attribute__((address_space(4))) char* ka = (const __attribute__((address_space(4))) char*)__builtin_amdgcn_kernarg_segment_ptr();
        float* dst = *(float* const __attribute__((address_space(4)))*)(ka + 8 * 26);
        const float* src = *(const float* const __attribute__((address_space(4)))*)(ka + 8 * 0);
        unsigned char* wsb = *(unsigned char* const __attribute__((address_space(4)))*)(ka + 8 * 27);
        const bf16_t* srcb = MODE == 2 ? (const bf16_t*)dst : (const bf16_t*)(wsb + WS_SR);
        bf16_t* dstb = MODE == 1 ? (bf16_t*)dst : (bf16_t*)(wsb + WS_SR);
        const float* nw = *(const float* const __attribute__((address_space(4)))*)(ka + 8 * NWI);
        const float* mods = (const float*)(wsb + WS_MODS); float* xbuf = (float*)(wsb + WS_PART) + MODE * 65536; unsigned* pcnt = (unsigned*)(wsb + WS_CNT + 1024) + MODE * 4096;
        const int cond = u.pm < 32 ? 0 : 1;
        const int col0 = u.pn * 256 + wc * 32 + 4 * fq;
        const float* mrow = mods + cond * NMODS + RMIDX * D + col0;
        PG8_LAS float* P = (PG8_LAS float*)lds;
        PG8_LAS float* S = (PG8_LAS float*)(lds + 8192);
        {
            f32x4 mv[2][2];
#pragma unroll
            for (int bj = 0; bj < 2; ++bj)
#pragma unroll
                for (int n = 0; n < 2; ++n) mv[bj][n] = *(const f32x4*)(mrow + bj * 128 + n * 16) * scale;
#pragma unroll
            for (int ai = 0; ai < 2; ++ai)
#pragma unroll
                for (int m = 0; m < 4; ++m) {
                    const int r = ai * 128 + wr * 64 + m * 16 + fr;
                    const size_t ro = (size_t)(u.pm * 256 + r) * D + col0;
                    float sq = 0.f;
#pragma unroll
                    for (int bj = 0; bj < 2; ++bj)
#pragma unroll
                        for (int n = 0; n < 2; ++n) {
                            f32x4 xin;
                            if (MODE == 1) xin = __builtin_nontemporal_load((const f32x4*)(src + ro + bj * 128 + n * 16));
                            else { const u32x2 t = *(const u32x2*)(srcb + ro + bj * 128 + n * 16); xin = (f32x4){bflo(t.x), bfhi(t.x), bflo(t.y), bfhi(t.y)}; }
                            const f32x4 x = xin + mv[bj][n] * acc[ai][bj][m][n]; acc[ai][bj][m][n] = x; sq += (x[0] * x[0] + x[1] * x[1]) + (x[2] * x[2] + x[3] * x[3]);
                            if (MODE != 0) { u32x2 o; o.x = cvtpk(x[0], x[1]); o.y = cvtpk(x[2], x[3]); *(u32x2*)(dstb + ro + bj * 128 + n * 16) = o; } }
                    sq += __shfl_xor(sq, 16); sq += __shfl_xor(sq, 32);
                    if (fq == 0) P[r * 4 + wc] = sq;
                    asm volatile("" ::: "memory");
                }
        }
        asm volatile("s_waitcnt lgkmcnt(0)" ::: "memory"); __builtin_amdgcn_s_barrier(); asm volatile("" ::: "memory");
        const int row = wid * 32 + (lane & 31);
        if (lane < 32) {
            const float t = (P[row * 4 + 0] + P[row * 4 + 1]) + (P[row * 4 + 2] + P[row * 4 + 3]);
            __hip_atomic_store(xbuf + ((size_t)(u.pm * 256 + row) * 4 + u.pn), t, __ATOMIC_RELAXED, __HIP_MEMORY_SCOPE_AGENT);
        }
        asm volatile("s_waitcnt vmcnt(0)" ::: "memory");
        if (lane == 0) __hip_atomic_fetch_add(pcnt + 64 * u.pm, 1u, __ATOMIC_RELAXED, __HIP_MEMORY_SCOPE_AGENT);
        if (wid == 0) {
            unsigned spins = 0;
            while ((unsigned)__builtin_amdgcn_readfirstlane((int)__hip_atomic_load(pcnt + 64 * u.pm, __ATOMIC_RELAXED, __HIP_MEMORY_SCOPE_AGENT)) < 32u) { __builtin_amdgcn_s_sleep(2); if (++spins > (1u << 22)) break; }
            __builtin_amdgcn_fence(__ATOMIC_ACQUIRE, "agent");
        }
        asm volatile("s_waitcnt vmcnt(0) lgkmcnt(0)" ::: "memory"); __builtin_amdgcn_s_barrier(); asm volatile("" ::: "memory");
        if (lane < 32) {
            const unsigned long long* slot = (const unsigned long long*)(xbuf + (size_t)(u.pm * 256 + row) * 4);
            const unsigned long long s01 = __hip_atomic_load(slot, __ATOMIC_RELAXED, __HIP_MEMORY_SCOPE_AGENT), s23 = __hip_atomic_load(slot + 1, __ATOMIC_RELAXED, __HIP_MEMORY_SCOPE_AGENT);
            const float ss = (__builtin_bit_cast(float, (unsigned)s01) + __builtin_bit_cast(float, (unsigned)(s01 >> 32))) + (__builtin_bit_cast(float, (unsigned)s23) + __builtin_bit_cast(float, (unsigned)(s23 >> 32)));
            S[row] = 1.0f / sqrtf(ss * (1.0f / D) + EPS);
        }
        asm volatile("s_waitcnt lgkmcnt(0)" ::: "memory"); __builtin_amdgcn_s_barrier(); asm volatile("" ::: "memory");
        f32x4 wv[2][2], shv[2][2];
#pragma unroll
        for (int bj = 0; bj < 2; ++bj)
#pragma unroll
            for (int n = 0; n < 2; ++n) { wv[bj][n] = *(const f32x4*)(nw + col0 + bj * 128 + n * 16);
                if (MODE != 0) { wv[bj][n] = wv[bj][n] * (*(const f32x4*)(mods + cond * NMODS + SC * D + col0 + bj * 128 + n * 16) + 1.0f); shv[bj][n] = *(const f32x4*)(mods + cond * NMODS + SH * D + col0 + bj * 128 + n * 16); } }
        bf16_t* Hb = (bf16_t*)(wsb + WS_H);
#pragma unroll
        for (int ai = 0; ai < 2; ++ai)
#pragma unroll
            for (int m = 0; m < 4; ++m) {
                const int r = ai * 128 + wr * 64 + m * 16 + fr; const float rs = S[r];
                const size_t ro = (size_t)(u.pm * 256 + r) * D + col0;
#pragma unroll
                for (int bj = 0; bj < 2; ++bj)
#pragma unroll
                    for (int n = 0; n < 2; ++n) {
                        if (MODE == 0) __builtin_nontemporal_store(acc[ai][bj][m][n] * rs * wv[bj][n], (f32x4*)(dst + ro + bj * 128 + n * 16));
                        else { const f32x4 hh = acc[ai][bj][m][n] * rs * wv[bj][n] + shv[bj][n]; u32x2 o; o.x = pk2(hh[0], hh[1]); o.y = pk2(hh[2], hh[3]); *(u32x2*)(Hb + ro + bj * 128 + n * 16) = o; }
                    }
            }
    }
};

template <int MODE> __device__ __forceinline__ int dest_row(int n, int row_off) {
    if (MODE == 0) return n + row_off;
    if (MODE == 1) return (n >> 7) * 256 + (n & 127) + row_off;
    if (n >= 1024) return n;
    const int d = n & 127, half = d >> 6, x = (d >> 5) & 1, i = d & 31;
    const int wc = 2 * half + (i >> 4), fq = (i >> 2) & 3, j = i & 3;
    return (n & ~127) + 32 * wc + 8 * fq + 4 * x + j;
}
template <int MODE> __device__ __forceinline__ void transpose_item(const float* W, int K, int N, bf16_t* WT, int row_off, LAS float* scr, int item, int lane) {
    const int nblk = N / 32, kb = item / nblk, nb = item % nblk, k0 = 64 * kb, n0 = 32 * nb;
    float wv[32];
#pragma unroll
    for (int i = 0; i < 32; ++i) { const int kk = 2 * i + (lane >> 5); wv[i] = __builtin_nontemporal_load(W + (size_t)(k0 + kk) * N + n0 + (lane & 31)); }
#pragma unroll
    for (int i = 0; i < 32; ++i) { const int kk = 2 * i + (lane >> 5); scr[kk * 33 + (lane & 31)] = wv[i]; }
    LDS_WAIT();
    const int c = lane & 7;
#pragma unroll
    for (int j = 0; j < 4; ++j) { const int n = (lane >> 3) + 8 * j; const LAS float* s = scr + (8 * c) * 33 + n;
        u32x4 o; o.x = pk2(s[0 * 33], s[1 * 33]); o.y = pk2(s[2 * 33], s[3 * 33]); o.z = pk2(s[4 * 33], s[5 * 33]); o.w = pk2(s[6 * 33], s[7 * 33]);
        *(u32x4*)(WT + (size_t)dest_row<MODE>(n0 + n, row_off) * K + k0 + 8 * c) = o; }
    LDS_WAIT();
}
__device__ __forceinline__ void convert_ffn(const float* w1, const float* w3, const float* w2, bf16_t* W13, bf16_t* W2, LAS float* scr, int gw, int NGW, int lane) {
    constexpr int I13 = (D / 64) * (FF / 32), I2 = (FF / 64) * (D / 32);
    for (int it = gw; it < 2 * I13 + I2; it += NGW) {
        int r = it;
        if (r < I13) { transpose_item<1>(w1, D, FF, W13, 0, scr, r, lane); continue; } r -= I13;
        if (r < I13) { transpose_item<1>(w3, D, FF, W13, 128, scr, r, lane); continue; } r -= I13;
        transpose_item<0>(w2, FF, D, W2, 0, scr, r, lane);
    }
}

template <bool FROM_PART, bool FINAL>
__device__ __forceinline__ void norm_phase(LAS unsigned char* lds, const float* src_lat, const float* src_ctx, int nrows, const float* nw, const float* part, const float* ada_b, const float* mods,
                                           int shift_idx, int scale_idx, bf16_t* H, float* outf, int gw, int NGW, int tid, int lane, int row_begin = 0, const float* slabs = nullptr) {
    LAS float* tab = (LAS float*)lds;
    if (!FINAL) {
        for (int i4 = tid; i4 < 1536; i4 += NTHREADS) {
            const int idx = 4 * i4, cond = idx >> 11, which = (idx >> 10) & 1, col = idx & 1023, mi = which ? scale_idx : shift_idx;
            if (row_begin >= NLAT && cond != 2) continue;
            f32x4 v;
            if (FROM_PART) { v = *(const f32x4*)(ada_b + mi * D + col);
#pragma unroll
                for (int s = 0; s < 16; ++s) v += *(const f32x4*)(part + (size_t)(s * 3 + cond) * NMODS + mi * D + col); }
            else v = *(const f32x4*)(mods + cond * NMODS + mi * D + col);
            *(LAS f32x4*)(tab + idx) = v;
        }
        __syncthreads();
    }
    f32x4 wv[4];
#pragma unroll
    for (int j = 0; j < 4; ++j) wv[j] = *((const f32x4*)nw + 64 * j + lane);
    for (int row = row_begin + gw; row < nrows; row += 2 * NGW) {
        const int row2 = row + NGW; const bool has2 = row2 < nrows; const int r2 = has2 ? row2 : row;
        const float* xr = row < NLAT ? src_lat + (size_t)row * D : src_ctx + (size_t)(row - NLAT) * D;
        const float* xr2 = r2 < NLAT ? src_lat + (size_t)r2 * D : src_ctx + (size_t)(r2 - NLAT) * D;
        f32x4 v[2][4]; float s[2] = {0.f, 0.f};
#pragma unroll
        for (int j = 0; j < 4; ++j) { v[0][j] = __builtin_nontemporal_load((const f32x4*)xr + 64 * j + lane); v[1][j] = __builtin_nontemporal_load((const f32x4*)xr2 + 64 * j + lane); }
        if (slabs) {
#pragma unroll
            for (int q = 0; q < 2; ++q) { const size_t ro = (size_t)((q ? r2 : row) - NLAT) * D;
#pragma unroll
                for (int j = 0; j < 4; ++j)
#pragma unroll
                    for (int pt = 0; pt < 3; ++pt) v[q][j] += *((const f32x4*)(slabs + (size_t)pt * NCTX * D + ro) + 64 * j + lane); }
        }
#pragma unroll
        for (int q = 0; q < 2; ++q)
#pragma unroll
            for (int j = 0; j < 4; ++j) s[q] += (v[q][j].x * v[q][j].x + v[q][j].y * v[q][j].y) + (v[q][j].z * v[q][j].z + v[q][j].w * v[q][j].w);
#pragma unroll
        for (int q = 0; q < 2; ++q) {
            if (q == 1 && !has2) break;
            const int rr = q ? row2 : row;
            const float rstd = 1.0f / sqrtf(wave_sum(s[q]) * (1.0f / D) + EPS);
            if (FINAL) {
#pragma unroll
                for (int j = 0; j < 4; ++j) *((f32x4*)(outf + (size_t)rr * D) + 64 * j + lane) = v[q][j] * rstd * wv[j];
            } else {
                const int cond = rr < 8192 ? 0 : (rr < NLAT ? 1 : 2);
#pragma unroll
                for (int j = 0; j < 4; ++j) {
                    const f32x4 sh = *((const LAS f32x4*)(tab + (cond * 2 + 0) * 1024) + 64 * j + lane), scl = *((const LAS f32x4*)(tab + (cond * 2 + 1) * 1024) + 64 * j + lane);
                    const f32x4 hh = v[q][j] * rstd * wv[j] * (scl + 1.0f) + sh;
                    u32x2 o; o.x = pk2(hh.x, hh.y); o.y = pk2(hh.z, hh.w);
                    *((u32x2*)(H + (size_t)rr * D) + 64 * j + lane) = o;
                }
            }
        }
    }
}

__device__ __forceinline__ bf16x8 mk8(u32x2 lo, u32x2 hi) { u32x4 t; t.x = lo.x; t.y = lo.y; t.z = hi.x; t.w = hi.y; return __builtin_bit_cast(bf16x8, t); }
__device__ __forceinline__ bf16x8 row_frag(const LAS unsigned char* img, int pitch, int r0, int k0, int fr, int fq) { return *(const LAS bf16x8*)(img + (r0 + fr) * pitch + (k0 + 8 * fq) * 2); }
__device__ __forceinline__ void tr1(unsigned a0, unsigned a1, bf16x8& o) {
    u32x2 l0, h0;
    asm volatile("ds_read_b64_tr_b16 %0, %2\n\tds_read_b64_tr_b16 %1, %3\n\ts_waitcnt lgkmcnt(0)" : "=&v"(l0), "=&v"(h0) : "v"(a0), "v"(a1) : "memory");
    o = mk8(l0, h0);
}
__device__ __forceinline__ void tr2(unsigned a0, unsigned a1, bf16x8 (&o)[2]) {
    u32x2 l0, l1, h0, h1;
    asm volatile("ds_read_b64_tr_b16 %0, %4\n\tds_read_b64_tr_b16 %1, %4 offset:32\n\tds_read_b64_tr_b16 %2, %5\n\tds_read_b64_tr_b16 %3, %5 offset:32\n\ts_waitcnt lgkmcnt(0)"
                 : "=&v"(l0), "=&v"(l1), "=&v"(h0), "=&v"(h1) : "v"(a0), "v"(a1) : "memory");
    o[0] = mk8(l0, h0); o[1] = mk8(l1, h1);
}
__device__ __forceinline__ void tr4(unsigned a0, unsigned a1, bf16x8 (&o)[4]) {
    u32x2 l0, l1, l2, l3, h0, h1, h2, h3;
    asm volatile("ds_read_b64_tr_b16 %0, %8\n\tds_read_b64_tr_b16 %1, %8 offset:32\n\tds_read_b64_tr_b16 %2, %8 offset:64\n\tds_read_b64_tr_b16 %3, %8 offset:96\n\t"
                 "ds_read_b64_tr_b16 %4, %9\n\tds_read_b64_tr_b16 %5, %9 offset:32\n\tds_read_b64_tr_b16 %6, %9 offset:64\n\tds_read_b64_tr_b16 %7, %9 offset:96\n\ts_waitcnt lgkmcnt(0)"
                 : "=&v"(l0), "=&v"(l1), "=&v"(l2), "=&v"(l3), "=&v"(h0), "=&v"(h1), "=&v"(h2), "=&v"(h3) : "v"(a0), "v"(a1) : "memory");
    o[0] = mk8(l0, h0); o[1] = mk8(l1, h1); o[2] = mk8(l2, h2); o[3] = mk8(l3, h3);
}
__device__ __forceinline__ void tr8(unsigned a0, unsigned a1, bf16x8 (&o)[8]) {
    u32x2 l0, l1, l2, l3, l4, l5, l6, l7, h0, h1, h2, h3, h4, h5, h6, h7;
    asm volatile("ds_read_b64_tr_b16 %0, %16\n\tds_read_b64_tr_b16 %1, %16 offset:32\n\tds_read_b64_tr_b16 %2, %16 offset:64\n\tds_read_b64_tr_b16 %3, %16 offset:96\n\t"
                 "ds_read_b64_tr_b16 %4, %16 offset:128\n\tds_read_b64_tr_b16 %5, %16 offset:160\n\tds_read_b64_tr_b16 %6, %16 offset:192\n\tds_read_b64_tr_b16 %7, %16 offset:224\n\t"
                 "ds_read_b64_tr_b16 %8, %17\n\tds_read_b64_tr_b16 %9, %17 offset:32\n\tds_read_b64_tr_b16 %10, %17 offset:64\n\tds_read_b64_tr_b16 %11, %17 offset:96\n\t"
                 "ds_read_b64_tr_b16 %12, %17 offset:128\n\tds_read_b64_tr_b16 %13, %17 offset:160\n\tds_read_b64_tr_b16 %14, %17 offset:192\n\tds_read_b64_tr_b16 %15, %17 offset:224\n\ts_waitcnt lgkmcnt(0)"
                 : "=&v"(l0), "=&v"(l1), "=&v"(l2), "=&v"(l3), "=&v"(l4), "=&v"(l5), "=&v"(l6), "=&v"(l7), "=&v"(h0), "=&v"(h1), "=&v"(h2), "=&v"(h3), "=&v"(h4), "=&v"(h5), "=&v"(h6), "=&v"(h7)
                 : "v"(a0), "v"(a1) : "memory");
    o[0] = mk8(l0, h0); o[1] = mk8(l1, h1); o[2] = mk8(l2, h2); o[3] = mk8(l3, h3); o[4] = mk8(l4, h4); o[5] = mk8(l5, h5); o[6] = mk8(l6, h6); o[7] = mk8(l7, h7);
}
#define MFMA16(a, b, c) __builtin_amdgcn_mfma_f32_16x16x32_bf16((a), (b), (c), 0, 0, 0)

constexpr int PT128 = 288;
constexpr int PT64 = 160;
constexpr int IMG128 = 128 * PT128;
constexpr int IMG64 = 128 * PT64;

__device__ __forceinline__ float logsig(float z) { return fminf(z, 0.f) - __logf(1.0f + __expf(-fabsf(z))); }
__device__ __forceinline__ u32x4 scale8(u32x4 v, float s) {
    u32x4 o;
    o.x = cvtpk(bflo(v.x) * s, bfhi(v.x) * s); o.y = cvtpk(bflo(v.y) * s, bfhi(v.y) * s);
    o.z = cvtpk(bflo(v.z) * s, bfhi(v.z) * s); o.w = cvtpk(bflo(v.w) * s, bfhi(v.w) * s);
    return o;
}
__device__ __forceinline__ void stage128(LAS unsigned char* img, const bf16_t* src, int tid) {
#pragma unroll
    for (int i = 0; i < 4; ++i) { const int v = tid + NTHREADS * i, tok = v >> 4, ch = v & 15;
        *(LAS u32x4*)(img + tok * PT128 + ch * 16) = *(const u32x4*)(src + (size_t)tok * PP + ch * 8); }
}

__device__ __forceinline__ void p6_ret_item(LAS unsigned char* lds, const bf16_t* P, bf16_t* SR, const float* dec_f, const float* dec_b, int item, int tid, int wave, int lane) {
    asm volatile("" : "+v"(tid), "+v"(lane));
    const int tc = item % 66, bh = item / 66, h = bh & 3, b = bh >> 2;
    const int row0 = tc < 2 ? (NLAT + b * 256 + tc * 128) : (b * 8192 + (tc - 2) * 128);
    const float lgf = -log1pf(expf(-dec_f[h])), lgb = -log1pf(expf(-dec_b[h]));
    LAS unsigned char* KF = lds; LAS unsigned char* KB = lds + IMG128; LAS unsigned char* V = lds + 2 * IMG128;
    for (int rep1 = 0; rep1 < (PROBE == 19 ? 2 : 1); ++rep1) {
    u32x4 kvr[4], vvr[4];
#pragma unroll
    for (int i = 0; i < 4; ++i) { const int v = tid + NTHREADS * i, tok = v >> 4, ch = v & 15;
        const bf16_t* prow = P + (size_t)(row0 + tok) * PP + h * 128 + ch * 8;
        kvr[i] = *(const u32x4*)(prow + 512); vvr[i] = *(const u32x4*)(prow + 1024); }
#pragma unroll
    for (int i = 0; i < 4; ++i) { const int v = tid + NTHREADS * i, tok = v >> 4, ch = v & 15;
        const float sf = __expf((float)(127 - tok) * lgf), sb = __expf((float)tok * lgb);
        *(LAS u32x4*)(KF + tok * PT128 + ch * 16) = scale8(kvr[i], sf);
        *(LAS u32x4*)(KB + tok * PT128 + ch * 16) = scale8(kvr[i], sb);
        *(LAS u32x4*)(V + tok * PT128 + ch * 16) = vvr[i]; }
    __syncthreads();
    }
    const int g = lane >> 4, q = (lane & 15) >> 2, p = lane & 3, fr = lane & 15, fq = g;
    const int rb = wave >> 1, cb = wave & 1;
    const unsigned base = (unsigned)(size_t)lds;
    f32x4 af[2][4], ab[2][4];
#pragma unroll
    for (int x = 0; x < 2; ++x)
#pragma unroll
        for (int y = 0; y < 4; ++y) { af[x][y] = (f32x4){0.f, 0.f, 0.f, 0.f}; ab[x][y] = (f32x4){0.f, 0.f, 0.f, 0.f}; }
    for (int rep2 = 0; rep2 < (PROBE == 20 ? 2 : 1); ++rep2)
#pragma unroll
    for (int ks = 0; ks < 4; ++ks) {
        const unsigned rofs = (unsigned)((32 * ks + 8 * g + q) * PT128 + 8 * p);
        bf16x8 vf[4], kf[2], kb[2];
        tr4(base + 2 * IMG128 + rofs + 128 * cb, base + 2 * IMG128 + rofs + 128 * cb + 4 * PT128, vf);
        tr2(base + rofs + 64 * rb, base + rofs + 64 * rb + 4 * PT128, kf);
        tr2(base + IMG128 + rofs + 64 * rb, base + IMG128 + rofs + 64 * rb + 4 * PT128, kb);
#pragma unroll
        for (int x = 0; x < 2; ++x)
#pragma unroll
            for (int y = 0; y < 4; ++y) { af[x][y] = MFMA16(kf[x], vf[y], af[x][y]); ab[x][y] = MFMA16(kb[x], vf[y], ab[x][y]); }
    }
    if (PROBE == 20) {
#pragma unroll
        for (int x = 0; x < 2; ++x)
#pragma unroll
            for (int y = 0; y < 4; ++y) { af[x][y] *= 0.5f; ab[x][y] *= 0.5f; } }
    bf16_t* Uf = SR + ((size_t)((0 * 2 + b) * 4 + h) * 66 + tc) * 16384;
    bf16_t* Ub = SR + ((size_t)((1 * 2 + b) * 4 + h) * 66 + tc) * 16384;
    for (int rep3 = 0; rep3 < (PROBE == 21 ? 2 : 1); ++rep3)
#pragma unroll
    for (int x = 0; x < 2; ++x)
#pragma unroll
        for (int y = 0; y < 4; ++y) {
            const int dk = 32 * rb + 16 * x + 4 * fq, dv = 64 * cb + 16 * y + fr;
#ifdef TEST_CLAMP
#pragma unroll
            for (int e = 0; e < 4; ++e) { af[x][y][e] = fminf(fmaxf(af[x][y][e], -1e4f), 1e4f); ab[x][y][e] = fminf(fmaxf(ab[x][y][e], -1e4f), 1e4f); }
#endif
            u32x2 o; o.x = pk2(af[x][y][0], af[x][y][1]); o.y = pk2(af[x][y][2], af[x][y][3]);
            *(u32x2*)(Uf + dv * 128 + dk) = o;
            o.x = pk2(ab[x][y][0], ab[x][y][1]); o.y = pk2(ab[x][y][2], ab[x][y][3]);
            *(u32x2*)(Ub + dv * 128 + dk) = o;
        }
    __syncthreads();
}

constexpr int LRS_OFF = 122880;
__device__ __forceinline__ void gla_gates(LAS unsigned char* lds, LAS float* tot, const float* LR, const float* wf, const float* bfv, const float* wb, const float* bbv, int row0, int h, int tid, int wave,
                                          float (&bf)[16], float (&bb)[16], float& totf, float& totb) {
    const int d = tid & 63, col = h * 64 + d;
    LAS float* lrs = (LAS float*)(lds + LRS_OFF);
    { const f32x4* srcv = (const f32x4*)(LR + (size_t)row0 * 32); const f32x4 v0 = srcv[tid], v1 = srcv[tid + NTHREADS]; *((LAS f32x4*)lrs + tid) = v0; *((LAS f32x4*)lrs + tid + NTHREADS) = v1; }
    f32x2 wf2[8], wb2[8];
#pragma unroll
    for (int r = 0; r < 8; ++r) { wf2[r] = (f32x2){wf[(2 * r) * 256 + col], wf[(2 * r + 1) * 256 + col]}; wb2[r] = (f32x2){wb[(2 * r) * 256 + col], wb[(2 * r + 1) * 256 + col]}; }
    const float biasf = bfv[col], biasb = bbv[col];
    __syncthreads();
#pragma unroll
    for (int t = 0; t < 16; ++t) {
        const LAS float* lr = lrs + (16 * wave + t) * 32;
        f32x2 zf = (f32x2){biasf, 0.f}, zb = (f32x2){biasb, 0.f};
#pragma unroll
        for (int r4 = 0; r4 < 4; ++r4) { const f32x4 a = *(const LAS f32x4*)(lr + 4 * r4), c = *(const LAS f32x4*)(lr + 16 + 4 * r4);
            zf = __builtin_elementwise_fma((f32x2){a.x, a.y}, wf2[2 * r4], zf); zf = __builtin_elementwise_fma((f32x2){a.z, a.w}, wf2[2 * r4 + 1], zf);
            zb = __builtin_elementwise_fma((f32x2){c.x, c.y}, wb2[2 * r4], zb); zb = __builtin_elementwise_fma((f32x2){c.z, c.w}, wb2[2 * r4 + 1], zb); }
        bf[t] = logsig(zf.x + zf.y) * (1.0f / 16.0f); bb[t] = logsig(zb.x + zb.y) * (1.0f / 16.0f);
    }
#pragma unroll
    for (int t = 1; t < 16; ++t) bf[t] += bf[t - 1];
#pragma unroll
    for (int t = 14; t >= 0; --t) bb[t] += bb[t + 1];
    tot[wave * 64 + d] = bf[15]; tot[512 + wave * 64 + d] = bb[0];
    __syncthreads();
    const int sub = wave >> 2, gi = wave & 3;
    float pf = 0.f, sb = 0.f; totf = 0.f; totb = 0.f;
#pragma unroll
    for (int g2 = 0; g2 < 4; ++g2) { const float a = tot[(sub * 4 + g2) * 64 + d], c = tot[512 + (sub * 4 + g2) * 64 + d]; totf += a; totb += c; if (g2 < gi) pf += a; if (g2 > gi) sb += c; }
#pragma unroll
    for (int t = 0; t < 16; ++t) { bf[t] += pf; bb[t] += sb; }
}

__device__ __forceinline__ void p6_gla_item(LAS unsigned char* lds, const bf16_t* P, const float* LR, bf16_t* SG, float* DG, const float* wf, const float* bfv, const float* wb, const float* bbv,
                                            int item, int tid, int wave, int lane, float* CB) {
    asm volatile("" : "+v"(tid), "+v"(lane));
    const int tc = item % 66, bh = item / 66, h = bh & 3, b = bh >> 2;
    const int row0 = tc < 2 ? (NLAT + b * 256 + tc * 128) : (b * 8192 + (tc - 2) * 128);
    LAS unsigned char* KF = lds; LAS unsigned char* KB = lds + IMG64; LAS unsigned char* V = lds + 2 * IMG64; LAS float* tot = (LAS float*)(lds + 2 * IMG64 + IMG128);
    stage128(V, P + (size_t)row0 * PP + 2560 + h * 128, tid);
    const int d = tid & 63, sub = wave >> 2;
    bf16_t kraw[16];
#pragma unroll
    for (int t = 0; t < 16; ++t) kraw[t] = P[(size_t)(row0 + 16 * wave + t) * PP + 2304 + h * 64 + d];
    float bf[16], bb[16], totf, totb;
    gla_gates(lds, tot, LR, wf, bfv, wb, bbv, row0, h, tid, wave, bf, bb, totf, totb);
    const int chf = (0 * 2 + b) * 4 + h, chb = (1 * 2 + b) * 4 + h, tc64 = 2 * tc + sub;
    if (tc >= 2) {
#pragma unroll
        for (int t = 0; t < 16; ++t) { const size_t o = (size_t)(row0 + 16 * wave + t) * 256 + h * 64 + d; CB[o] = bf[t]; CB[(size_t)NLAT * 256 + o] = bb[t]; }
    }
#pragma unroll
    for (int t = 0; t < 16; ++t) {
        const int tok = 16 * wave + t;
        const float kv = bf2f(kraw[t]);
        *(LAS bf16_t*)(KF + tok * PT64 + d * 2) = (bf16_t)cvtpk(kv * __expf(totf - bf[t]), 0.f);
        *(LAS bf16_t*)(KB + tok * PT64 + d * 2) = (bf16_t)cvtpk(kv * __expf(totb - bb[t]), 0.f);
    }
    if ((wave & 3) == 0) { DG[((size_t)chf * 132 + tc64) * 64 + d] = __expf(totf); DG[((size_t)chb * 132 + tc64) * 64 + d] = __expf(totb); }
    __syncthreads();
    const int g = lane >> 4, q = (lane & 15) >> 2, p = lane & 3, fr = lane & 15, fq = g, wl = wave & 3;
    const unsigned base = (unsigned)(size_t)lds;
    f32x4 af[8], ab[8];
#pragma unroll
    for (int y = 0; y < 8; ++y) { af[y] = (f32x4){0.f, 0.f, 0.f, 0.f}; ab[y] = (f32x4){0.f, 0.f, 0.f, 0.f}; }
#pragma unroll
    for (int ks = 0; ks < 2; ++ks) {
        const int r = sub * 64 + 32 * ks + 8 * g + q;
        bf16x8 vf[8], xf, xb;
        tr8(base + 2 * IMG64 + r * PT128 + 8 * p, base + 2 * IMG64 + (r + 4) * PT128 + 8 * p, vf);
        tr1(base + r * PT64 + 32 * wl + 8 * p, base + (r + 4) * PT64 + 32 * wl + 8 * p, xf);
        tr1(base + IMG64 + r * PT64 + 32 * wl + 8 * p, base + IMG64 + (r + 4) * PT64 + 32 * wl + 8 * p, xb);
#pragma unroll
        for (int y = 0; y < 8; ++y) { af[y] = MFMA16(xf, vf[y], af[y]); ab[y] = MFMA16(xb, vf[y], ab[y]); }
    }
    bf16_t* Uf = SG + ((size_t)chf * 132 + tc64) * 8192;
    bf16_t* Ub = SG + ((size_t)chb * 132 + tc64) * 8192;
#pragma unroll
    for (int y = 0; y < 8; ++y) {
        const int dk = 16 * wl + 4 * fq, dv = 16 * y + fr;
        u32x2 o; o.x = pk2(af[y][0], af[y][1]); o.y = pk2(af[y][2], af[y][3]);
        *(u32x2*)(Uf + dv * 64 + dk) = o;
        o.x = pk2(ab[y][0], ab[y][1]); o.y = pk2(ab[y][2], ab[y][3]);
        *(u32x2*)(Ub + dv * 64 + dk) = o;
    }
    __syncthreads();
}

__device__ __forceinline__ void p7_scan(bf16_t* SR, bf16_t* SG, const float* DG, const float* dec_f, const float* dec_b, int gtid, int gthreads) {
    for (int task = gtid; task < 65536 + 32768; task += gthreads) {
        if (task < 65536) {
            const int chain = task >> 12, e4 = task & 4095, dir = chain >> 3, h = chain & 3;
            const float lg = -log1pf(expf(-(dir ? dec_b[h] : dec_f[h])));
            const float dec = expf(128.0f * lg);
            bf16_t* basep = SR + (size_t)chain * 66 * 16384 + e4 * 4;
            f32x4 s = (f32x4){0.f, 0.f, 0.f, 0.f};
            for (int n0 = 0; n0 < 66; n0 += 11) {
                u32x2 u[11];
#pragma unroll
                for (int i = 0; i < 11; ++i) { const int n = n0 + i; const int tc = dir ? (n < 2 ? 1 - n : 67 - n) : n; u[i] = __builtin_nontemporal_load((const u32x2*)(basep + (size_t)tc * 16384)); }
#pragma unroll
                for (int i = 0; i < 11; ++i) { const int n = n0 + i; const int tc = dir ? (n < 2 ? 1 - n : 67 - n) : n;
                    u32x2 o; o.x = pk2(s.x, s.y); o.y = pk2(s.z, s.w);
                    *(u32x2*)(basep + (size_t)tc * 16384) = o;
                    s.x = dec * s.x + bflo(u[i].x); s.y = dec * s.y + bfhi(u[i].x); s.z = dec * s.z + bflo(u[i].y); s.w = dec * s.w + bfhi(u[i].y); }
            }
        } else {
            const int t2 = task - 65536, chain = t2 >> 11, e4 = t2 & 2047, dir = chain >> 3, dk0 = (e4 * 4) & 63;
            bf16_t* basep = SG + (size_t)chain * 132 * 8192 + e4 * 4;
            const float* dgp = DG + (size_t)chain * 132 * 64 + dk0;
            f32x4 s = (f32x4){0.f, 0.f, 0.f, 0.f};
            for (int n0 = 0; n0 < 132; n0 += 11) {
                u32x2 u[11]; f32x4 dc[11];
#pragma unroll
                for (int i = 0; i < 11; ++i) { const int n = n0 + i; const int tc = dir ? (n < 4 ? 3 - n : 135 - n) : n; u[i] = __builtin_nontemporal_load((const u32x2*)(basep + (size_t)tc * 8192)); dc[i] = *(const f32x4*)(dgp + tc * 64); }
#pragma unroll
                for (int i = 0; i < 11; ++i) { const int n = n0 + i; const int tc = dir ? (n < 4 ? 3 - n : 135 - n) : n;
                    u32x2 o; o.x = pk2(s.x, s.y); o.y = pk2(s.z, s.w);
                    *(u32x2*)(basep + (size_t)tc * 8192) = o;
                    s.x = dc[i].x * s.x + bflo(u[i].x); s.y = dc[i].y * s.y + bfhi(u[i].x); s.z = dc[i].z * s.z + bflo(u[i].y); s.w = dc[i].w * s.w + bfhi(u[i].y); }
            }
        }
    }
}

__device__ __forceinline__ void p8_ret_item(LAS unsigned char* lds, const bf16_t* P, const bf16_t* SR, bf16_t* Hm, const float* dec_f, const float* dec_b, const float* normw,
                                            int item, int tid, int wave, int lane) {
    asm volatile("" : "+v"(tid), "+v"(lane));
    const int c = item & 63, bh = item >> 6, h = bh & 3, b = bh >> 2;
    const int row0 = b * 8192 + c * 128, tc = c + 2;
    const float lgf = -log1pf(expf(-dec_f[h])), lgb = -log1pf(expf(-dec_b[h]));
    LAS unsigned char* Q = lds; LAS unsigned char* K = lds + IMG128; LAS unsigned char* V = lds + 2 * IMG128;
    stage128(Q, P + (size_t)row0 * PP + h * 128, tid);
    stage128(K, P + (size_t)row0 * PP + 512 + h * 128, tid);
    stage128(V, P + (size_t)row0 * PP + 1024 + h * 128, tid);
    const bf16_t* Sf = SR + ((size_t)((0 * 2 + b) * 4 + h) * 66 + tc) * 16384;
    const bf16_t* Sb = SR + ((size_t)((1 * 2 + b) * 4 + h) * 66 + tc) * 16384;
    u32x4 sfr[4], sbr[4];
#pragma unroll
    for (int i = 0; i < 4; ++i) { sfr[i] = *(const u32x4*)(Sf + (size_t)(tid + NTHREADS * i) * 8); sbr[i] = *(const u32x4*)(Sb + (size_t)(tid + NTHREADS * i) * 8); }
    __syncthreads();
    const int g = lane >> 4, q = (lane & 15) >> 2, p = lane & 3, fr = lane & 15, fq = g;
    const int i0 = 16 * wave;
    const unsigned base = (unsigned)(size_t)lds;
    bf16x8 qf[4];
#pragma unroll
    for (int ks = 0; ks < 4; ++ks) qf[ks] = row_frag(Q, PT128, i0, 32 * ks, fr, fq);
    u32x2 scp[8];
#pragma unroll
    for (int jb = 0; jb < 8; ++jb) {
        f32x4 a = (f32x4){0.f, 0.f, 0.f, 0.f};
#pragma unroll
        for (int ks = 0; ks < 4; ++ks) a = MFMA16(row_frag(K, PT128, 16 * jb, 32 * ks, fr, fq), qf[ks], a);
        const int i = i0 + fr;
#pragma unroll
        for (int e = 0; e < 4; ++e) { const float dd = (float)(i - (16 * jb + 4 * fq + e)); const float dcy = __expf(fmaxf(dd, 0.f) * lgf + fmaxf(-dd, 0.f) * lgb) * (2.0f - fminf(fabsf(dd), 1.0f)); a[e] *= dcy; }
        scp[jb].x = pg8::cvt_pk_bf16(a[0], a[1]); scp[jb].y = pg8::cvt_pk_bf16(a[2], a[3]);
        asm volatile("" ::: "memory");
    }
    f32x4 ao[8];
#pragma unroll
    for (int y = 0; y < 8; ++y) ao[y] = (f32x4){0.f, 0.f, 0.f, 0.f};
#pragma unroll
    for (int s2 = 0; s2 < 4; ++s2) {
        const bf16x8 xs = mk8(scp[2 * s2], scp[2 * s2 + 1]);
        const int r = 32 * s2 + 4 * g + q;
        bf16x8 vf[8];
        tr8(base + 2 * IMG128 + r * PT128 + 8 * p, base + 2 * IMG128 + (r + 16) * PT128 + 8 * p, vf);
#pragma unroll
        for (int y = 0; y < 8; ++y) ao[y] = MFMA16(vf[y], xs, ao[y]);
    }
    __syncthreads();
#pragma unroll
    for (int i = 0; i < 4; ++i) { const int v = tid + NTHREADS * i, dv = v >> 4, ch = v & 15;
        *(LAS u32x4*)(Q + dv * PT128 + ch * 16) = sfr[i]; *(LAS u32x4*)(K + dv * PT128 + ch * 16) = sbr[i]; }
    __syncthreads();
    const float qsf = __expf((float)(i0 + fr + 1) * lgf), qsb = __expf((float)(128 - i0 - fr) * lgb);
#pragma unroll
    for (int ks = 0; ks < 4; ++ks) {
        const bf16x8 xf = __builtin_bit_cast(bf16x8, scale8(__builtin_bit_cast(u32x4, qf[ks]), qsf)), xb = __builtin_bit_cast(bf16x8, scale8(__builtin_bit_cast(u32x4, qf[ks]), qsb));
#pragma unroll
        for (int y = 0; y < 8; ++y) ao[y] = MFMA16(row_frag(Q, PT128, 16 * y, 32 * ks, fr, fq), xf, ao[y]);
#pragma unroll
        for (int y = 0; y < 8; ++y) ao[y] = MFMA16(row_frag(K, PT128, 16 * y, 32 * ks, fr, fq), xb, ao[y]);
        asm volatile("" ::: "memory");
    }
    float s1 = 0.f, sq = 0.f;
#pragma unroll
    for (int y = 0; y < 8; ++y) s1 += (ao[y][0] + ao[y][1]) + (ao[y][2] + ao[y][3]);
    s1 += __shfl_xor(s1, 16); s1 += __shfl_xor(s1, 32);
    const float mu = s1 * (1.0f / 128.0f);
#pragma unroll
    for (int y = 0; y < 8; ++y)
#pragma unroll
        for (int e = 0; e < 4; ++e) { const float dlt = ao[y][e] - mu; sq += dlt * dlt; }
    sq += __shfl_xor(sq, 16); sq += __shfl_xor(sq, 32);
    const float rstd = 1.0f / sqrtf(sq * (1.0f / 128.0f) + EPS);
    const int row = row0 + i0 + fr;
    const bf16_t* gp = P + (size_t)row * PP + 1536 + h * 128 + 4 * fq;
    bf16_t* op = Hm + (size_t)row * D + h * 128 + 4 * fq;
    const float* wp = normw + h * 128 + 4 * fq;
#pragma unroll
    for (int y = 0; y < 8; ++y) {
        const u32x2 gt = *(const u32x2*)(gp + 16 * y); const f32x4 w = *(const f32x4*)(wp + 16 * y);
        u32x2 o;
        o.x = pk2((ao[y][0] - mu) * rstd * w.x * bflo(gt.x), (ao[y][1] - mu) * rstd * w.y * bfhi(gt.x));
        o.y = pk2((ao[y][2] - mu) * rstd * w.z * bflo(gt.y), (ao[y][3] - mu) * rstd * w.w * bfhi(gt.y));
        *(u32x2*)(op + 16 * y) = o;
    }
    __syncthreads();
}

__device__ __forceinline__ void p8_gla_item(LAS unsigned char* lds, const bf16_t* P, const float* LR, const bf16_t* SG, bf16_t* Hm, const float* wf, const float* bfv, const float* wb, const float* bbv,
                                            const float* normw, int item, int tid, int wave, int lane, const float* CB) {
    asm volatile("" : "+v"(tid), "+v"(lane));
    const int c = item & 63, bh = item >> 6, h = bh & 3, b = bh >> 2;
    const int row0 = b * 8192 + c * 128;
    LAS unsigned char* QF = lds; LAS unsigned char* KF = lds + IMG64; LAS unsigned char* QB = lds + 2 * IMG64; LAS unsigned char* KB = lds + 3 * IMG64; LAS unsigned char* V = lds + 4 * IMG64;
    LAS float* tot = (LAS float*)(lds + 4 * IMG64 + IMG128);
    stage128(V, P + (size_t)row0 * PP + 2560 + h * 128, tid);
    const bf16_t* Sf = SG + ((size_t)((0 * 2 + b) * 4 + h) * 132 + 4 + 2 * c) * 8192;
    const bf16_t* Sb = SG + ((size_t)((1 * 2 + b) * 4 + h) * 132 + 4 + 2 * c) * 8192;
    u32x4 sfr[4], sbr[4];
#pragma unroll
    for (int i = 0; i < 4; ++i) { sfr[i] = *(const u32x4*)(Sf + (size_t)(tid + NTHREADS * i) * 8); sbr[i] = *(const u32x4*)(Sb + (size_t)(tid + NTHREADS * i) * 8); }
    const int d = tid & 63, sub = wave >> 2, wl = wave & 3;
    bf16_t qraw[16], kraw[16];
#pragma unroll
    for (int t = 0; t < 16; ++t) { const bf16_t* pr = P + (size_t)(row0 + 16 * wave + t) * PP + h * 64 + d; qraw[t] = pr[2048]; kraw[t] = pr[2304]; }
    float bf[16], bb[16];
#pragma unroll
    for (int t = 0; t < 16; ++t) { const size_t o = (size_t)(row0 + 16 * wave + t) * 256 + h * 64 + d; bf[t] = CB[o]; bb[t] = CB[(size_t)NLAT * 256 + o]; }
#pragma unroll
    for (int t = 0; t < 16; ++t) {
        const int tok = 16 * wave + t;
        const float qv = bf2f(qraw[t]), kv = bf2f(kraw[t]);
        const float ef = __expf(bf[t]), eb = __expf(bb[t]);
        *(LAS bf16_t*)(QF + tok * PT64 + d * 2) = (bf16_t)cvtpk(qv * ef, 0.f);
        *(LAS bf16_t*)(KF + tok * PT64 + d * 2) = (bf16_t)cvtpk(kv * __builtin_amdgcn_rcpf(ef), 0.f);
        *(LAS bf16_t*)(QB + tok * PT64 + d * 2) = (bf16_t)cvtpk(qv * eb, 0.f);
        *(LAS bf16_t*)(KB + tok * PT64 + d * 2) = (bf16_t)cvtpk(kv * __builtin_amdgcn_rcpf(eb), 0.f);
    }
    __syncthreads();
    const int g = lane >> 4, q = (lane & 15) >> 2, p = lane & 3, fr = lane & 15, fq = g;
    const int i0 = sub * 64 + 16 * wl;
    const unsigned base = (unsigned)(size_t)lds;
    bf16x8 qff[2], qbf[2];
#pragma unroll
    for (int ks = 0; ks < 2; ++ks) { qff[ks] = row_frag(QF, PT64, i0, 32 * ks, fr, fq); qbf[ks] = row_frag(QB, PT64, i0, 32 * ks, fr, fq); }
    u32x2 scp[4];
#pragma unroll
    for (int jb = 0; jb < 4; ++jb) {
        f32x4 a = (f32x4){0.f, 0.f, 0.f, 0.f}, a2 = (f32x4){0.f, 0.f, 0.f, 0.f};
#pragma unroll
        for (int ks = 0; ks < 2; ++ks) { a = MFMA16(row_frag(KF, PT64, sub * 64 + 16 * jb, 32 * ks, fr, fq), qff[ks], a); a2 = MFMA16(row_frag(KB, PT64, sub * 64 + 16 * jb, 32 * ks, fr, fq), qbf[ks], a2); }
        const int il = 16 * wl + fr;
        float v[4];
#pragma unroll
        for (int e = 0; e < 4; ++e) { const float dd = (float)(il - (16 * jb + 4 * fq + e)); v[e] = a[e] * fminf(fmaxf(dd + 1.0f, 0.f), 1.0f) + a2[e] * fminf(fmaxf(1.0f - dd, 0.f), 1.0f); }
        scp[jb].x = pg8::cvt_pk_bf16(v[0], v[1]); scp[jb].y = pg8::cvt_pk_bf16(v[2], v[3]);
        asm volatile("" ::: "memory");
    }
    f32x4 ao[8];
#pragma unroll
    for (int y = 0; y < 8; ++y) ao[y] = (f32x4){0.f, 0.f, 0.f, 0.f};
#pragma unroll
    for (int s2 = 0; s2 < 2; ++s2) {
        const bf16x8 xs = mk8(scp[2 * s2], scp[2 * s2 + 1]);
        const int r = sub * 64 + 32 * s2 + 4 * g + q;
        bf16x8 vf[8];
        tr8(base + 4 * IMG64 + r * PT128 + 8 * p, base + 4 * IMG64 + (r + 16) * PT128 + 8 * p, vf);
#pragma unroll
        for (int y = 0; y < 8; ++y) ao[y] = MFMA16(vf[y], xs, ao[y]);
    }
    __syncthreads();
#pragma unroll
    for (int i = 0; i < 4; ++i) { const int v = tid + NTHREADS * i, m = v >> 10, dv = (v >> 3) & 127, ch = v & 7;
        *(LAS u32x4*)(lds + m * IMG64 + dv * PT64 + ch * 16) = sfr[i]; *(LAS u32x4*)(lds + (2 + m) * IMG64 + dv * PT64 + ch * 16) = sbr[i]; }
    __syncthreads();
    const LAS unsigned char* SFI = lds + sub * IMG64; const LAS unsigned char* SBI = lds + (2 + sub) * IMG64;
#pragma unroll
    for (int ks = 0; ks < 2; ++ks) {
#pragma unroll
        for (int y = 0; y < 8; ++y) ao[y] = MFMA16(row_frag(SFI, PT64, 16 * y, 32 * ks, fr, fq), qff[ks], ao[y]);
#pragma unroll
        for (int y = 0; y < 8; ++y) ao[y] = MFMA16(row_frag(SBI, PT64, 16 * y, 32 * ks, fr, fq), qbf[ks], ao[y]);
        asm volatile("" ::: "memory");
    }
    float ss = 0.f;
#pragma unroll
    for (int y = 0; y < 8; ++y)
#pragma unroll
        for (int e = 0; e < 4; ++e) ss += ao[y][e] * ao[y][e];
    ss += __shfl_xor(ss, 16); ss += __shfl_xor(ss, 32);
    const float rstd = 1.0f / sqrtf(ss * (1.0f / 128.0f) + EPS);
    const int row = row0 + i0 + fr;
    const bf16_t* gp = P + (size_t)row * PP + 3072 + h * 128 + 4 * fq;
    bf16_t* op = Hm + (size_t)row * D + 512 + h * 128 + 4 * fq;
    const float* wp = normw + h * 128 + 4 * fq;
#pragma unroll
    for (int y = 0; y < 8; ++y) {
        const u32x2 gt = *(const u32x2*)(gp + 16 * y); const f32x4 w = *(const f32x4*)(wp + 16 * y);
        u32x2 o;
        o.x = pk2(ao[y][0] * rstd * w.x * bflo(gt.x), ao[y][1] * rstd * w.y * bfhi(gt.x));
        o.y = pk2(ao[y][2] * rstd * w.z * bflo(gt.y), ao[y][3] * rstd * w.w * bfhi(gt.y));
        *(u32x2*)(op + 16 * y) = o;
    }
    __syncthreads();
}

#define XB_TMO      128
#define XB_XCNT(j)  (256  + 64 * (j))
#define XB_XSUB(j)  (1280 + 64 * (j))
#define XB_XGEN(j)  (2304 + 64 * (j))
#define XB_TOP      3328
#define XB_TOPGEN   3392
#define XCD_BAR_WORDS 3456
#define XB_SPIN_CAP (1u << 18)

__device__ __forceinline__ unsigned xb_ld(unsigned* p)              { return __hip_atomic_load(p, __ATOMIC_RELAXED, __HIP_MEMORY_SCOPE_AGENT); }
__device__ __forceinline__ unsigned xb_add(unsigned* p, unsigned v) { return __hip_atomic_fetch_add(p, v, __ATOMIC_RELAXED, __HIP_MEMORY_SCOPE_AGENT); }
__device__ __forceinline__ unsigned xb_xcc_id() { return (unsigned)__builtin_amdgcn_s_getreg((3 << 11) | 20) & 0xFu; }
#define XB_SPIN(cond, bar) do { unsigned _sp = 0; while (cond) { __builtin_amdgcn_s_sleep(1); \
    if ((++_sp & 255u) == 0u) { if (xb_ld(&(bar)[XB_TMO])) break; if (_sp > XB_SPIN_CAP) { atomicAdd(&(bar)[XB_TMO], 1u); break; } } } } while (0)

struct XcdBarrier {
    unsigned* bar; unsigned x;
    volatile LAS unsigned* st;
};

__device__ __forceinline__ XcdBarrier xcd_barrier_post(unsigned* bar, volatile LAS unsigned* st) {
    XcdBarrier b; b.bar = bar; b.x = xb_xcc_id(); b.st = st;
    if (threadIdx.x == 0) (void)xb_add(&bar[XB_XCNT(b.x)], 1u);
    return b;
}
__device__ __forceinline__ void xcd_barrier_complete(unsigned* bar, unsigned x, unsigned& nloc, unsigned& nx) {
    const unsigned G = gridDim.x * gridDim.y * gridDim.z;
    unsigned sum, cnt, mine, sp = 0u;
    for (;;) {
        sum = 0u; cnt = 0u; mine = 0u;
#pragma unroll
        for (unsigned j = 0; j < 16; ++j) { const unsigned c = xb_ld(&bar[XB_XCNT(j)]); sum += c; cnt += (c > 0u) ? 1u : 0u; mine = (j == x) ? c : mine; }
        if (sum == G) break;
        __builtin_amdgcn_s_sleep(1);
        if ((++sp & 255u) == 0u) { if (xb_ld(&bar[XB_TMO])) break; if (sp > XB_SPIN_CAP) { atomicAdd(&bar[XB_TMO], 1u); break; } }
    }
    nloc = mine > 0u ? mine : 1u; nx = cnt > 0u ? cnt : 1u;
}

__device__ __forceinline__ void xcd_barrier(const XcdBarrier& b) {
    asm volatile("s_waitcnt vmcnt(0)" ::: "memory");
    __syncthreads();
    if (threadIdx.x == 0) {
        unsigned* bar = b.bar;
        __builtin_amdgcn_s_waitcnt(0);
        unsigned nloc = b.st[0], nx = b.st[1];
        if (nloc == 0u) { xcd_barrier_complete(bar, b.x, nloc, nx); b.st[0] = nloc; b.st[1] = nx; }
        const unsigned old = xb_add(&bar[XB_XSUB(b.x)], 1u);
        const unsigned gen = old / nloc;
        if (old + 1u == (gen + 1u) * nloc) {
            __builtin_amdgcn_fence(__ATOMIC_RELEASE, "agent");
            asm volatile("s_waitcnt vmcnt(0)" ::: "memory");
            const unsigned og = xb_add(&bar[XB_TOP], 1u);
            const unsigned tg = og / nx;
            if (og + 1u == (tg + 1u) * nx) xb_add(&bar[XB_TOPGEN], 1u);
            else XB_SPIN(xb_ld(&bar[XB_TOPGEN]) == tg, bar);
            __builtin_amdgcn_fence(__ATOMIC_ACQUIRE, "agent");
            xb_add(&bar[XB_XGEN(b.x)], 1u);
            asm volatile("s_waitcnt vmcnt(0)" ::: "memory");
        } else {
            XB_SPIN(xb_ld(&bar[XB_XGEN(b.x)]) == gen, bar);
            __builtin_amdgcn_fence(__ATOMIC_ACQUIRE, "agent");
            asm volatile("s_waitcnt vmcnt(0)" ::: "memory");
        }
    }
    __syncthreads();
}


__device__ __attribute__((noinline)) void xcd_barrier_ool(unsigned* barp, unsigned x, volatile LAS unsigned* st) { XcdBarrier b; b.bar = barp; b.x = x; b.st = st; xcd_barrier(b); }

#ifndef PHM
#define PHM 0xffff
#endif
struct Args { const float* in[26]; float* out; unsigned char* ws; };
enum { I_X = 0, I_C, I_CTX, I_CCTX, I_ADAW, I_ADAB, I_N1W, I_F1W1, I_F1W3, I_F1W2, I_N2W, I_WIN, I_RDF, I_RDB, I_RNW, I_GWF, I_GBF, I_GWB, I_GBB, I_GNW, I_WOUT, I_N3W, I_F2W1, I_F2W3, I_F2W2, I_FNW };

#ifndef P6SKIP
#define P6SKIP 0
#endif
#ifndef PROBE
#define PROBE 0
#endif
#ifndef PHSKIP
#define PHSKIP 0
#endif
template <int ph> __device__ __forceinline__ void run_phase(LAS unsigned char* lds, const int G, const int NGW, const bool probe_dst = false) {
    if (PHSKIP & (1 << ph)) return;
        int tid = threadIdx.x; asm volatile("" : "+v"(tid));
        int bid = blockIdx.x; asm volatile("" : "+s"(bid));
        const int lane = tid & 63, wave = __builtin_amdgcn_readfirstlane(tid >> 6), gw = bid * 8 + wave;
        const __attribute__((address_space(4))) char* kargs = (const __attribute__((address_space(4))) char*)__builtin_amdgcn_kernarg_segment_ptr(); asm volatile("" : "+s"(kargs));
        unsigned char* ws = *(unsigned char* const __attribute__((address_space(4)))*)(kargs + 8 * 27);
        float* out = *(float* const __attribute__((address_space(4)))*)(kargs + 8 * 26);
#define INP(i) (*(const float* const __attribute__((address_space(4)))*)(kargs + 8 * (i)))
        float* part = (float*)(ws + WS_PART); float* mods = (float*)(ws + WS_MODS); float* LR = (float*)(ws + WS_LR); float* X1C = (float*)(ws + WS_X1C); float* DG = (float*)(ws + WS_DG);
        bf16_t* W13 = (bf16_t*)(ws + WS_W13); bf16_t* W2 = (bf16_t*)(ws + WS_W2); bf16_t* WIN = (bf16_t*)(ws + WS_WIN); bf16_t* WOUT = (bf16_t*)(ws + WS_WOUT);
        bf16_t* H = (bf16_t*)(ws + WS_H); bf16_t* GP = (bf16_t*)(ws + WS_GP); bf16_t* SR = (bf16_t*)(ws + WS_SR); bf16_t* SG = (bf16_t*)(ws + WS_SG);
        if (ph == 0 && (PHM & 1)) {
            LAS float* scv = (LAS float*)lds;
            LAS f32x4* red = (LAS f32x4*)(lds + 1024);
            for (int it = bid; it < 288; it += G) {
                const int s = it / 18, cc = it % 18;
                if (tid < 192) { const int cond = tid >> 6, k = s * 64 + (tid & 63); const float v = cond < 2 ? INP(I_C)[cond * D + k] : INP(I_CCTX)[k]; scv[tid] = v / (1.0f + expf(-v)); }
                __syncthreads();
                const int cg4 = tid & 127, ks = tid >> 7;
                f32x4 acc[3] = {(f32x4){0.f, 0.f, 0.f, 0.f}, (f32x4){0.f, 0.f, 0.f, 0.f}, (f32x4){0.f, 0.f, 0.f, 0.f}};
                const float* wp = INP(I_ADAW) + (size_t)(s * 64 + ks * 16) * NMODS + cc * 512 + cg4 * 4;
#pragma unroll
                for (int kk = 0; kk < 16; ++kk) { const f32x4 w = __builtin_nontemporal_load((const f32x4*)(wp + (size_t)kk * NMODS));
#pragma unroll
                    for (int cnd = 0; cnd < 3; ++cnd) acc[cnd] += w * scv[cnd * 64 + ks * 16 + kk]; }
#pragma unroll
                for (int cnd = 0; cnd < 3; ++cnd) red[(ks * 3 + cnd) * 128 + cg4] = acc[cnd];
                __syncthreads();
                if (tid < 384) { const int cnd = tid >> 7, g4 = tid & 127;
                    const f32x4 r = (red[(0 * 3 + cnd) * 128 + g4] + red[(1 * 3 + cnd) * 128 + g4]) + (red[(2 * 3 + cnd) * 128 + g4] + red[(3 * 3 + cnd) * 128 + g4]);
                    *(f32x4*)(part + (size_t)(s * 3 + cnd) * NMODS + cc * 512 + g4 * 4) = r; }
                __syncthreads();
            }
            LAS float* scr = (LAS float*)(lds + wave * 16384);
            convert_ffn(INP(I_F1W1), INP(I_F1W3), INP(I_F1W2), W13, W2, scr, gw, NGW, lane);
            constexpr int IIN = (D / 64) * (NIN / 32), IOUT = (D / 64) * (D / 32);
            for (int it = gw; it < IIN + IOUT; it += NGW) {
                if (it < IIN) transpose_item<2>(INP(I_WIN), D, NIN, WIN, 0, scr, it, lane);
                else transpose_item<0>(INP(I_WOUT), D, D, WOUT, 0, scr, it - IIN, lane);
            }
            for (int v = bid * NTHREADS + tid; v < (NINP - NIN) * D / 8; v += G * NTHREADS) *((u32x4*)(WIN + (size_t)NIN * D) + v) = (u32x4){0u, 0u, 0u, 0u};
        } else if (ph == 1 && (PHM & 2)) {
            for (int g4 = bid * NTHREADS + tid; g4 < 3 * NMODS / 4; g4 += G * NTHREADS) { const int gid = 4 * g4, cond = gid / NMODS, rem = gid % NMODS; f32x4 v = *(const f32x4*)(INP(I_ADAB) + rem);
#pragma unroll
                for (int s = 0; s < 16; ++s) v += *(const f32x4*)(part + (size_t)(s * 3 + cond) * NMODS + rem);
                *(f32x4*)(mods + gid) = v; }
            norm_phase<true, false>(lds, INP(I_X), INP(I_CTX), MROWS, INP(I_N1W), part, INP(I_ADAB), mods, 0, 1, H, nullptr, gw, NGW, tid, lane);
        } else if (ph == 2 && (PHM & 4)) {
            unsigned* cnt = (unsigned*)(ws + WS_CNT);
            { pg8::Gemm g{H, W13, MROWS, 2 * FF, D, D / 64}; CtxFirstOrder S; S.init(G, bid, cnt, (LAS unsigned*)(lds + LDS_BYTES - 64 + 16));
              EpiSwiglu E{GP};
              pg8::gemm_phase<EpiSwiglu, CtxFirstOrder, true, true>(lds, g, S, E); }
            if (bid >= G - 24) {
                if (tid == 0) { while (__hip_atomic_load(cnt, __ATOMIC_RELAXED, __HIP_MEMORY_SCOPE_AGENT) < 44u * 8u) __builtin_amdgcn_s_sleep(4); }
                __builtin_amdgcn_fence(__ATOMIC_ACQUIRE, "agent");
                asm volatile("s_waitcnt vmcnt(0)" ::: "memory");
                __syncthreads();
                const int qd = bid - (G - 24), part3 = qd % 3, tile = qd / 3, k0 = part3 == 0 ? 0 : (part3 == 1 ? 16 * 64 : 30 * 64);
                pg8::Gemm g{GP + (size_t)NLAT * FF + k0, W2 + k0, NCTX, D, FF, part3 == 0 ? 16 : 14}; OneUnit S{tile >> 2, tile & 3};
                EpiCtxAtomic E{(float*)(ws + WS_SR) + (size_t)part3 * NCTX * D, mods};
                pg8::gemm_phase<EpiCtxAtomic, OneUnit, true, true>(lds, g, S, E);
            }
        } else if (ph == 11 && (PHM & 4)) {
            pg8::Gemm g{H, W13, NLAT, 2 * FF, D, D / 64}; pg8::StaticOrder S; S.init(NLAT, 2 * FF, G, bid);
            EpiSwiglu E{GP};
            pg8::gemm_phase<EpiSwiglu, pg8::StaticOrder, true, true>(lds, g, S, E);
        } else if (ph == 12 && (PHM & 8)) {
            pg8::Gemm g{GP, W2, NLAT, D, FF, FF / 64}; pg8::StaticOrder S; S.init(NLAT, D, G, bid);
            EpiResidNorm<0> E{};
            pg8::gemm_phase<EpiResidNorm<0>, pg8::StaticOrder, false, true>(lds, g, S, E);
        } else if (ph == 3 && (PHM & 8)) {
            norm_phase<false, false>(lds, out, INP(I_CTX), MROWS, INP(I_N2W), part, INP(I_ADAB), mods, 3, 4, H, nullptr, gw, NGW, tid, lane, NLAT, (const float*)(ws + WS_SR));
            __syncthreads();
            pg8::Gemm g{GP, W2, NLAT, D, FF, FF / 64}; pg8::StaticOrder S; S.init(NLAT, D, G, bid);
            EpiResidNorm<1> E{};
            pg8::gemm_phase<EpiResidNorm<1>, pg8::StaticOrder, false, true>(lds, g, S, E);
        } else if (ph == 9 && (PHM & 8)) {
            pg8::Gemm g{H, WOUT, NLAT, D, D, D / 64}; pg8::StaticOrder S; S.init(NLAT, D, G, bid);
            EpiResidNorm<2> E{};
            pg8::gemm_phase<EpiResidNorm<2>, pg8::StaticOrder, false, true>(lds, g, S, E);
        } else if (ph == 4 && (PHM & 16)) {
            norm_phase<false, false>(lds, out, X1C, MROWS, INP(I_N2W), part, INP(I_ADAB), mods, 3, 4, H, nullptr, gw, NGW, tid, lane);
        } else if (ph == 5 && (PHM & 32)) {
            pg8::Gemm g{H, WIN, MROWS, NINP, D, D / 64}; pg8::StaticOrder S; S.init(MROWS, NINP, G, bid);
            EpiWin E{GP, LR};
            pg8::gemm_phase<EpiWin, pg8::StaticOrder, true, true>(lds, g, S, E);
        } else if (ph == 6 && (PHM & 64)) {
            unsigned* qctr = (unsigned*)(ws + WS_CNT + 768);
            volatile LAS int* nx = (volatile LAS int*)(lds + LDS_BYTES - 64 + 32);
            int it = bid, k = 0;
            while (it < 1056) {
                if (tid == 0) nx[k & 1] = G + (int)__hip_atomic_fetch_add(qctr, 1u, __ATOMIC_RELAXED, __HIP_MEMORY_SCOPE_AGENT);
                if (it < 528) { if (!(P6SKIP & 2)) p6_gla_item(lds, GP, LR, SG, DG, INP(I_GWF), INP(I_GBF), INP(I_GWB), INP(I_GBB), it, tid, wave, lane, out + (size_t)NLAT * 512); }
                else if (!(P6SKIP & 1)) p6_ret_item(lds, GP, SR, INP(I_RDF), INP(I_RDB), it - 528, tid, wave, lane);
                it = nx[k & 1]; ++k;
            }
        } else if (ph == 7 && (PHM & 128)) {
            p7_scan(SR, SG, DG, INP(I_RDF), INP(I_RDB), bid * NTHREADS + tid, G * NTHREADS);
            { LAS float* scr = (LAS float*)(lds + wave * 16384); convert_ffn(INP(I_F2W1), INP(I_F2W3), INP(I_F2W2), W13, W2, scr, gw, NGW, lane); }
        } else if (ph == 8 && (PHM & 256)) {
            for (int it = bid; it < 1024; it += G) for (int rep = 0; rep < (PROBE == 14 ? 2 : 1); ++rep) {
                if (it < 512) p8_ret_item(lds, GP, SR, H, INP(I_RDF), INP(I_RDB), INP(I_RNW), it, tid, wave, lane);
                else p8_gla_item(lds, GP, LR, SG, H, INP(I_GWF), INP(I_GBF), INP(I_GWB), INP(I_GBB), INP(I_GNW), it - 512, tid, wave, lane, out + (size_t)NLAT * 512);
            }
        } else if (ph == 10 && (PHM & 512)) {
            norm_phase<false, false>(lds, out, X1C, NLAT, INP(I_N3W), part, INP(I_ADAB), mods, 6, 7, H, nullptr, gw, NGW, tid, lane);
        } else if (ph == 13 && (PHM & 1024)) {
            norm_phase<false, true>(lds, out, X1C, NLAT, INP(I_FNW), part, INP(I_ADAB), mods, 0, 0, nullptr, probe_dst ? (float*)(ws + WS_SR) : out, gw, NGW, tid, lane);
        }
}

__global__ void __launch_bounds__(NTHREADS, 2) mk_fwd(Args a) {
    extern __shared__ __attribute__((aligned(16))) unsigned char lds_raw[];
    LAS unsigned char* lds = (LAS unsigned char*)lds_raw;
    cg::grid_group grid = cg::this_grid();
    const int G = gridDim.x, NGW = G * 8;
#ifndef PROBE
#define PROBE 0
#endif
#ifndef PROBE
#define PROBE 0
#endif
    if (gridDim.y == 4242u) grid.sync();
    unsigned* barw = (unsigned*)(a.ws + WS_BAR);
    volatile LAS unsigned* bst = (volatile LAS unsigned*)(lds + LDS_BYTES - 64);
    if (threadIdx.x < 8) bst[threadIdx.x] = 0u;
    __syncthreads();
    XcdBarrier bar = xcd_barrier_post(barw, bst);
#define SEAM() xcd_barrier_ool(bar.bar, bar.x, bar.st)
    run_phase<0>(lds, G, NGW); SEAM();
    run_phase<1>(lds, G, NGW); SEAM();
    run_phase<2>(lds, G, NGW); SEAM();
    run_phase<3>(lds, G, NGW); SEAM();
    run_phase<5>(lds, G, NGW); SEAM();
    run_phase<6>(lds, G, NGW); SEAM();
    run_phase<7>(lds, G, NGW); SEAM();
    run_phase<8>(lds, G, NGW); SEAM();
    run_phase<9>(lds, G, NGW); SEAM();
    run_phase<11>(lds, G, NGW); SEAM();
    run_phase<12>(lds, G, NGW);
}

extern "C" void kernel_launch(void* const* d_in, const int* in_sizes, int n_in, void* d_out, int out_size, void* d_ws, size_t ws_size, hipStream_t stream) {
    static int grid = 0;
    if (grid == 0) {
        if (n_in != 26 || ws_size < WS_END) { fprintf(stderr, "kernel_launch: unexpected n_in %d or ws_size %zu (< %zu)\n", n_in, ws_size, (size_t)WS_END); grid = -1; return; }
        int dev = 0, cus = 0, per_cu = 0;
        hipGetDevice(&dev);
        hipDeviceGetAttribute(&cus, hipDeviceAttributeMultiprocessorCount, dev);
        hipFuncSetAttribute((const void*)mk_fwd, hipFuncAttributeMaxDynamicSharedMemorySize, LDS_BYTES);
        hipOccupancyMaxActiveBlocksPerMultiprocessor(&per_cu, (const void*)mk_fwd, NTHREADS, LDS_BYTES);
        if (per_cu < 1) { fprintf(stderr, "kernel_launch: occupancy query reports %d blocks per CU\n", per_cu); per_cu = 1; }
        grid = cus;
        (void)hipGetLastError();
    }
    if (grid < 0) return;
    if (hipMemsetAsync((char*)d_ws + WS_BAR, 0, 128 * 1024, stream) != hipSuccess) { fprintf(stderr, "kernel_launch: memset of the barrier words failed\n"); return; }
    Args a{};
    for (int i = 0; i < 26; ++i) a.in[i] = (const float*)d_in[i];
    a.out = (float*)d_out; a.ws = (unsigned char*)d_ws;
    void* args[] = {&a};
    hipError_t e = hipLaunchCooperativeKernel((const void*)mk_fwd, dim3(grid), dim3(NTHREADS), args, LDS_BYTES, stream);
    if (e != hipSuccess) fprintf(stderr, "cooperative launch failed: %s (grid %d)\n", hipGetErrorString(e), grid);
}
```

```cpp
#include <hip/hip_runtime.h>
#include <hip/hip_cooperative_groups.h>
#include <cstdio>
#include <cstdint>
namespace cg = cooperative_groups;
namespace pg8 {
#define PG8_LAS __attribute__((address_space(3)))
typedef unsigned short bf16_t;
typedef short bf16x8 __attribute__((ext_vector_type(8)));
typedef float f32x4 __attribute__((ext_vector_type(4)));
typedef unsigned u32x4 __attribute__((ext_vector_type(4)));
constexpr int BM = 256, BK = 64, HALF = 128, HTB = HALF * BK * 2  , STAGE_BYTES = 8 * HTB, NXCD = 8, WGM = 8;

__host__ __device__ __forceinline__ int lds_byte(int r, int c) { const int st = (r >> 4) * 2 + (c >> 5), rr = r & 15, cc = c & 31, ob = rr * 64 + cc * 2; return st * 1024 + (ob ^ (((ob >> 9) & 1) << 5)); }
__host__ __device__ __forceinline__ void stage_rc(int b, int& R, int& C) { const int st = b / 1024, sb = b % 1024, swz = sb ^ (((sb >> 9) & 1) << 5); R = (st >> 1) * 16 + swz / 64; C = (st & 1) * 32 + (swz % 64) / 2; }
__host__ __device__ __forceinline__ int perm32(int rho) { const int n = rho >> 4, i = rho & 15; return 8 * (i >> 2) + 4 * n + (i & 3); }

struct Unit { int pm, pn; };
struct Gemm { const bf16_t* A; const bf16_t* Bt; int M, N, K, KT; };

struct StaticOrder {
    int nM, nN, nwg, G, c;
    __host__ __device__ void init(int M, int N, int G_, int c_) { nM = M / BM; nN = N / BM; nwg = nM * nN; G = G_; c = c_; }
    __host__ __device__ bool next(int i, Unit& u) const {
        const long L = (long)i * G + c; if (L >= nwg) return false;
        int wgid = (int)L; { const int q = nwg / NXCD, r = nwg % NXCD, xcd = wgid % NXCD, off = wgid / NXCD; wgid = (xcd < r ? xcd * (q + 1) : r * (q + 1) + (xcd - r) * q) + off; }
        const int nig = WGM * nN, gid = wgid / nig, fm = gid * WGM, gsz = (nM - fm) < WGM ? (nM - fm) : WGM;
        u.pm = fm + ((wgid % nig) % gsz); u.pn = (wgid % nig) / gsz; return true;
    }
    __device__ __forceinline__ void a_ready(const Unit&) const {}
    __device__ __forceinline__ void done(const Unit&) const {}
};

__device__ __forceinline__ unsigned cvt_pk_bf16(float lo, float hi) { unsigned r; asm volatile("v_cvt_pk_bf16_f32 %0, %1, %2" : "=v"(r) : "v"(lo), "v"(hi)); return r; }
template <class Epi, class Sched, bool ALIGN_EPI = false, bool SP2 = false>
__device__ __forceinline__ void gemm_phase(PG8_LAS unsigned char* lds, const Gemm g, const Sched& S, const Epi& E) {
    const int tid = threadIdx.x, wid = __builtin_amdgcn_readfirstlane(tid >> 6), lane = tid & 63, wr = wid >> 2, wc = wid & 3, fr = lane & 15, fq = lane >> 4;
    const int K = g.K, nt = g.KT;
    unsigned voffA[2], voffB[2];
#pragma unroll
    for (int i = 0; i < 2; ++i) { int R, C; stage_rc(tid * 16 + i * 8192, R, C); const int Rb = Epi::PERM ? ((R & ~31) + perm32(R & 31)) : R;
        voffA[i] = (unsigned)(R * K + C) * 2u; voffB[i] = (unsigned)(Rb * K + C) * 2u; }
    const size_t kstep = (size_t)(BK * 2);
    const size_t hstep = (size_t)HALF * K * 2;
    const size_t tstep = 2 * hstep;
    const unsigned ldsw = (unsigned)wid * 1024u;
    const int aoff = lds_byte(wr * 64 + fr, fq * 8), boff = lds_byte(wc * 32 + fr, fq * 8);
#define PG8_SA(b, h) (((b) * 2 + (h)) * HTB)
#define PG8_SB(b, h) ((4 + (b) * 2 + (h)) * HTB)
#define PG8_STAGE(bufoff, gbase, voff) do { _Pragma("unroll") for (int _i = 0; _i < 2; ++_i) \
        __builtin_amdgcn_global_load_lds((const unsigned*)((const char*)(gbase) + (voff)[_i]), (PG8_LAS unsigned*)(lds + (bufoff) + ldsw + _i * 8192), 16, 0, 0); } while (0)
#define PG8_LDA(dst, b, h) do { _Pragma("unroll") for (int m = 0; m < 4; ++m) _Pragma("unroll") for (int k = 0; k < 2; ++k) dst[m][k] = *(const PG8_LAS bf16x8*)(lds + PG8_SA(b, h) + aoff + m * 2048 + k * 1024); } while (0)
#define PG8_LDB(dst, b, h) do { _Pragma("unroll") for (int n = 0; n < 2; ++n) _Pragma("unroll") for (int k = 0; k < 2; ++k) dst[n][k] = *(const PG8_LAS bf16x8*)(lds + PG8_SB(b, h) + boff + n * 2048 + k * 1024); } while (0)
#define PG8_MMA(ai, bj, At, Bt) do { __builtin_amdgcn_s_setprio(1); _Pragma("unroll") for (int m = 0; m < 4; ++m) _Pragma("unroll") for (int n = 0; n < 2; ++n) _Pragma("unroll") for (int k = 0; k < 2; ++k) \
        acc[ai][bj][m][n] = __builtin_amdgcn_mfma_f32_16x16x32_bf16(Bt[n][k], At[m][k], acc[ai][bj][m][n], 0, 0, 0); __builtin_amdgcn_s_setprio(0); } while (0)
#define PG8_WAIT_V(n) asm volatile("s_waitcnt vmcnt(" #n ")" ::: "memory")
#define PG8_WAIT_L(n) asm volatile("s_waitcnt lgkmcnt(" #n ")" ::: "memory")
#define PG8_BAR __builtin_amdgcn_s_barrier()
#define PG8_SCHED __builtin_amdgcn_sched_barrier(0)
    Unit cur, nxt; int ui = 0;
    if (!S.next(0, cur)) return;
    f32x4 acc[2][2][4][2];
#pragma unroll
    for (int a = 0; a < 2; ++a)
#pragma unroll
        for (int b = 0; b < 2; ++b)
#pragma unroll
            for (int m = 0; m < 4; ++m)
#pragma unroll
                for (int n = 0; n < 2; ++n) acc[a][b][m][n] = (f32x4){0.f, 0.f, 0.f, 0.f};
    bf16x8 At[4][2], B0[2][2], B1[2][2];
    const char* cA = (const char*)g.A + (size_t)cur.pm * tstep; const char* cB = (const char*)g.Bt + (size_t)cur.pn * tstep;
    S.a_ready(cur);
    if constexpr (SP2) {
        PG8_STAGE(PG8_SB(0, 0), cB, voffB); PG8_STAGE(PG8_SB(0, 1), cB + hstep, voffB); PG8_STAGE(PG8_SA(0, 0), cA, voffA); PG8_STAGE(PG8_SA(0, 1), cA + hstep, voffA);
        if (wr == 1) PG8_BAR;
        PG8_WAIT_V(2); PG8_BAR;
        PG8_STAGE(PG8_SB(1, 0), cB + kstep, voffB); PG8_STAGE(PG8_SA(1, 0), cA + kstep, voffA); PG8_STAGE(PG8_SB(1, 1), cB + hstep + kstep, voffB);
        PG8_WAIT_V(6); PG8_BAR;
    } else {
        PG8_STAGE(PG8_SB(0, 0), cB, voffB); PG8_STAGE(PG8_SA(0, 0), cA, voffA); PG8_STAGE(PG8_SB(0, 1), cB + hstep, voffB); PG8_STAGE(PG8_SA(0, 1), cA + hstep, voffA);
        if (wr == 1) PG8_BAR;
        PG8_WAIT_V(4); PG8_BAR;
        PG8_STAGE(PG8_SB(1, 0), cB + kstep, voffB); PG8_STAGE(PG8_SA(1, 0), cA + kstep, voffA); PG8_STAGE(PG8_SB(1, 1), cB + hstep + kstep, voffB);
        PG8_WAIT_V(6); PG8_BAR;
    }
    for (;;) {
        const bool has_next = S.next(ui + 1, nxt);
        const char* nA = has_next ? (const char*)g.A + (size_t)nxt.pm * tstep : cA; const char* nB = has_next ? (const char*)g.Bt + (size_t)nxt.pn * tstep : cB;
        for (int t = 0; t < nt; t += 2) {
            const bool last = (t == nt - 2);
            const char* a1 = cA + (size_t)(t + 1) * kstep;
            const char* a2 = last ? nA : cA + (size_t)(t + 2) * kstep; const char* b2 = last ? nB : cB + (size_t)(t + 2) * kstep;
            const char* a3 = a2 + kstep; const char* b3 = b2 + kstep;
            if (last && has_next) S.a_ready(nxt);
            if constexpr (SP2) {
            PG8_LDB(B0, 0, 0); PG8_LDB(B1, 0, 1); PG8_SCHED; PG8_LDA(At, 0, 0); PG8_STAGE(PG8_SA(1, 1), a1 + hstep, voffA);
            PG8_WAIT_V(8); PG8_WAIT_L(0); PG8_BAR; PG8_MMA(0, 0, At, B0); PG8_MMA(0, 1, At, B1); PG8_BAR; PG8_SCHED;
            PG8_LDA(At, 0, 1); PG8_STAGE(PG8_SB(0, 0), b2, voffB); PG8_STAGE(PG8_SB(0, 1), b2 + hstep, voffB); PG8_STAGE(PG8_SA(0, 0), a2, voffA);
            PG8_WAIT_V(8); PG8_WAIT_L(0); PG8_BAR; PG8_MMA(1, 0, At, B0); PG8_MMA(1, 1, At, B1); PG8_BAR; PG8_SCHED;
            PG8_LDB(B0, 1, 0); PG8_LDB(B1, 1, 1); PG8_SCHED; PG8_LDA(At, 1, 0); PG8_STAGE(PG8_SA(0, 1), a2 + hstep, voffA);
            PG8_WAIT_V(8); PG8_WAIT_L(0); PG8_BAR; PG8_MMA(0, 0, At, B0); PG8_MMA(0, 1, At, B1); PG8_BAR; PG8_SCHED;
            PG8_LDA(At, 1, 1); PG8_STAGE(PG8_SB(1, 0), b3, voffB); PG8_STAGE(PG8_SB(1, 1), b3 + hstep, voffB); PG8_STAGE(PG8_SA(1, 0), a3, voffA);
            PG8_WAIT_V(8); PG8_WAIT_L(0); PG8_BAR; PG8_MMA(1, 0, At, B0); PG8_MMA(1, 1, At, B1); PG8_BAR; PG8_SCHED;
            } else {
            PG8_LDB(B0, 0, 0); PG8_SCHED; PG8_LDA(At, 0, 0); PG8_STAGE(PG8_SA(1, 1), a1 + hstep, voffA);
            PG8_WAIT_L(8); PG8_BAR; PG8_WAIT_L(0); PG8_MMA(0, 0, At, B0); PG8_BAR; PG8_SCHED;
            PG8_LDB(B1, 0, 1); PG8_STAGE(PG8_SB(0, 0), b2, voffB);
            PG8_BAR; PG8_WAIT_L(0); PG8_MMA(0, 1, At, B1); PG8_BAR;
            PG8_LDA(At, 0, 1); PG8_STAGE(PG8_SA(0, 0), a2, voffA);
            PG8_BAR; PG8_WAIT_L(0); PG8_MMA(1, 0, At, B0); PG8_BAR; PG8_SCHED;
            PG8_STAGE(PG8_SB(0, 1), b2 + hstep, voffB);
            PG8_WAIT_V(6); PG8_BAR; PG8_MMA(1, 1, At, B1); PG8_BAR;
            PG8_LDB(B0, 1, 0); PG8_SCHED; PG8_LDA(At, 1, 0); PG8_STAGE(PG8_SA(0, 1), a2 + hstep, voffA);
            PG8_WAIT_L(8); PG8_BAR; PG8_WAIT_L(0); PG8_MMA(0, 0, At, B0); PG8_BAR; PG8_SCHED;
            PG8_LDB(B1, 1, 1); PG8_STAGE(PG8_SB(1, 0), b3, voffB);
            PG8_BAR; PG8_WAIT_L(0); PG8_MMA(0, 1, At, B1); PG8_BAR;
            PG8_LDA(At, 1, 1); PG8_STAGE(PG8_SA(1, 0), a3, voffA);
            PG8_BAR; PG8_WAIT_L(0); PG8_MMA(1, 0, At, B0); PG8_BAR; PG8_SCHED;
            PG8_STAGE(PG8_SB(1, 1), b3 + hstep, voffB);
            PG8_WAIT_V(6); PG8_BAR; PG8_MMA(1, 1, At, B1); PG8_BAR;
            }
        }
        if constexpr (ALIGN_EPI) { if (wr == 0) PG8_BAR; }
        if constexpr (!Epi::AFTER_DRAIN) { E(acc, cur, wr, wc, fr, fq); S.done(cur); }
        if (!has_next) break;
#pragma unroll
        for (int a = 0; a < 2; ++a)
#pragma unroll
            for (int b = 0; b < 2; ++b)
#pragma unroll
                for (int m = 0; m < 4; ++m)
#pragma unroll
                    for (int n = 0; n < 2; ++n) acc[a][b][m][n] = (f32x4){0.f, 0.f, 0.f, 0.f};
        cur = nxt; cA = nA; cB = nB; ++ui;
        if constexpr (ALIGN_EPI) { if (wr == 1) PG8_BAR; }
    }
    PG8_WAIT_V(0);
    if constexpr (!ALIGN_EPI) { if (wr == 0) PG8_BAR; }
    PG8_BAR;
    if constexpr (Epi::AFTER_DRAIN) { E.fused(acc, cur, wr, wc, fr, fq, lds, wid, lane); S.done(cur); }
#undef PG8_SA
#undef PG8_SB
#undef PG8_STAGE
#undef PG8_LDA
#undef PG8_LDB
#undef PG8_MMA
#undef PG8_WAIT_V
#undef PG8_WAIT_L
#undef PG8_BAR
#undef PG8_SCHED
}
}

#define LAS __attribute__((address_space(3)))
#ifndef PROBE
#define PROBE 0
#endif
typedef unsigned short bf16_t;
typedef short bf16x8 __attribute__((ext_vector_type(8)));
typedef float f32x4 __attribute__((ext_vector_type(4)));
typedef unsigned u32x4 __attribute__((ext_vector_type(4)));
typedef unsigned u32x2 __attribute__((ext_vector_type(2)));

constexpr int D = 1024, FF = 2816, NLAT = 16384, NCTX = 512, MROWS = NLAT + NCTX, NIN = 3616, NINP = 3840, PP = 3584  ;
constexpr int NMODS = 9 * D;
constexpr float EPS = 1e-6f;
constexpr int NTHREADS = 512;
constexpr int LDS_BYTES = 144 * 1024;

constexpr size_t MiB = 1u << 20;
constexpr size_t WS_PART = 0;
constexpr size_t WS_BAR  = WS_PART + 1792 * 1024;
constexpr size_t WS_CNT  = WS_BAR + 64 * 1024;
constexpr size_t WS_MODS = WS_PART + 2 * MiB;
constexpr size_t WS_LR   = WS_MODS + 128 * 1024;
constexpr size_t WS_X1C  = WS_LR + (size_t)MROWS * 32 * 4 + 0;
constexpr size_t WS_DG   = WS_X1C + 2 * MiB;
constexpr size_t WS_W13  = WS_DG + 1 * MiB;
constexpr size_t WS_W2   = WS_W13 + (size_t)2 * FF * D * 2;
constexpr size_t WS_WIN  = WS_W2 + (size_t)FF * D * 2;
constexpr size_t WS_WOUT = WS_WIN + (size_t)NINP * D * 2;
constexpr size_t WS_H    = WS_WOUT + (size_t)D * D * 2;
constexpr size_t WS_GP   = WS_H + (size_t)MROWS * D * 2;
constexpr size_t WS_SR   = WS_GP + (size_t)MROWS * PP * 2;
constexpr size_t WS_SG   = WS_SR + (size_t)16 * 66 * 16384 * 2;
constexpr size_t WS_END  = WS_SG + (size_t)16 * 132 * 8192 * 2;
static_assert(WS_END <= 256 * MiB, "workspace over 256 MiB");
static_assert(WS_LR % 256 == 0 && WS_X1C % 256 == 0 && WS_W13 % 256 == 0 && WS_H % 256 == 0 && WS_GP % 256 == 0 && WS_SR % 256 == 0 && WS_SG % 256 == 0, "align");

__device__ __forceinline__ unsigned f2bf(float f) { unsigned u = __builtin_bit_cast(unsigned, f); return (u + 0x7fffu + ((u >> 16) & 1u)) >> 16; }
__device__ __forceinline__ unsigned pk2(float lo, float hi) { return f2bf(lo) | (f2bf(hi) << 16); }
__device__ __forceinline__ unsigned cvtpk(float lo, float hi) { unsigned r; asm("v_cvt_pk_bf16_f32 %0, %1, %2" : "=v"(r) : "v"(lo), "v"(hi)); return r; }
__device__ __forceinline__ float bflo(unsigned u) { return __builtin_bit_cast(float, u << 16); }
__device__ __forceinline__ float bfhi(unsigned u) { return __builtin_bit_cast(float, u & 0xffff0000u); }
__device__ __forceinline__ float bf2f(bf16_t h) { return __builtin_bit_cast(float, (unsigned)h << 16); }
__device__ __forceinline__ float silu_f(float v) { return v * __builtin_amdgcn_rcpf(1.0f + __expf(-v)); }
__device__ __forceinline__ float wave_sum(float v) {
#pragma unroll
    for (int o = 1; o < 64; o <<= 1) v += __shfl_xor(v, o);
    return v;
}
#define LDS_WAIT() asm volatile("s_waitcnt lgkmcnt(0)" ::: "memory")

typedef float f32x2 __attribute__((ext_vector_type(2)));
__device__ __forceinline__ f32x2 swiglu2(f32x2 g, f32x2 u) {
    const f32x2 t = g * (-1.4426950408889634f);
    f32x2 e; e.x = __builtin_amdgcn_exp2f(t.x); e.y = __builtin_amdgcn_exp2f(t.y);
    const f32x2 dn = e + 1.0f;
    f32x2 r; r.x = __builtin_amdgcn_rcpf(dn.x); r.y = __builtin_amdgcn_rcpf(dn.y);
    return (g * u) * r;
}
struct EpiSwiglu {
    static constexpr bool PERM = true, AFTER_DRAIN = false;
    bf16_t* G;
    __device__ __forceinline__ void operator()(const f32x4 (&acc)[2][2][4][2], const pg8::Unit& u, int wr, int wc, int fr, int fq) const {
        const int row0 = u.pm * 256 + wr * 64 + fr, col0 = u.pn * 128 + wc * 32 + 8 * fq;
#pragma unroll
        for (int ai = 0; ai < 2; ++ai)
#pragma unroll
            for (int m = 0; m < 4; ++m) {
                bf16_t* p = G + (size_t)(row0 + ai * 128 + m * 16) * FF + col0;
                const f32x4 g0 = acc[ai][0][m][0], g1 = acc[ai][0][m][1], u0 = acc[ai][1][m][0], u1 = acc[ai][1][m][1];
                const f32x2 a = swiglu2((f32x2){g0[0], g0[1]}, (f32x2){u0[0], u0[1]}), b = swiglu2((f32x2){g0[2], g0[3]}, (f32x2){u0[2], u0[3]});
                const f32x2 c = swiglu2((f32x2){g1[0], g1[1]}, (f32x2){u1[0], u1[1]}), d = swiglu2((f32x2){g1[2], g1[3]}, (f32x2){u1[2], u1[3]});
                u32x4 w;
                w.x = pg8::cvt_pk_bf16(a.x, a.y); w.y = pg8::cvt_pk_bf16(b.x, b.y); w.z = pg8::cvt_pk_bf16(c.x, c.y); w.w = pg8::cvt_pk_bf16(d.x, d.y);
                *(u32x4*)p = w;
            }
    }
};
struct EpiResid {
    static constexpr bool PERM = false, AFTER_DRAIN = false;
    const float* src_lat; const float* src_ctx; float* dst_lat; float* dst_ctx; const float* mods; int midx; float scale;
    __device__ __forceinline__ void operator()(const f32x4 (&acc)[2][2][4][2], const pg8::Unit& u, int wr, int wc, int fr, int fq) const {
        const int cond = u.pm < 32 ? 0 : (u.pm < 64 ? 1 : 2);
        const int col0 = u.pn * 256 + wc * 32 + 4 * fq;
        const float* mrow = mods + cond * NMODS + midx * D + col0;
        f32x4 mv[2][2];
#pragma unroll
        for (int bj = 0; bj < 2; ++bj)
#pragma unroll
            for (int n = 0; n < 2; ++n) mv[bj][n] = *(const f32x4*)(mrow + bj * 128 + n * 16) * scale;
        const bool lat = u.pm < 64;
        const int rbase = (lat ? u.pm * 256 : (u.pm - 64) * 256) + wr * 64 + fr;
        const float* sb = lat ? src_lat : src_ctx; float* db = lat ? dst_lat : dst_ctx;
#pragma unroll
        for (int ai = 0; ai < 2; ++ai)
#pragma unroll
            for (int m = 0; m < 4; ++m) {
                const size_t ro = (size_t)(rbase + ai * 128 + m * 16) * D + col0;
#pragma unroll
                for (int bj = 0; bj < 2; ++bj)
#pragma unroll
                    for (int n = 0; n < 2; ++n) {
                        const f32x4 s = *(const f32x4*)(sb + ro + bj * 128 + n * 16);
                        *(f32x4*)(db + ro + bj * 128 + n * 16) = s + mv[bj][n] * acc[ai][bj][m][n];
                    }
                asm volatile("" ::: "memory");
            }
    }
};
struct EpiWin {
    static constexpr bool PERM = true, AFTER_DRAIN = false;
    bf16_t* P; float* LR;
    __device__ __forceinline__ void operator()(const f32x4 (&acc)[2][2][4][2], const pg8::Unit& u, int wr, int wc, int fr, int fq) const {
        const int pn = u.pn; const int rowb = u.pm * 256 + wr * 64 + fr;
        if (pn == 14) {
            if (wc == 0) {
#pragma unroll
                for (int ai = 0; ai < 2; ++ai)
#pragma unroll
                    for (int m = 0; m < 4; ++m) { float* p = LR + (size_t)(rowb + ai * 128 + m * 16) * 32 + 8 * fq; *(f32x4*)p = acc[ai][0][m][0]; *(f32x4*)(p + 4) = acc[ai][0][m][1]; }
            }
            return;
        }
        const bool rope = (pn < 4) && (u.pm < 64);
        const bool dosilu = (pn == 6) || (pn == 7) || (pn == 12) || (pn == 13);
        const float sc = pn < 2 ? 0.08838834764831845f : (pn == 8 ? 0.125f : 1.0f);
        const int col0 = pn * 256 + wc * 32 + 8 * fq;
        float frq[4];
#pragma unroll
        for (int j = 0; j < 4; ++j) frq[j] = exp2f(-(float)(16 * (wc & 1) + 4 * fq + j) * (13.287712379549449f / 32.0f));
#pragma unroll
        for (int ai = 0; ai < 2; ++ai)
#pragma unroll
            for (int m = 0; m < 4; ++m) {
                const int row = rowb + ai * 128 + m * 16;
                const int tok = row & 8191;
                const float pos = (float)((wc < 2) ? (tok >> 6) : (tok & 63));
#pragma unroll
                for (int bj = 0; bj < 2; ++bj) {
                    f32x4 v0 = acc[ai][bj][m][0] * sc, v1 = acc[ai][bj][m][1] * sc;
                    if (rope) {
#pragma unroll
                        for (int j = 0; j < 4; ++j) { const float ang = pos * frq[j]; const float sn = __sinf(ang), cs = __cosf(ang); const float a = v0[j], b = v1[j]; v0[j] = a * cs - b * sn; v1[j] = a * sn + b * cs; }
                    }
                    if (dosilu) {
#pragma unroll
                        for (int j = 0; j < 4; ++j) { v0[j] = silu_f(v0[j]); v1[j] = silu_f(v1[j]); }
                    }
                    u32x4 w; w.x = pg8::cvt_pk_bf16(v0[0], v0[1]); w.y = pg8::cvt_pk_bf16(v0[2], v0[3]); w.z = pg8::cvt_pk_bf16(v1[0], v1[1]); w.w = pg8::cvt_pk_bf16(v1[2], v1[3]);
                    *(u32x4*)(P + (size_t)row * PP + col0 + bj * 128) = w;
                }
            }
    }
};

struct CtxFirstOrder {
    int nN, nwg, G, c; unsigned* cnt; LAS unsigned* lcnt;
    __device__ void init(int G_, int c_, unsigned* cnt_, LAS unsigned* lcnt_) { nN = 22; nwg = 64 * 22; G = G_; c = c_; cnt = cnt_; lcnt = lcnt_; }
    __device__ bool next(int i, pg8::Unit& u) const {
        long L = (long)i * G + c;
        if (L < 44) { u.pm = 64 + (L >= 22 ? 1 : 0); u.pn = (int)(L % 22); return true; }
        L -= 44; if (L >= nwg) return false;
        int wgid = (int)L; { const int q = nwg / pg8::NXCD, r = nwg % pg8::NXCD, xcd = wgid % pg8::NXCD, off = wgid / pg8::NXCD; wgid = (xcd < r ? xcd * (q + 1) : r * (q + 1) + (xcd - r) * q) + off; }
        const int nig = pg8::WGM * nN, gid = wgid / nig, fm = gid * pg8::WGM, gsz = (64 - fm) < pg8::WGM ? (64 - fm) : pg8::WGM;
        u.pm = fm + ((wgid % nig) % gsz); u.pn = (wgid % nig) / gsz; return true;
    }
    __device__ __forceinline__ void a_ready(const pg8::Unit&) const {}
    __device__ __forceinline__ void done(const pg8::Unit& u) const {
        if (u.pm >= 64) {
            asm volatile("s_waitcnt vmcnt(0)" ::: "memory");
            unsigned old = 0u;
            if ((threadIdx.x & 63) == 0) old = __hip_atomic_fetch_add((LAS unsigned*)lcnt, 1u, __ATOMIC_RELAXED, __HIP_MEMORY_SCOPE_WORKGROUP);
            old = (unsigned)__builtin_amdgcn_readfirstlane((int)old);
            if ((old & 7u) == 7u) { __builtin_amdgcn_fence(__ATOMIC_RELEASE, "agent"); asm volatile("s_waitcnt vmcnt(0)" ::: "memory");
                if ((threadIdx.x & 63) == 0) __hip_atomic_fetch_add(cnt, 8u, __ATOMIC_RELAXED, __HIP_MEMORY_SCOPE_AGENT); }
        }
    }
};
struct OneUnit { int pm, pn;
    __device__ bool next(int i, pg8::Unit& u) const { if (i != 0) return false; u.pm = pm; u.pn = pn; return true; }
    __device__ __forceinline__ void a_ready(const pg8::Unit&) const {}
    __device__ __forceinline__ void done(const pg8::Unit&) const {}
};
struct EpiCtxAtomic {
    static constexpr bool PERM = false, AFTER_DRAIN = false;
    float* slab; const float* mods;
    __device__ __forceinline__ void operator()(const f32x4 (&acc)[2][2][4][2], const pg8::Unit& u, int wr, int wc, int fr, int fq) const {
        const int col0 = u.pn * 256 + wc * 32 + 4 * fq;
        const float* mrow = mods + 2 * NMODS + 2 * D + col0;
        f32x4 mv[2][2];
#pragma unroll
        for (int bj = 0; bj < 2; ++bj)
#pragma unroll
            for (int n = 0; n < 2; ++n) mv[bj][n] = *(const f32x4*)(mrow + bj * 128 + n * 16) * 0.5f;
#pragma unroll
        for (int ai = 0; ai < 2; ++ai)
#pragma unroll
            for (int m = 0; m < 4; ++m) {
                float* rp = slab + (size_t)(u.pm * 256 + ai * 128 + wr * 64 + m * 16 + fr) * D + col0;
#pragma unroll
                for (int bj = 0; bj < 2; ++bj)
#pragma unroll
                    for (int n = 0; n < 2; ++n) *(f32x4*)(rp + bj * 128 + n * 16) = mv[bj][n] * acc[ai][bj][m][n];
            }
    }
};

template <int MODE> struct EpiResidNorm {
    static constexpr bool PERM = false, AFTER_DRAIN = true;
    static constexpr int RMIDX = MODE == 0 ? 8 : (MODE == 1 ? 2 : 5), SH = MODE == 1 ? 3 : 6, SC = MODE == 1 ? 4 : 7, NWI = MODE == 0 ? 25 : (MODE == 1 ? 10 : 21);
    static constexpr float scale = MODE == 2 ? 1.0f : 0.5f;
    __device__ __forceinline__ void operator()(const f32x4 (&)[2][2][4][2], const pg8::Unit&, int, int, int, int) const {}
    __device__ __forceinline__ void fused(f32x4 (&acc)[2][2][4][2], const pg8::Unit& u, int wr, int wc, int fr, int fq, PG8_LAS unsigned char* lds, int wid, int lane) const {
        const __attribute__((address_space(4))) char* ka = (const __attribute__((address_space(4))) char*)__builtin_amdgcn_kernarg_segment_ptr();
        float* dst = *(float* const __attribute__((address_space(4)))*)(ka + 8 * 26);
        const float* src = *(const float* const __attribute__((address_space(4)))*)(ka + 8 * 0);
        unsigned char* wsb = *(unsigned char* const __attribute__((address_space(4)))*)(ka + 8 * 27);
        const bf16_t* srcb = MODE == 2 ? (const bf16_t*)dst : (const bf16_t*)(wsb + WS_SR);
        bf16_t* dstb = MODE == 1 ? (bf16_t*)dst : (bf16_t*)(wsb + WS_SR);
        const float* nw = *(const float* const __attribute__((address_space(4)))*)(ka + 8 * NWI);
        const float* mods = (const float*)(wsb + WS_MODS); float* xbuf = (float*)(wsb + WS_PART) + MODE * 65536; unsigned* pcnt = (unsigned*)(wsb + WS_CNT + 1024) + MODE * 4096;
        const int cond = u.pm < 32 ? 0 : 1;
        const int col0 = u.pn * 256 + wc * 32 + 4 * fq;
        const float* mrow = mods + cond * NMODS + RMIDX * D + col0;
        PG8_LAS float* P = (PG8_LAS float*)lds;
        PG8_LAS float* S = (PG8_LAS float*)(lds + 8192);
        {
            f32x4 mv[2][2];
#pragma unroll
            for (int bj = 0; bj < 2; ++bj)
#pragma unroll
                for (int n = 0; n < 2; ++n) mv[bj][n] = *(const f32x4*)(mrow + bj * 128 + n * 16) * scale;
#pragma unroll
            for (int ai = 0; ai < 2; ++ai)
#pragma unroll
                for (int m = 0; m < 4; ++m) {
                    const int r = ai * 128 + wr * 64 + m * 16 + fr;
                    const size_t ro = (size_t)(u.pm * 256 + r) * D + col0;
                    float sq = 0.f;
#pragma unroll
                    for (int bj = 0; bj < 2; ++bj)
#pragma unroll
                        for (int n = 0; n < 2; ++n) {
                            f32x4 xin;
                            if (MODE == 1) xin = __builtin_nontemporal_load((const f32x4*)(src + ro + bj * 128 + n * 16));
                            else { const u32x2 t = *(const u32x2*)(srcb + ro + bj * 128 + n * 16); xin = (f32x4){bflo(t.x), bfhi(t.x), bflo(t.y), bfhi(t.y)}; }
                            const f32x4 x = xin + mv[bj][n] * acc[ai][bj][m][n]; acc[ai][bj][m][n] = x; sq += (x[0] * x[0] + x[1] * x[1]) + (x[2] * x[2] + x[3] * x[3]);
                            if (MODE != 0) { u32x2 o; o.x = cvtpk(x[0], x[1]); o.y = cvtpk(x[2], x[3]); *(u32x2*)(dstb + ro + bj * 128 + n * 16) = o; } }
                    sq += __shfl_xor(sq, 16); sq += __shfl_xor(sq, 32);
                    if (fq == 0) P[r * 4 + wc] = sq;
                    asm volatile("" ::: "memory");
                }
        }
        asm volatile("s_waitcnt lgkmcnt(0)" ::: "memory"); __builtin_amdgcn_s_barrier(); asm volatile("" ::: "memory");
        const int row = wid * 32 + (lane & 31);
        if (lane < 32) {
            const float t = (P[row * 4 + 0] + P[row * 4 + 1]) + (P[row * 4 + 2] + P[row * 4 + 3]);
            __hip_atomic_store(xbuf + ((size_t)(u.pm * 256 + row) * 4 + u.pn), t, __ATOMIC_RELAXED, __HIP_MEMORY_SCOPE_AGENT);
        }
        asm volatile("s_waitcnt vmcnt(0)" ::: "memory");
        if (lane == 0) __hip_atomic_fetch_add(pcnt + 64 * u.pm, 1u, __ATOMIC_RELAXED, __HIP_MEMORY_SCOPE_AGENT);
        if (wid == 0) {
            unsigned spins = 0;
            while ((unsigned)__builtin_amdgcn_readfirstlane((int)__hip_atomic_load(pcnt + 64 * u.pm, __ATOMIC_RELAXED, __HIP_MEMORY_SCOPE_AGENT)) < 32u) { __builtin_amdgcn_s_sleep(2); if (++spins > (1u << 22)) break; }
            __builtin_amdgcn_fence(__ATOMIC_ACQUIRE, "agent");
        }
        asm volatile("s_waitcnt vmcnt(0) lgkmcnt(0)" ::: "memory"); __builtin_amdgcn_s_barrier(); asm volatile("" ::: "memory");
        if (lane < 32) {
            const unsigned long long* slot = (const unsigned long long*)(xbuf + (size_t)(u.pm * 256 + row) * 4);
            const unsigned long long s01 = __hip_atomic_load(slot, __ATOMIC_RELAXED, __HIP_MEMORY_SCOPE_AGENT), s23 = __hip_atomic_load(slot + 1, __ATOMIC_RELAXED, __HIP_MEMORY_SCOPE_AGENT);
            const float ss = (__builtin_bit_cast(float, (unsigned)s01) + __builtin_bit_cast(float, (unsigned)(s01 >> 32))) + (__builtin_bit_cast(float, (unsigned)s23) + __builtin_bit_cast(float, (unsigned)(s23 >> 32)));
            S[row] = 1.0f / sqrtf(ss * (1.0f / D) + EPS);
        }
        asm volatile("s_waitcnt lgkmcnt(0)" ::: "memory"); __builtin_amdgcn_s_barrier(); asm volatile("" ::: "memory");
        f32x4 wv[2][2], shv[2][2];
#pragma unroll
        for (int bj = 0; bj < 2; ++bj)
#pragma unroll
            for (int n = 0; n < 2; ++n) { wv[bj][n] = *(const f32x4*)(nw + col0 + bj * 128 + n * 16);
                if (MODE != 0) { wv[bj][n] = wv[bj][n] * (*(const f32x4*)(mods + cond * NMODS + SC * D + col0 + bj * 128 + n * 16) + 1.0f); shv[bj][n] = *(const f32x4*)(mods + cond * NMODS + SH * D + col0 + bj * 128 + n * 16); } }
        bf16_t* Hb = (bf16_t*)(wsb + WS_H);
#pragma unroll
        for (int ai = 0; ai < 2; ++ai)
#pragma unroll
            for (int m = 0; m < 4; ++m) {
                const int r = ai * 128 + wr * 64 + m * 16 + fr; const float rs = S[r];
                const size_t ro = (size_t)(u.pm * 256 + r) * D + col0;
#pragma unroll
                for (int bj = 0; bj < 2; ++bj)
#pragma unroll
                    for (int n = 0; n < 2; ++n) {
                        if (MODE == 0) __builtin_nontemporal_store(acc[ai][bj][m][n] * rs * wv[bj][n], (f32x4*)(dst + ro + bj * 128 + n * 16));
                        else { const f32x4 hh = acc[ai][bj][m][n] * rs * wv[bj][n] + shv[bj][n]; u32x2 o; o.x = pk2(hh[0], hh[1]); o.y = pk2(hh[2], hh[3]); *(u32x2*)(Hb + ro + bj * 128 + n * 16) = o; }
                    }
            }
    }
};

template <int MODE> __device__ __forceinline__ int dest_row(int n, int row_off) {
    if (MODE == 0) return n + row_off;
    if (MODE == 1) return (n >> 7) * 256 + (n & 127) + row_off;
    if (n >= 1024) return n;
    const int d = n & 127, half = d >> 6, x = (d >> 5) & 1, i = d & 31;
    const int wc = 2 * half + (i >> 4), fq = (i >> 2) & 3, j = i & 3;
    return (n & ~127) + 32 * wc + 8 * fq + 4 * x + j;
}
template <int MODE> __device__ __forceinline__ void transpose_item(const float* W, int K, int N, bf16_t* WT, int row_off, LAS float* scr, int item, int lane) {
    const int nblk = N / 32, kb = item / nblk, nb = item % nblk, k0 = 64 * kb, n0 = 32 * nb;
    float wv[32];
#pragma unroll
    for (int i = 0; i < 32; ++i) { const int kk = 2 * i + (lane >> 5); wv[i] = __builtin_nontemporal_load(W + (size_t)(k0 + kk) * N + n0 + (lane & 31)); }
#pragma unroll
    for (int i = 0; i < 32; ++i) { const int kk = 2 * i + (lane >> 5); scr[kk * 33 + (lane & 31)] = wv[i]; }
    LDS_WAIT();
    const int c = lane & 7;
#pragma unroll
    for (int j = 0; j < 4; ++j) { const int n = (lane >> 3) + 8 * j; const LAS float* s = scr + (8 * c) * 33 + n;
        u32x4 o; o.x = pk2(s[0 * 33], s[1 * 33]); o.y = pk2(s[2 * 33], s[3 * 33]); o.z = pk2(s[4 * 33], s[5 * 33]); o.w = pk2(s[6 * 33], s[7 * 33]);
        *(u32x4*)(WT + (size_t)dest_row<MODE>(n0 + n, row_off) * K + k0 + 8 * c) = o; }
    LDS_WAIT();
}
__device__ __forceinline__ void convert_ffn(const float* w1, const float* w3, const float* w2, bf16_t* W13, bf16_t* W2, LAS float* scr, int gw, int NGW, int lane) {
    constexpr int I13 = (D / 64) * (FF / 32), I2 = (FF / 64) * (D / 32);
    for (int it = gw; it < 2 * I13 + I2; it += NGW) {
        int r = it;
        if (r < I13) { transpose_item<1>(w1, D, FF, W13, 0, scr, r, lane); continue; } r -= I13;
        if (r < I13) { transpose_item<1>(w3, D, FF, W13, 128, scr, r, lane); continue; } r -= I13;
        transpose_item<0>(w2, FF, D, W2, 0, scr, r, lane);
    }
}

template <bool FROM_PART, bool FINAL>
__device__ __forceinline__ void norm_phase(LAS unsigned char* lds, const float* src_lat, const float* src_ctx, int nrows, const float* nw, const float* part, const float* ada_b, const float* mods,
                                           int shift_idx, int scale_idx, bf16_t* H, float* outf, int gw, int NGW, int tid, int lane, int row_begin = 0, const float* slabs = nullptr) {
    LAS float* tab = (LAS float*)lds;
    if (!FINAL) {
        for (int i4 = tid; i4 < 1536; i4 += NTHREADS) {
            const int idx = 4 * i4, cond = idx >> 11, which = (idx >> 10) & 1, col = idx & 1023, mi = which ? scale_idx : shift_idx;
            if (row_begin >= NLAT && cond != 2) continue;
            f32x4 v;
            if (FROM_PART) { v = *(const f32x4*)(ada_b + mi * D + col);
#pragma unroll
                for (int s = 0; s < 16; ++s) v += *(const f32x4*)(part + (size_t)(s * 3 + cond) * NMODS + mi * D + col); }
            else v = *(const f32x4*)(mods + cond * NMODS + mi * D + col);
            *(LAS f32x4*)(tab + idx) = v;
        }
        __syncthreads();
    }
    f32x4 wv[4];
#pragma unroll
    for (int j = 0; j < 4; ++j) wv[j] = *((const f32x4*)nw + 64 * j + lane);
    for (int row = row_begin + gw; row < nrows; row += 2 * NGW) {
        const int row2 = row + NGW; const bool has2 = row2 < nrows; const int r2 = has2 ? row2 : row;
        const float* xr = row < NLAT ? src_lat + (size_t)row * D : src_ctx + (size_t)(row - NLAT) * D;
        const float* xr2 = r2 < NLAT ? src_lat + (size_t)r2 * D : src_ctx + (size_t)(r2 - NLAT) * D;
        f32x4 v[2][4]; float s[2] = {0.f, 0.f};
#pragma unroll
        for (int j = 0; j < 4; ++j) { v[0][j] = __builtin_nontemporal_load((const f32x4*)xr + 64 * j + lane); v[1][j] = __builtin_nontemporal_load((const f32x4*)xr2 + 64 * j + lane); }
        if (slabs) {
#pragma unroll
            for (int q = 0; q < 2; ++q) { const size_t ro = (size_t)((q ? r2 : row) - NLAT) * D;
#pragma unroll
                for (int j = 0; j < 4; ++j)
#pragma unroll
                    for (int pt = 0; pt < 3; ++pt) v[q][j] += *((const f32x4*)(slabs + (size_t)pt * NCTX * D + ro) + 64 * j + lane); }
        }
#pragma unroll
        for (int q = 0; q < 2; ++q)
#pragma unroll
            for (int j = 0; j < 4; ++j) s[q] += (v[q][j].x * v[q][j].x + v[q][j].y * v[q][j].y) + (v[q][j].z * v[q][j].z + v[q][j].w * v[q][j].w);
#pragma unroll
        for (int q = 0; q < 2; ++q) {
            if (q == 1 && !has2) break;
            const int rr = q ? row2 : row;
            const float rstd = 1.0f / sqrtf(wave_sum(s[q]) * (1.0f / D) + EPS);
            if (FINAL) {
#pragma unroll
                for (int j = 0; j < 4; ++j) *((f32x4*)(outf + (size_t)rr * D) + 64 * j + lane) = v[q][j] * rstd * wv[j];
            } else {
                const int cond = rr < 8192 ? 0 : (rr < NLAT ? 1 : 2);
#pragma unroll
                for (int j = 0; j < 4; ++j) {
                    const f32x4 sh = *((const LAS f32x4*)(tab + (cond * 2 + 0) * 1024) + 64 * j + lane), scl = *((const LAS f32x4*)(tab + (cond * 2 + 1) * 1024) + 64 * j + lane);
                    const f32x4 hh = v[q][j] * rstd * wv[j] * (scl + 1.0f) + sh;
                    u32x2 o; o.x = pk2(hh.x, hh.y); o.y = pk2(hh.z, hh.w);
                    *((u32x2*)(H + (size_t)rr * D) + 64 * j + lane) = o;
                }
            }
        }
    }
}

__device__ __forceinline__ bf16x8 mk8(u32x2 lo, u32x2 hi) { u32x4 t; t.x = lo.x; t.y = lo.y; t.z = hi.x; t.w = hi.y; return __builtin_bit_cast(bf16x8, t); }
__device__ __forceinline__ bf16x8 row_frag(const LAS unsigned char* img, int pitch, int r0, int k0, int fr, int fq) { return *(const LAS bf16x8*)(img + (r0 + fr) * pitch + (k0 + 8 * fq) * 2); }
__device__ __forceinline__ void tr1(unsigned a0, unsigned a1, bf16x8& o) {
    u32x2 l0, h0;
    asm volatile("ds_read_b64_tr_b16 %0, %2\n\tds_read_b64_tr_b16 %1, %3\n\ts_waitcnt lgkmcnt(0)" : "=&v"(l0), "=&v"(h0) : "v"(a0), "v"(a1) : "memory");
    o = mk8(l0, h0);
}
__device__ __forceinline__ void tr2(unsigned a0, unsigned a1, bf16x8 (&o)[2]) {
    u32x2 l0, l1, h0, h1;
    asm volatile("ds_read_b64_tr_b16 %0, %4\n\tds_read_b64_tr_b16 %1, %4 offset:32\n\tds_read_b64_tr_b16 %2, %5\n\tds_read_b64_tr_b16 %3, %5 offset:32\n\ts_waitcnt lgkmcnt(0)"
                 : "=&v"(l0), "=&v"(l1), "=&v"(h0), "=&v"(h1) : "v"(a0), "v"(a1) : "memory");
    o[0] = mk8(l0, h0); o[1] = mk8(l1, h1);
}
__device__ __forceinline__ void tr4(unsigned a0, unsigned a1, bf16x8 (&o)[4]) {
    u32x2 l0, l1, l2, l3, h0, h1, h2, h3;
    asm volatile("ds_read_b64_tr_b16 %0, %8\n\tds_read_b64_tr_b16 %1, %8 offset:32\n\tds_read_b64_tr_b16 %2, %8 offset:64\n\tds_read_b64_tr_b16 %3, %8 offset:96\n\t"
                 "ds_read_b64_tr_b16 %4, %9\n\tds_read_b64_tr_b16 %5, %9 offset:32\n\tds_read_b64_tr_b16 %6, %9 offset:64\n\tds_read_b64_tr_b16 %7, %9 offset:96\n\ts_waitcnt lgkmcnt(0)"
                 : "=&v"(l0), "=&v"(l1), "=&v"(l2), "=&v"(l3), "=&v"(h0), "=&v"(h1), "=&v"(h2), "=&v"(h3) : "v"(a0), "v"(a1) : "memory");
    o[0] = mk8(l0, h0); o[1] = mk8(l1, h1); o[2] = mk8(l2, h2); o[3] = mk8(l3, h3);
}
__device__ __forceinline__ void tr8(unsigned a0, unsigned a1, bf16x8 (&o)[8]) {
    u32x2 l0, l1, l2, l3, l4, l5, l6, l7, h0, h1, h2, h3, h4, h5, h6, h7;
    asm volatile("ds_read_b64_tr_b16 %0, %16\n\tds_read_b64_tr_b16 %1, %16 offset:32\n\tds_read_b64_tr_b16 %2, %16 offset:64\n\tds_read_b64_tr_b16 %3, %16 offset:96\n\t"
                 "ds_read_b64_tr_b16 %4, %16 offset:128\n\tds_read_b64_tr_b16 %5, %16 offset:160\n\tds_read_b64_tr_b16 %6, %16 offset:192\n\tds_read_b64_tr_b16 %7, %16 offset:224\n\t"
                 "ds_read_b64_tr_b16 %8, %17\n\tds_read_b64_tr_b16 %9, %17 offset:32\n\tds_read_b64_tr_b16 %10, %17 offset:64\n\tds_read_b64_tr_b16 %11, %17 offset:96\n\t"
                 "ds_read_b64_tr_b16 %12, %17 offset:128\n\tds_read_b64_tr_b16 %13, %17 offset:160\n\tds_read_b64_tr_b16 %14, %17 offset:192\n\tds_read_b64_tr_b16 %15, %17 offset:224\n\ts_waitcnt lgkmcnt(0)"
                 : "=&v"(l0), "=&v"(l1), "=&v"(l2), "=&v"(l3), "=&v"(l4), "=&v"(l5), "=&v"(l6), "=&v"(l7), "=&v"(h0), "=&v"(h1), "=&v"(h2), "=&v"(h3), "=&v"(h4), "=&v"(h5), "=&v"(h6), "=&v"(h7)
                 : "v"(a0), "v"(a1) : "memory");
    o[0] = mk8(l0, h0); o[1] = mk8(l1, h1); o[2] = mk8(l2, h2); o[3] = mk8(l3, h3); o[4] = mk8(l4, h4); o[5] = mk8(l5, h5); o[6] = mk8(l6, h6); o[7] = mk8(l7, h7);
}
#define MFMA16(a, b, c) __builtin_amdgcn_mfma_f32_16x16x32_bf16((a), (b), (c), 0, 0, 0)

constexpr int PT128 = 288;
constexpr int PT64 = 160;
constexpr int IMG128 = 128 * PT128;
constexpr int IMG64 = 128 * PT64;

__device__ __forceinline__ float logsig(float z) { return fminf(z, 0.f) - __logf(1.0f + __expf(-fabsf(z))); }
__device__ __forceinline__ u32x4 scale8(u32x4 v, float s) {
    u32x4 o;
    o.x = cvtpk(bflo(v.x) * s, bfhi(v.x) * s); o.y = cvtpk(bflo(v.y) * s, bfhi(v.y) * s);
    o.z = cvtpk(bflo(v.z) * s, bfhi(v.z) * s); o.w = cvtpk(bflo(v.w) * s, bfhi(v.w) * s);
    return o;
}
__device__ __forceinline__ void stage128(LAS unsigned char* img, const bf16_t* src, int tid) {
#pragma unroll
    for (int i = 0; i < 4; ++i) { const int v = tid + NTHREADS * i, tok = v >> 4, ch = v & 15;
        *(LAS u32x4*)(img + tok * PT128 + ch * 16) = *(const u32x4*)(src + (size_t)tok * PP + ch * 8); }
}

__device__ __forceinline__ void p6_ret_item(LAS unsigned char* lds, const bf16_t* P, bf16_t* SR, const float* dec_f, const float* dec_b, int item, int tid, int wave, int lane) {
    asm volatile("" : "+v"(tid), "+v"(lane));
    const int tc = item % 66, bh = item / 66, h = bh & 3, b = bh >> 2;
    const int row0 = tc < 2 ? (NLAT + b * 256 + tc * 128) : (b * 8192 + (tc - 2) * 128);
    const float lgf = -log1pf(expf(-dec_f[h])), lgb = -log1pf(expf(-dec_b[h]));
    LAS unsigned char* KF = lds; LAS unsigned char* KB = lds + IMG128; LAS unsigned char* V = lds + 2 * IMG128;
    for (int rep1 = 0; rep1 < (PROBE == 19 ? 2 : 1); ++rep1) {
    u32x4 kvr[4], vvr[4];
#pragma unroll
    for (int i = 0; i < 4; ++i) { const int v = tid + NTHREADS * i, tok = v >> 4, ch = v & 15;
        const bf16_t* prow = P + (size_t)(row0 + tok) * PP + h * 128 + ch * 8;
        kvr[i] = *(const u32x4*)(prow + 512); vvr[i] = *(const u32x4*)(prow + 1024); }
#pragma unroll
    for (int i = 0; i < 4; ++i) { const int v = tid + NTHREADS * i, tok = v >> 4, ch = v & 15;
        const float sf = __expf((float)(127 - tok) * lgf), sb = __expf((float)tok * lgb);
        *(LAS u32x4*)(KF + tok * PT128 + ch * 16) = scale8(kvr[i], sf);
        *(LAS u32x4*)(KB + tok * PT128 + ch * 16) = scale8(kvr[i], sb);
        *(LAS u32x4*)(V + tok * PT128 + ch * 16) = vvr[i]; }
    __syncthreads();
    }
    const int g = lane >> 4, q = (lane & 15) >> 2, p = lane & 3, fr = lane & 15, fq = g;
    const int rb = wave >> 1, cb = wave & 1;
    const unsigned base = (unsigned)(size_t)lds;
    f32x4 af[2][4], ab[2][4];
#pragma unroll
    for (int x = 0; x < 2; ++x)
#pragma unroll
        for (int y = 0; y < 4; ++y) { af[x][y] = (f32x4){0.f, 0.f, 0.f, 0.f}; ab[x][y] = (f32x4){0.f, 0.f, 0.f, 0.f}; }
    for (int rep2 = 0; rep2 < (PROBE == 20 ? 2 : 1); ++rep2)
#pragma unroll
    for (int ks = 0; ks < 4; ++ks) {
        const unsigned rofs = (unsigned)((32 * ks + 8 * g + q) * PT128 + 8 * p);
        bf16x8 vf[4], kf[2], kb[2];
        tr4(base + 2 * IMG128 + rofs + 128 * cb, base + 2 * IMG128 + rofs + 128 * cb + 4 * PT128, vf);
        tr2(base + rofs + 64 * rb, base + rofs + 64 * rb + 4 * PT128, kf);
        tr2(base + IMG128 + rofs + 64 * rb, base + IMG128 + rofs + 64 * rb + 4 * PT128, kb);
#pragma unroll
        for (int x = 0; x < 2; ++x)
#pragma unroll
            for (int y = 0; y < 4; ++y) { af[x][y] = MFMA16(kf[x], vf[y], af[x][y]); ab[x][y] = MFMA16(kb[x], vf[y], ab[x][y]); }
    }
    if (PROBE == 20) {
#pragma unroll
        for (int x = 0; x < 2; ++x)
#pragma unroll
            for (int y = 0; y < 4; ++y) { af[x][y] *= 0.5f; ab[x][y] *= 0.5f; } }
    bf16_t* Uf = SR + ((size_t)((0 * 2 + b) * 4 + h) * 66 + tc) * 16384;
    bf16_t* Ub = SR + ((size_t)((1 * 2 + b) * 4 + h) * 66 + tc) * 16384;
    for (int rep3 = 0; rep3 < (PROBE == 21 ? 2 : 1); ++rep3)
#pragma unroll
    for (int x = 0; x < 2; ++x)
#pragma unroll
        for (int y = 0; y < 4; ++y) {
            const int dk = 32 * rb + 16 * x + 4 * fq, dv = 64 * cb + 16 * y + fr;
#ifdef TEST_CLAMP
#pragma unroll
            for (int e = 0; e < 4; ++e) { af[x][y][e] = fminf(fmaxf(af[x][y][e], -1e4f), 1e4f); ab[x][y][e] = fminf(fmaxf(ab[x][y][e], -1e4f), 1e4f); }
#endif
            u32x2 o; o.x = pk2(af[x][y][0], af[x][y][1]); o.y = pk2(af[x][y][2], af[x][y][3]);
            *(u32x2*)(Uf + dv * 128 + dk) = o;
            o.x = pk2(ab[x][y][0], ab[x][y][1]); o.y = pk2(ab[x][y][2], ab[x][y][3]);
            *(u32x2*)(Ub + dv * 128 + dk) = o;
        }
    __syncthreads();
}

constexpr int LRS_OFF = 122880;
__device__ __forceinline__ void gla_gates(LAS unsigned char* lds, LAS float* tot, const float* LR, const float* wf, const float* bfv, const float* wb, const float* bbv, int row0, int h, int tid, int wave,
                                          float (&bf)[16], float (&bb)[16], float& totf, float& totb) {
    const int d = tid & 63, col = h * 64 + d;
    LAS float* lrs = (LAS float*)(lds + LRS_OFF);
    { const f32x4* srcv = (const f32x4*)(LR + (size_t)row0 * 32); const f32x4 v0 = srcv[tid], v1 = srcv[tid + NTHREADS]; *((LAS f32x4*)lrs + tid) = v0; *((LAS f32x4*)lrs + tid + NTHREADS) = v1; }
    f32x2 wf2[8], wb2[8];
#pragma unroll
    for (int r = 0; r < 8; ++r) { wf2[r] = (f32x2){wf[(2 * r) * 256 + col], wf[(2 * r + 1) * 256 + col]}; wb2[r] = (f32x2){wb[(2 * r) * 256 + col], wb[(2 * r + 1) * 256 + col]}; }
    const float biasf = bfv[col], biasb = bbv[col];
    __syncthreads();
#pragma unroll
    for (int t = 0; t < 16; ++t) {
        const LAS float* lr = lrs + (16 * wave + t) * 32;
        f32x2 zf = (f32x2){biasf, 0.f}, zb = (f32x2){biasb, 0.f};
#pragma unroll
        for (int r4 = 0; r4 < 4; ++r4) { const f32x4 a = *(const LAS f32x4*)(lr + 4 * r4), c = *(const LAS f32x4*)(lr + 16 + 4 * r4);
            zf = __builtin_elementwise_fma((f32x2){a.x, a.y}, wf2[2 * r4], zf); zf = __builtin_elementwise_fma((f32x2){a.z, a.w}, wf2[2 * r4 + 1], zf);
            zb = __builtin_elementwise_fma((f32x2){c.x, c.y}, wb2[2 * r4], zb); zb = __builtin_elementwise_fma((f32x2){c.z, c.w}, wb2[2 * r4 + 1], zb); }
        bf[t] = logsig(zf.x + zf.y) * (1.0f / 16.0f); bb[t] = logsig(zb.x + zb.y) * (1.0f / 16.0f);
    }
#pragma unroll
    for (int t = 1; t < 16; ++t) bf[t] += bf[t - 1];
#pragma unroll
    for (int t = 14; t >= 0; --t) bb[t] += bb[t + 1];
    tot[wave * 64 + d] = bf[15]; tot[512 + wave * 64 + d] = bb[0];
    __syncthreads();
    const int sub = wave >> 2, gi = wave & 3;
    float pf = 0.f, sb = 0.f; totf = 0.f; totb = 0.f;
#pragma unroll
    for (int g2 = 0; g2 < 4; ++g2) { const float a = tot[(sub * 4 + g2) * 64 + d], c = tot[512 + (sub * 4 + g2) * 64 + d]; totf += a; totb += c; if (g2 < gi) pf += a; if (g2 > gi) sb += c; }
#pragma unroll
    for (int t = 0; t < 16; ++t) { bf[t] += pf; bb[t] += sb; }
}

__device__ __forceinline__ void p6_gla_item(LAS unsigned char* lds, const bf16_t* P, const float* LR, bf16_t* SG, float* DG, const float* wf, const float* bfv, const float* wb, const float* bbv,
                                            int item, int tid, int wave, int lane) {
    asm volatile("" : "+v"(tid), "+v"(lane));
    const int tc = item % 66, bh = item / 66, h = bh & 3, b = bh >> 2;
    const int row0 = tc < 2 ? (NLAT + b * 256 + tc * 128) : (b * 8192 + (tc - 2) * 128);
    LAS unsigned char* KF = lds; LAS unsigned char* KB = lds + IMG64; LAS unsigned char* V = lds + 2 * IMG64; LAS float* tot = (LAS float*)(lds + 2 * IMG64 + IMG128);
    stage128(V, P + (size_t)row0 * PP + 2560 + h * 128, tid);
    const int d = tid & 63, sub = wave >> 2;
    bf16_t kraw[16];
#pragma unroll
    for (int t = 0; t < 16; ++t) kraw[t] = P[(size_t)(row0 + 16 * wave + t) * PP + 2304 + h * 64 + d];
    float bf[16], bb[16], totf, totb;
    gla_gates(lds, tot, LR, wf, bfv, wb, bbv, row0, h, tid, wave, bf, bb, totf, totb);
    const int chf = (0 * 2 + b) * 4 + h, chb = (1 * 2 + b) * 4 + h, tc64 = 2 * tc + sub;
#pragma unroll
    for (int t = 0; t < 16; ++t) {
        const int tok = 16 * wave + t;
        const float kv = bf2f(kraw[t]);
        *(LAS bf16_t*)(KF + tok * PT64 + d * 2) = (bf16_t)cvtpk(kv * __expf(totf - bf[t]), 0.f);
        *(LAS bf16_t*)(KB + tok * PT64 + d * 2) = (bf16_t)cvtpk(kv * __expf(totb - bb[t]), 0.f);
    }
    if ((wave & 3) == 0) { DG[((size_t)chf * 132 + tc64) * 64 + d] = __expf(totf); DG[((size_t)chb * 132 + tc64) * 64 + d] = __expf(totb); }
    __syncthreads();
    const int g = lane >> 4, q = (lane & 15) >> 2, p = lane & 3, fr = lane & 15, fq = g, wl = wave & 3;
    const unsigned base = (unsigned)(size_t)lds;
    f32x4 af[8], ab[8];
#pragma unroll
    for (int y = 0; y < 8; ++y) { af[y] = (f32x4){0.f, 0.f, 0.f, 0.f}; ab[y] = (f32x4){0.f, 0.f, 0.f, 0.f}; }
#pragma unroll
    for (int ks = 0; ks < 2; ++ks) {
        const int r = sub * 64 + 32 * ks + 8 * g + q;
        bf16x8 vf[8], xf, xb;
        tr8(base + 2 * IMG64 + r * PT128 + 8 * p, base + 2 * IMG64 + (r + 4) * PT128 + 8 * p, vf);
        tr1(base + r * PT64 + 32 * wl + 8 * p, base + (r + 4) * PT64 + 32 * wl + 8 * p, xf);
        tr1(base + IMG64 + r * PT64 + 32 * wl + 8 * p, base + IMG64 + (r + 4) * PT64 + 32 * wl + 8 * p, xb);
#pragma unroll
        for (int y = 0; y < 8; ++y) { af[y] = MFMA16(xf, vf[y], af[y]); ab[y] = MFMA16(xb, vf[y], ab[y]); }
    }
    bf16_t* Uf = SG + ((size_t)chf * 132 + tc64) * 8192;
    bf16_t* Ub = SG + ((size_t)chb * 132 + tc64) * 8192;
#pragma unroll
    for (int y = 0; y < 8; ++y) {
        const int dk = 16 * wl + 4 * fq, dv = 16 * y + fr;
        u32x2 o; o.x = pk2(af[y][0], af[y][1]); o.y = pk2(af[y][2], af[y][3]);
        *(u32x2*)(Uf + dv * 64 + dk) = o;
        o.x = pk2(ab[y][0], ab[y][1]); o.y = pk2(ab[y][2], ab[y][3]);
        *(u32x2*)(Ub + dv * 64 + dk) = o;
    }
    __syncthreads();
}

__device__ __forceinline__ void p7_scan(bf16_t* SR, bf16_t* SG, const float* DG, const float* dec_f, const float* dec_b, int gtid, int gthreads) {
    for (int task = gtid; task < 65536 + 32768; task += gthreads) {
        if (task < 65536) {
            const int chain = task >> 12, e4 = task & 4095, dir = chain >> 3, h = chain & 3;
            const float lg = -log1pf(expf(-(dir ? dec_b[h] : dec_f[h])));
            const float dec = expf(128.0f * lg);
            bf16_t* basep = SR + (size_t)chain * 66 * 16384 + e4 * 4;
            f32x4 s = (f32x4){0.f, 0.f, 0.f, 0.f};
            for (int n0 = 0; n0 < 66; n0 += 11) {
                u32x2 u[11];
#pragma unroll
                for (int i = 0; i < 11; ++i) { const int n = n0 + i; const int tc = dir ? (n < 2 ? 1 - n : 67 - n) : n; u[i] = __builtin_nontemporal_load((const u32x2*)(basep + (size_t)tc * 16384)); }
#pragma unroll
                for (int i = 0; i < 11; ++i) { const int n = n0 + i; const int tc = dir ? (n < 2 ? 1 - n : 67 - n) : n;
                    u32x2 o; o.x = pk2(s.x, s.y); o.y = pk2(s.z, s.w);
                    *(u32x2*)(basep + (size_t)tc * 16384) = o;
                    s.x = dec * s.x + bflo(u[i].x); s.y = dec * s.y + bfhi(u[i].x); s.z = dec * s.z + bflo(u[i].y); s.w = dec * s.w + bfhi(u[i].y); }
            }
        } else {
            const int t2 = task - 65536, chain = t2 >> 11, e4 = t2 & 2047, dir = chain >> 3, dk0 = (e4 * 4) & 63;
            bf16_t* basep = SG + (size_t)chain * 132 * 8192 + e4 * 4;
            const float* dgp = DG + (size_t)chain * 132 * 64 + dk0;
            f32x4 s = (f32x4){0.f, 0.f, 0.f, 0.f};
            for (int n0 = 0; n0 < 132; n0 += 11) {
                u32x2 u[11]; f32x4 dc[11];
#pragma unroll
                for (int i = 0; i < 11; ++i) { const int n = n0 + i; const int tc = dir ? (n < 4 ? 3 - n : 135 - n) : n; u[i] = __builtin_nontemporal_load((const u32x2*)(basep + (size_t)tc * 8192)); dc[i] = *(const f32x4*)(dgp + tc * 64); }
#pragma unroll
                for (int i = 0; i < 11; ++i) { const int n = n0 + i; const int tc = dir ? (n < 4 ? 3 - n : 135 - n) : n;
                    u32x2 o; o.x = pk2(s.x, s.y); o.y = pk2(s.z, s.w);
                    *(u32x2*)(basep + (size_t)tc * 8192) = o;
                    s.x = dc[i].x * s.x + bflo(u[i].x); s.y = dc[i].y * s.y + bfhi(u[i].x); s.z = dc[i].z * s.z + bflo(u[i].y); s.w = dc[i].w * s.w + bfhi(u[i].y); }
            }
        }
    }
}

__device__ __forceinline__ void p8_ret_item(LAS unsigned char* lds, const bf16_t* P, const bf16_t* SR, bf16_t* Hm, const float* dec_f, const float* dec_b, const float* normw,
                                            int item, int tid, int wave, int lane) {
    asm volatile("" : "+v"(tid), "+v"(lane));
    const int c = item & 63, bh = item >> 6, h = bh & 3, b = bh >> 2;
    const int row0 = b * 8192 + c * 128, tc = c + 2;
    const float lgf = -log1pf(expf(-dec_f[h])), lgb = -log1pf(expf(-dec_b[h]));
    LAS unsigned char* Q = lds; LAS unsigned char* K = lds + IMG128; LAS unsigned char* V = lds + 2 * IMG128;
    stage128(Q, P + (size_t)row0 * PP + h * 128, tid);
    stage128(K, P + (size_t)row0 * PP + 512 + h * 128, tid);
    stage128(V, P + (size_t)row0 * PP + 1024 + h * 128, tid);
    const bf16_t* Sf = SR + ((size_t)((0 * 2 + b) * 4 + h) * 66 + tc) * 16384;
    const bf16_t* Sb = SR + ((size_t)((1 * 2 + b) * 4 + h) * 66 + tc) * 16384;
    u32x4 sfr[4], sbr[4];
#pragma unroll
    for (int i = 0; i < 4; ++i) { sfr[i] = *(const u32x4*)(Sf + (size_t)(tid + NTHREADS * i) * 8); sbr[i] = *(const u32x4*)(Sb + (size_t)(tid + NTHREADS * i) * 8); }
    __syncthreads();
    const int g = lane >> 4, q = (lane & 15) >> 2, p = lane & 3, fr = lane & 15, fq = g;
    const int i0 = 16 * wave;
    const unsigned base = (unsigned)(size_t)lds;
    bf16x8 qf[4];
#pragma unroll
    for (int ks = 0; ks < 4; ++ks) qf[ks] = row_frag(Q, PT128, i0, 32 * ks, fr, fq);
    u32x2 scp[8];
#pragma unroll
    for (int jb = 0; jb < 8; ++jb) {
        f32x4 a = (f32x4){0.f, 0.f, 0.f, 0.f};
#pragma unroll
        for (int ks = 0; ks < 4; ++ks) a = MFMA16(row_frag(K, PT128, 16 * jb, 32 * ks, fr, fq), qf[ks], a);
        const int i = i0 + fr;
#pragma unroll
        for (int e = 0; e < 4; ++e) { const float dd = (float)(i - (16 * jb + 4 * fq + e)); const float dcy = __expf(fmaxf(dd, 0.f) * lgf + fmaxf(-dd, 0.f) * lgb) * (2.0f - fminf(fabsf(dd), 1.0f)); a[e] *= dcy; }
        scp[jb].x = pg8::cvt_pk_bf16(a[0], a[1]); scp[jb].y = pg8::cvt_pk_bf16(a[2], a[3]);
        asm volatile("" ::: "memory");
    }
    f32x4 ao[8];
#pragma unroll
    for (int y = 0; y < 8; ++y) ao[y] = (f32x4){0.f, 0.f, 0.f, 0.f};
#pragma unroll
    for (int s2 = 0; s2 < 4; ++s2) {
        const bf16x8 xs = mk8(scp[2 * s2], scp[2 * s2 + 1]);
        const int r = 32 * s2 + 4 * g + q;
        bf16x8 vf[8];
        tr8(base + 2 * IMG128 + r * PT128 + 8 * p, base + 2 * IMG128 + (r + 16) * PT128 + 8 * p, vf);
#pragma unroll
        for (int y = 0; y < 8; ++y) ao[y] = MFMA16(vf[y], xs, ao[y]);
    }
    __syncthreads();
#pragma unroll
    for (int i = 0; i < 4; ++i) { const int v = tid + NTHREADS * i, dv = v >> 4, ch = v & 15;
        *(LAS u32x4*)(Q + dv * PT128 + ch * 16) = sfr[i]; *(LAS u32x4*)(K + dv * PT128 + ch * 16) = sbr[i]; }
    __syncthreads();
    const float qsf = __expf((float)(i0 + fr + 1) * lgf), qsb = __expf((float)(128 - i0 - fr) * lgb);
#pragma unroll
    for (int ks = 0; ks < 4; ++ks) {
        const bf16x8 xf = __builtin_bit_cast(bf16x8, scale8(__builtin_bit_cast(u32x4, qf[ks]), qsf)), xb = __builtin_bit_cast(bf16x8, scale8(__builtin_bit_cast(u32x4, qf[ks]), qsb));
#pragma unroll
        for (int y = 0; y < 8; ++y) ao[y] = MFMA16(row_frag(Q, PT128, 16 * y, 32 * ks, fr, fq), xf, ao[y]);
#pragma unroll
        for (int y = 0; y < 8; ++y) ao[y] = MFMA16(row_frag(K, PT128, 16 * y, 32 * ks, fr, fq), xb, ao[y]);
        asm volatile("" ::: "memory");
    }
    float s1 = 0.f, sq = 0.f;
#pragma unroll
    for (int y = 0; y < 8; ++y) s1 += (ao[y][0] + ao[y][1]) + (ao[y][2] + ao[y][3]);
    s1 += __shfl_xor(s1, 16); s1 += __shfl_xor(s1, 32);
    const float mu = s1 * (1.0f / 128.0f);
#pragma unroll
    for (int y = 0; y < 8; ++y)
#pragma unroll
        for (int e = 0; e < 4; ++e) { const float dlt = ao[y][e] - mu; sq += dlt * dlt; }
    sq += __shfl_xor(sq, 16); sq += __shfl_xor(sq, 32);
    const float rstd = 1.0f / sqrtf(sq * (1.0f / 128.0f) + EPS);
    const int row = row0 + i0 + fr;
    const bf16_t* gp = P + (size_t)row * PP + 1536 + h * 128 + 4 * fq;
    bf16_t* op = Hm + (size_t)row * D + h * 128 + 4 * fq;
    const float* wp = normw + h * 128 + 4 * fq;
#pragma unroll
    for (int y = 0; y < 8; ++y) {
        const u32x2 gt = *(const u32x2*)(gp + 16 * y); const f32x4 w = *(const f32x4*)(wp + 16 * y);
        u32x2 o;
        o.x = pk2((ao[y][0] - mu) * rstd * w.x * bflo(gt.x), (ao[y][1] - mu) * rstd * w.y * bfhi(gt.x));
        o.y = pk2((ao[y][2] - mu) * rstd * w.z * bflo(gt.y), (ao[y][3] - mu) * rstd * w.w * bfhi(gt.y));
        *(u32x2*)(op + 16 * y) = o;
    }
    __syncthreads();
}

__device__ __forceinline__ void p8_gla_item(LAS unsigned char* lds, const bf16_t* P, const float* LR, const bf16_t* SG, bf16_t* Hm, const float* wf, const float* bfv, const float* wb, const float* bbv,
                                            const float* normw, int item, int tid, int wave, int lane) {
    asm volatile("" : "+v"(tid), "+v"(lane));
    const int c = item & 63, bh = item >> 6, h = bh & 3, b = bh >> 2;
    const int row0 = b * 8192 + c * 128;
    LAS unsigned char* QF = lds; LAS unsigned char* KF = lds + IMG64; LAS unsigned char* QB = lds + 2 * IMG64; LAS unsigned char* KB = lds + 3 * IMG64; LAS unsigned char* V = lds + 4 * IMG64;
    LAS float* tot = (LAS float*)(lds + 4 * IMG64 + IMG128);
    stage128(V, P + (size_t)row0 * PP + 2560 + h * 128, tid);
    const bf16_t* Sf = SG + ((size_t)((0 * 2 + b) * 4 + h) * 132 + 4 + 2 * c) * 8192;
    const bf16_t* Sb = SG + ((size_t)((1 * 2 + b) * 4 + h) * 132 + 4 + 2 * c) * 8192;
    u32x4 sfr[4], sbr[4];
#pragma unroll
    for (int i = 0; i < 4; ++i) { sfr[i] = *(const u32x4*)(Sf + (size_t)(tid + NTHREADS * i) * 8); sbr[i] = *(const u32x4*)(Sb + (size_t)(tid + NTHREADS * i) * 8); }
    const int d = tid & 63, sub = wave >> 2, wl = wave & 3;
    bf16_t qraw[16], kraw[16];
#pragma unroll
    for (int t = 0; t < 16; ++t) { const bf16_t* pr = P + (size_t)(row0 + 16 * wave + t) * PP + h * 64 + d; qraw[t] = pr[2048]; kraw[t] = pr[2304]; }
    float bf[16], bb[16], totf, totb;
    gla_gates(lds, tot, LR, wf, bfv, wb, bbv, row0, h, tid, wave, bf, bb, totf, totb);
#pragma unroll
    for (int t = 0; t < 16; ++t) {
        const int tok = 16 * wave + t;
        const float qv = bf2f(qraw[t]), kv = bf2f(kraw[t]);
        const float ef = __expf(bf[t]), eb = __expf(bb[t]);
        *(LAS bf16_t*)(QF + tok * PT64 + d * 2) = (bf16_t)cvtpk(qv * ef, 0.f);
        *(LAS bf16_t*)(KF + tok * PT64 + d * 2) = (bf16_t)cvtpk(kv * __builtin_amdgcn_rcpf(ef), 0.f);
        *(LAS bf16_t*)(QB + tok * PT64 + d * 2) = (bf16_t)cvtpk(qv * eb, 0.f);
        *(LAS bf16_t*)(KB + tok * PT64 + d * 2) = (bf16_t)cvtpk(kv * __builtin_amdgcn_rcpf(eb), 0.f);
    }
    __syncthreads();
    const int g = lane >> 4, q = (lane & 15) >> 2, p = lane & 3, fr = lane & 15, fq = g;
    const int i0 = sub * 64 + 16 * wl;
    const unsigned base = (unsigned)(size_t)lds;
    bf16x8 qff[2], qbf[2];
#pragma unroll
    for (int ks = 0; ks < 2; ++ks) { qff[ks] = row_frag(QF, PT64, i0, 32 * ks, fr, fq); qbf[ks] = row_frag(QB, PT64, i0, 32 * ks, fr, fq); }
    u32x2 scp[4];
#pragma unroll
    for (int jb = 0; jb < 4; ++jb) {
        f32x4 a = (f32x4){0.f, 0.f, 0.f, 0.f}, a2 = (f32x4){0.f, 0.f, 0.f, 0.f};
#pragma unroll
        for (int ks = 0; ks < 2; ++ks) { a = MFMA16(row_frag(KF, PT64, sub * 64 + 16 * jb, 32 * ks, fr, fq), qff[ks], a); a2 = MFMA16(row_frag(KB, PT64, sub * 64 + 16 * jb, 32 * ks, fr, fq), qbf[ks], a2); }
        const int il = 16 * wl + fr;
        float v[4];
#pragma unroll
        for (int e = 0; e < 4; ++e) { const float dd = (float)(il - (16 * jb + 4 * fq + e)); v[e] = a[e] * fminf(fmaxf(dd + 1.0f, 0.f), 1.0f) + a2[e] * fminf(fmaxf(1.0f - dd, 0.f), 1.0f); }
        scp[jb].x = pg8::cvt_pk_bf16(v[0], v[1]); scp[jb].y = pg8::cvt_pk_bf16(v[2], v[3]);
        asm volatile("" ::: "memory");
    }
    f32x4 ao[8];
#pragma unroll
    for (int y = 0; y < 8; ++y) ao[y] = (f32x4){0.f, 0.f, 0.f, 0.f};
#pragma unroll
    for (int s2 = 0; s2 < 2; ++s2) {
        const bf16x8 xs = mk8(scp[2 * s2], scp[2 * s2 + 1]);
        const int r = sub * 64 + 32 * s2 + 4 * g + q;
        bf16x8 vf[8];
        tr8(base + 4 * IMG64 + r * PT128 + 8 * p, base + 4 * IMG64 + (r + 16) * PT128 + 8 * p, vf);
#pragma unroll
        for (int y = 0; y < 8; ++y) ao[y] = MFMA16(vf[y], xs, ao[y]);
    }
    __syncthreads();
#pragma unroll
    for (int i = 0; i < 4; ++i) { const int v = tid + NTHREADS * i, m = v >> 10, dv = (v >> 3) & 127, ch = v & 7;
        *(LAS u32x4*)(lds + m * IMG64 + dv * PT64 + ch * 16) = sfr[i]; *(LAS u32x4*)(lds + (2 + m) * IMG64 + dv * PT64 + ch * 16) = sbr[i]; }
    __syncthreads();
    const LAS unsigned char* SFI = lds + sub * IMG64; const LAS unsigned char* SBI = lds + (2 + sub) * IMG64;
#pragma unroll
    for (int ks = 0; ks < 2; ++ks) {
#pragma unroll
        for (int y = 0; y < 8; ++y) ao[y] = MFMA16(row_frag(SFI, PT64, 16 * y, 32 * ks, fr, fq), qff[ks], ao[y]);
#pragma unroll
        for (int y = 0; y < 8; ++y) ao[y] = MFMA16(row_frag(SBI, PT64, 16 * y, 32 * ks, fr, fq), qbf[ks], ao[y]);
        asm volatile("" ::: "memory");
    }
    float ss = 0.f;
#pragma unroll
    for (int y = 0; y < 8; ++y)
#pragma unroll
        for (int e = 0; e < 4; ++e) ss += ao[y][e] * ao[y][e];
    ss += __shfl_xor(ss, 16); ss += __shfl_xor(ss, 32);
    const float rstd = 1.0f / sqrtf(ss * (1.0f / 128.0f) + EPS);
    const int row = row0 + i0 + fr;
    const bf16_t* gp = P + (size_t)row * PP + 3072 + h * 128 + 4 * fq;
    bf16_t* op = Hm + (size_t)row * D + 512 + h * 128 + 4 * fq;
    const float* wp = normw + h * 128 + 4 * fq;
#pragma unroll
    for (int y = 0; y < 8; ++y) {
        const u32x2 gt = *(const u32x2*)(gp + 16 * y); const f32x4 w = *(const f32x4*)(wp + 16 * y);
        u32x2 o;
        o.x = pk2(ao[y][0] * rstd * w.x * bflo(gt.x), ao[y][1] * rstd * w.y * bfhi(gt.x));
        o.y = pk2(ao[y][2] * rstd * w.z * bflo(gt.y), ao[y][3] * rstd * w.w * bfhi(gt.y));
        *(u32x2*)(op + 16 * y) = o;
    }
    __syncthreads();
}

#define XB_TMO      128
#define XB_XCNT(j)  (256  + 64 * (j))
#define XB_XSUB(j)  (1280 + 64 * (j))
#define XB_XGEN(j)  (2304 + 64 * (j))
#define XB_TOP      3328
#define XB_TOPGEN   3392
#define XCD_BAR_WORDS 3456
#define XB_SPIN_CAP (1u << 18)

__device__ __forceinline__ unsigned xb_ld(unsigned* p)              { return __hip_atomic_load(p, __ATOMIC_RELAXED, __HIP_MEMORY_SCOPE_AGENT); }
__device__ __forceinline__ unsigned xb_add(unsigned* p, unsigned v) { return __hip_atomic_fetch_add(p, v, __ATOMIC_RELAXED, __HIP_MEMORY_SCOPE_AGENT); }
__device__ __forceinline__ unsigned xb_xcc_id() { return (unsigned)__builtin_amdgcn_s_getreg((3 << 11) | 20) & 0xFu; }
#define XB_SPIN(cond, bar) do { unsigned _sp = 0; while (cond) { __builtin_amdgcn_s_sleep(1); \
    if ((++_sp & 255u) == 0u) { if (xb_ld(&(bar)[XB_TMO])) break; if (_sp > XB_SPIN_CAP) { atomicAdd(&(bar)[XB_TMO], 1u); break; } } } } while (0)

struct XcdBarrier {
    unsigned* bar; unsigned x;
    volatile LAS unsigned* st;
};

__device__ __forceinline__ XcdBarrier xcd_barrier_post(unsigned* bar, volatile LAS unsigned* st) {
    XcdBarrier b; b.bar = bar; b.x = xb_xcc_id(); b.st = st;
    if (threadIdx.x == 0) (void)xb_add(&bar[XB_XCNT(b.x)], 1u);
    return b;
}
__device__ __forceinline__ void xcd_barrier_complete(unsigned* bar, unsigned x, unsigned& nloc, unsigned& nx) {
    const unsigned G = gridDim.x * gridDim.y * gridDim.z;
    unsigned sum, cnt, mine, sp = 0u;
    for (;;) {
        sum = 0u; cnt = 0u; mine = 0u;
#pragma unroll
        for (unsigned j = 0; j < 16; ++j) { const unsigned c = xb_ld(&bar[XB_XCNT(j)]); sum += c; cnt += (c > 0u) ? 1u : 0u; mine = (j == x) ? c : mine; }
        if (sum == G) break;
        __builtin_amdgcn_s_sleep(1);
        if ((++sp & 255u) == 0u) { if (xb_ld(&bar[XB_TMO])) break; if (sp > XB_SPIN_CAP) { atomicAdd(&bar[XB_TMO], 1u); break; } }
    }
    nloc = mine > 0u ? mine : 1u; nx = cnt > 0u ? cnt : 1u;
}

__device__ __forceinline__ void xcd_barrier(const XcdBarrier& b) {
    asm volatile("s_waitcnt vmcnt(0)" ::: "memory");
    __syncthreads();
    if (threadIdx.x == 0) {
        unsigned* bar = b.bar;
        __builtin_amdgcn_s_waitcnt(0);
        unsigned nloc = b.st[0], nx = b.st[1];
        if (nloc == 0u) { xcd_barrier_complete(bar, b.x, nloc, nx); b.st[0] = nloc; b.st[1] = nx; }
        const unsigned old = xb_add(&bar[XB_XSUB(b.x)], 1u);
        const unsigned gen = old / nloc;
        if (old + 1u == (gen + 1u) * nloc) {
            __builtin_amdgcn_fence(__ATOMIC_RELEASE, "agent");
            asm volatile("s_waitcnt vmcnt(0)" ::: "memory");
            const unsigned og = xb_add(&bar[XB_TOP], 1u);
            const unsigned tg = og / nx;
            if (og + 1u == (tg + 1u) * nx) xb_add(&bar[XB_TOPGEN], 1u);
            else XB_SPIN(xb_ld(&bar[XB_TOPGEN]) == tg, bar);
            __builtin_amdgcn_fence(__ATOMIC_ACQUIRE, "agent");
            xb_add(&bar[XB_XGEN(b.x)], 1u);
            asm volatile("s_waitcnt vmcnt(0)" ::: "memory");
        } else {
            XB_SPIN(xb_ld(&bar[XB_XGEN(b.x)]) == gen, bar);
            __builtin_amdgcn_fence(__ATOMIC_ACQUIRE, "agent");
            asm volatile("s_waitcnt vmcnt(0)" ::: "memory");
        }
    }
    __syncthreads();
}


__device__ __attribute__((noinline)) void xcd_barrier_ool(unsigned* barp, unsigned x, volatile LAS unsigned* st) { XcdBarrier b; b.bar = barp; b.x = x; b.st = st; xcd_barrier(b); }

#ifndef PHM
#define PHM 0xffff
#endif
struct Args { const float* in[26]; float* out; unsigned char* ws; };
enum { I_X = 0, I_C, I_CTX, I_CCTX, I_ADAW, I_ADAB, I_N1W, I_F1W1, I_F1W3, I_F1W2, I_N2W, I_WIN, I_RDF, I_RDB, I_RNW, I_GWF, I_GBF, I_GWB, I_GBB, I_GNW, I_WOUT, I_N3W, I_F2W1, I_F2W3, I_F2W2, I_FNW };

#ifndef P6SKIP
#define P6SKIP 0
#endif
#ifndef PROBE
#define PROBE 0
#endif
#ifndef PHSKIP
#define PHSKIP 0
#endif
template <int ph> __device__ __forceinline__ void run_phase(LAS unsigned char* lds, const int G, const int NGW, const bool probe_dst = false) {
    if (PHSKIP & (1 << ph)) return;
        int tid = threadIdx.x; asm volatile("" : "+v"(tid));
        int bid = blockIdx.x; asm volatile("" : "+s"(bid));
        const int lane = tid & 63, wave = __builtin_amdgcn_readfirstlane(tid >> 6), gw = bid * 8 + wave;
        const __attribute__((address_space(4))) char* kargs = (const __attribute__((address_space(4))) char*)__builtin_amdgcn_kernarg_segment_ptr(); asm volatile("" : "+s"(kargs));
        unsigned char* ws = *(unsigned char* const __attribute__((address_space(4)))*)(kargs + 8 * 27);
        float* out = *(float* const __attribute__((address_space(4)))*)(kargs + 8 * 26);
#define INP(i) (*(const float* const __attribute__((address_space(4)))*)(kargs + 8 * (i)))
        float* part = (float*)(ws + WS_PART); float* mods = (float*)(ws + WS_MODS); float* LR = (float*)(ws + WS_LR); float* X1C = (float*)(ws + WS_X1C); float* DG = (float*)(ws + WS_DG);
        bf16_t* W13 = (bf16_t*)(ws + WS_W13); bf16_t* W2 = (bf16_t*)(ws + WS_W2); bf16_t* WIN = (bf16_t*)(ws + WS_WIN); bf16_t* WOUT = (bf16_t*)(ws + WS_WOUT);
        bf16_t* H = (bf16_t*)(ws + WS_H); bf16_t* GP = (bf16_t*)(ws + WS_GP); bf16_t* SR = (bf16_t*)(ws + WS_SR); bf16_t* SG = (bf16_t*)(ws + WS_SG);
        if (ph == 0 && (PHM & 1)) {
            LAS float* scv = (LAS float*)lds;
            LAS f32x4* red = (LAS f32x4*)(lds + 1024);
            for (int it = bid; it < 288; it += G) {
                const int s = it / 18, cc = it % 18;
                if (tid < 192) { const int cond = tid >> 6, k = s * 64 + (tid & 63); const float v = cond < 2 ? INP(I_C)[cond * D + k] : INP(I_CCTX)[k]; scv[tid] = v / (1.0f + expf(-v)); }
                __syncthreads();
                const int cg4 = tid & 127, ks = tid >> 7;
                f32x4 acc[3] = {(f32x4){0.f, 0.f, 0.f, 0.f}, (f32x4){0.f, 0.f, 0.f, 0.f}, (f32x4){0.f, 0.f, 0.f, 0.f}};
                const float* wp = INP(I_ADAW) + (size_t)(s * 64 + ks * 16) * NMODS + cc * 512 + cg4 * 4;
#pragma unroll
                for (int kk = 0; kk < 16; ++kk) { const f32x4 w = __builtin_nontemporal_load((const f32x4*)(wp + (size_t)kk * NMODS));
#pragma unroll
                    for (int cnd = 0; cnd < 3; ++cnd) acc[cnd] += w * scv[cnd * 64 + ks * 16 + kk]; }
#pragma unroll
                for (int cnd = 0; cnd < 3; ++cnd) red[(ks * 3 + cnd) * 128 + cg4] = acc[cnd];
                __syncthreads();
                if (tid < 384) { const int cnd = tid >> 7, g4 = tid & 127;
                    const f32x4 r = (red[(0 * 3 + cnd) * 128 + g4] + red[(1 * 3 + cnd) * 128 + g4]) + (red[(2 * 3 + cnd) * 128 + g4] + red[(3 * 3 + cnd) * 128 + g4]);
                    *(f32x4*)(part + (size_t)(s * 3 + cnd) * NMODS + cc * 512 + g4 * 4) = r; }
                __syncthreads();
            }
            LAS float* scr = (LAS float*)(lds + wave * 16384);
            convert_ffn(INP(I_F1W1), INP(I_F1W3), INP(I_F1W2), W13, W2, scr, gw, NGW, lane);
            constexpr int IIN = (D / 64) * (NIN / 32), IOUT = (D / 64) * (D / 32);
            for (int it = gw; it < IIN + IOUT; it += NGW) {
                if (it < IIN) transpose_item<2>(INP(I_WIN), D, NIN, WIN, 0, scr, it, lane);
                else transpose_item<0>(INP(I_WOUT), D, D, WOUT, 0, scr, it - IIN, lane);
            }
            for (int v = bid * NTHREADS + tid; v < (NINP - NIN) * D / 8; v += G * NTHREADS) *((u32x4*)(WIN + (size_t)NIN * D) + v) = (u32x4){0u, 0u, 0u, 0u};
        } else if (ph == 1 && (PHM & 2)) {
            for (int g4 = bid * NTHREADS + tid; g4 < 3 * NMODS / 4; g4 += G * NTHREADS) { const int gid = 4 * g4, cond = gid / NMODS, rem = gid % NMODS; f32x4 v = *(const f32x4*)(INP(I_ADAB) + rem);
#pragma unroll
                for (int s = 0; s < 16; ++s) v += *(const f32x4*)(part + (size_t)(s * 3 + cond) * NMODS + rem);
                *(f32x4*)(mods + gid) = v; }
            norm_phase<true, false>(lds, INP(I_X), INP(I_CTX), MROWS, INP(I_N1W), part, INP(I_ADAB), mods, 0, 1, H, nullptr, gw, NGW, tid, lane);
        } else if (ph == 2 && (PHM & 4)) {
            unsigned* cnt = (unsigned*)(ws + WS_CNT);
            { pg8::Gemm g{H, W13, MROWS, 2 * FF, D, D / 64}; CtxFirstOrder S; S.init(G, bid, cnt, (LAS unsigned*)(lds + LDS_BYTES - 64 + 16));
              EpiSwiglu E{GP};
              pg8::gemm_phase<EpiSwiglu, CtxFirstOrder, true, true>(lds, g, S, E); }
            if (bid >= G - 24) {
                if (tid == 0) { while (__hip_atomic_load(cnt, __ATOMIC_RELAXED, __HIP_MEMORY_SCOPE_AGENT) < 44u * 8u) __builtin_amdgcn_s_sleep(4); }
                __builtin_amdgcn_fence(__ATOMIC_ACQUIRE, "agent");
                asm volatile("s_waitcnt vmcnt(0)" ::: "memory");
                __syncthreads();
                const int qd = bid - (G - 24), part3 = qd % 3, tile = qd / 3, k0 = part3 == 0 ? 0 : (part3 == 1 ? 16 * 64 : 30 * 64);
                pg8::Gemm g{GP + (size_t)NLAT * FF + k0, W2 + k0, NCTX, D, FF, part3 == 0 ? 16 : 14}; OneUnit S{tile >> 2, tile & 3};
                EpiCtxAtomic E{(float*)(ws + WS_SR) + (size_t)part3 * NCTX * D, mods};
                pg8::gemm_phase<EpiCtxAtomic, OneUnit, true, true>(lds, g, S, E);
            }
        } else if (ph == 11 && (PHM & 4)) {
            pg8::Gemm g{H, W13, NLAT, 2 * FF, D, D / 64}; pg8::StaticOrder S; S.init(NLAT, 2 * FF, G, bid);
            EpiSwiglu E{GP};
            pg8::gemm_phase<EpiSwiglu, pg8::StaticOrder, true, true>(lds, g, S, E);
        } else if (ph == 12 && (PHM & 8)) {
            pg8::Gemm g{GP, W2, NLAT, D, FF, FF / 64}; pg8::StaticOrder S; S.init(NLAT, D, G, bid);
            EpiResidNorm<0> E{};
            pg8::gemm_phase<EpiResidNorm<0>, pg8::StaticOrder, false, true>(lds, g, S, E);
        } else if (ph == 3 && (PHM & 8)) {
            norm_phase<false, false>(lds, out, INP(I_CTX), MROWS, INP(I_N2W), part, INP(I_ADAB), mods, 3, 4, H, nullptr, gw, NGW, tid, lane, NLAT, (const float*)(ws + WS_SR));
            __syncthreads();
            pg8::Gemm g{GP, W2, NLAT, D, FF, FF / 64}; pg8::StaticOrder S; S.init(NLAT, D, G, bid);
            EpiResidNorm<1> E{};
            pg8::gemm_phase<EpiResidNorm<1>, pg8::StaticOrder, false, true>(lds, g, S, E);
        } else if (ph == 9 && (PHM & 8)) {
            pg8::Gemm g{H, WOUT, NLAT, D, D, D / 64}; pg8::StaticOrder S; S.init(NLAT, D, G, bid);
            EpiResidNorm<2> E{};
            pg8::gemm_phase<EpiResidNorm<2>, pg8::StaticOrder, false, true>(lds, g, S, E);
        } else if (ph == 4 && (PHM & 16)) {
            norm_phase<false, false>(lds, out, X1C, MROWS, INP(I_N2W), part, INP(I_ADAB), mods, 3, 4, H, nullptr, gw, NGW, tid, lane);
        } else if (ph == 5 && (PHM & 32)) {
            pg8::Gemm g{H, WIN, MROWS, NINP, D, D / 64}; pg8::StaticOrder S; S.init(MROWS, NINP, G, bid);
            EpiWin E{GP, LR};
            pg8::gemm_phase<EpiWin, pg8::StaticOrder, true, true>(lds, g, S, E);
        } else if (ph == 6 && (PHM & 64)) {
            unsigned* qctr = (unsigned*)(ws + WS_CNT + 768);
            volatile LAS int* nx = (volatile LAS int*)(lds + LDS_BYTES - 64 + 32);
            int it = bid, k = 0;
            while (it < 1056) {
                if (tid == 0) nx[k & 1] = G + (int)__hip_atomic_fetch_add(qctr, 1u, __ATOMIC_RELAXED, __HIP_MEMORY_SCOPE_AGENT);
                if (it < 528) { if (!(P6SKIP & 2)) p6_gla_item(lds, GP, LR, SG, DG, INP(I_GWF), INP(I_GBF), INP(I_GWB), INP(I_GBB), it, tid, wave, lane); }
                else if (!(P6SKIP & 1)) p6_ret_item(lds, GP, SR, INP(I_RDF), INP(I_RDB), it - 528, tid, wave, lane);
                it = nx[k & 1]; ++k;
            }
            { LAS float* scr = (LAS float*)(lds + wave * 16384); convert_ffn(INP(I_F2W1), INP(I_F2W3), INP(I_F2W2), W13, W2, scr, gw, NGW, lane); }
        } else if (ph == 7 && (PHM & 128)) {
            p7_scan(SR, SG, DG, INP(I_RDF), INP(I_RDB), bid * NTHREADS + tid, G * NTHREADS);
        } else if (ph == 8 && (PHM & 256)) {
            for (int it = bid; it < 1024; it += G) for (int rep = 0; rep < (PROBE == 14 ? 2 : 1); ++rep) {
                if (it < 512) p8_ret_item(lds, GP, SR, H, INP(I_RDF), INP(I_RDB), INP(I_RNW), it, tid, wave, lane);
                else p8_gla_item(lds, GP, LR, SG, H, INP(I_GWF), INP(I_GBF), INP(I_GWB), INP(I_GBB), INP(I_GNW), it - 512, tid, wave, lane);
            }
        } else if (ph == 10 && (PHM & 512)) {
            norm_phase<false, false>(lds, out, X1C, NLAT, INP(I_N3W), part, INP(I_ADAB), mods, 6, 7, H, nullptr, gw, NGW, tid, lane);
        } else if (ph == 13 && (PHM & 1024)) {
            norm_phase<false, true>(lds, out, X1C, NLAT, INP(I_FNW), part, INP(I_ADAB), mods, 0, 0, nullptr, probe_dst ? (float*)(ws + WS_SR) : out, gw, NGW, tid, lane);
        }
}

__global__ void __launch_bounds__(NTHREADS, 2) mk_fwd(Args a) {
    extern __shared__ __attribute__((aligned(16))) unsigned char lds_raw[];
    LAS unsigned char* lds = (LAS unsigned char*)lds_raw;
    cg::grid_group grid = cg::this_grid();
    const int G = gridDim.x, NGW = G * 8;
#ifndef PROBE
#define PROBE 0
#endif
#ifndef PROBE
#define PROBE 0
#endif
    if (gridDim.y == 4242u) grid.sync();
    unsigned* barw = (unsigned*)(a.ws + WS_BAR);
    volatile LAS unsigned* bst = (volatile LAS unsigned*)(lds + LDS_BYTES - 64);
    if (threadIdx.x < 8) bst[threadIdx.x] = 0u;
    __syncthreads();
    XcdBarrier bar = xcd_barrier_post(barw, bst);
#define SEAM() xcd_barrier_ool(bar.bar, bar.x, bar.st)
    run_phase<0>(lds, G, NGW); SEAM();
    run_phase<1>(lds, G, NGW); SEAM();
    run_phase<2>(lds, G, NGW); SEAM();
    run_phase<3>(lds, G, NGW); SEAM();
    run_phase<5>(lds, G, NGW); SEAM();
    run_phase<6>(lds, G, NGW); SEAM();
    run_phase<7>(lds, G, NGW); SEAM();
    run_phase<8>(lds, G, NGW); SEAM();
    run_phase<9>(lds, G, NGW); SEAM();
    run_phase<11>(lds, G, NGW); SEAM();
    run_phase<12>(lds, G, NGW);
}

extern "C" void kernel_launch(void* const* d_in, const int* in_sizes, int n_in, void* d_out, int out_size, void* d_ws, size_t ws_size, hipStream_t stream) {
    static int grid = 0;
    if (grid == 0) {
        if (n_in != 26 || ws_size < WS_END) { fprintf(stderr, "kernel_launch: unexpected n_in %d or ws_size %zu (< %zu)\n", n_in, ws_size, (size_t)WS_END); grid = -1; return; }
        int dev = 0, cus = 0, per_cu = 0;
        hipGetDevice(&dev);
        hipDeviceGetAttribute(&cus, hipDeviceAttributeMultiprocessorCount, dev);
        hipFuncSetAttribute((const void*)mk_fwd, hipFuncAttributeMaxDynamicSharedMemorySize, LDS_BYTES);
        hipOccupancyMaxActiveBlocksPerMultiprocessor(&per_cu, (const void*)mk_fwd, NTHREADS, LDS_BYTES);
        if (per_cu < 1) { fprintf(stderr, "kernel_launch: occupancy query reports %d blocks per CU\n", per_cu); per_cu = 1; }
        grid = cus;
        (void)hipGetLastError();
    }
    if (grid < 0) return;
    if (hipMemsetAsync((char*)d_ws + WS_BAR, 0, 128 * 1024, stream) != hipSuccess) { fprintf(stderr, "kernel_launch: memset of the barrier words failed\n"); return; }
    Args a{};
    for (int i = 0; i < 26; ++i) a.in[i] = (const float*)d_in[i];
    a.out = (float*)d_out; a.ws = (unsigned char*)d_ws;
    void* args[] = {&a};
    hipError_t e = hipLaunchCooperativeKernel((const void*)mk_fwd, dim3(grid), dim3(NTHREADS), args, LDS_BYTES, stream);
    if (e != hipSuccess) fprintf(stderr, "cooperative launch failed: %s (grid %d)\n", hipGetErrorString(e), grid);
}
```

```cpp
#include <hip/hip_runtime.h>
#include <hip/hip_cooperative_groups.h>
#include <cstdio>
#include <cstdint>
namespace cg = cooperative_groups;
namespace pg8 {
#define PG8_LAS __attribute__((address_space(3)))
typedef unsigned short bf16_t;
typedef short bf16x8 __attribute__((ext_vector_type(8)));
typedef float f32x4 __attribute__((ext_vector_type(4)));
typedef unsigned u32x4 __attribute__((ext_vector_type(4)));
constexpr int BM = 256, BK = 64, HALF = 128, HTB = HALF * BK * 2  , STAGE_BYTES = 8 * HTB, NXCD = 8, WGM = 8;

__host__ __device__ __forceinline__ int lds_byte(int r, int c) { const int st = (r >> 4) * 2 + (c >> 5), rr = r & 15, cc = c & 31, ob = rr * 64 + cc * 2; return st * 1024 + (ob ^ (((ob >> 9) & 1) << 5)); }
__host__ __device__ __forceinline__ void stage_rc(int b, int& R, int& C) { const int st = b / 1024, sb = b % 1024, swz = sb ^ (((sb >> 9) & 1) << 5); R = (st >> 1) * 16 + swz / 64; C = (st & 1) * 32 + (swz % 64) / 2; }
__host__ __device__ __forceinline__ int perm32(int rho) { const int n = rho >> 4, i = rho & 15; return 8 * (i >> 2) + 4 * n + (i & 3); }

struct Unit { int pm, pn; };
struct Gemm { const bf16_t* A; const bf16_t* Bt; int M, N, K, KT; };

struct StaticOrder {
    int nM, nN, nwg, G, c;
    __host__ __device__ void init(int M, int N, int G_, int c_) { nM = M / BM; nN = N / BM; nwg = nM * nN; G = G_; c = c_; }
    __host__ __device__ bool next(int i, Unit& u) const {
        const long L = (long)i * G + c; if (L >= nwg) return false;
        int wgid = (int)L; { const int q = nwg / NXCD, r = nwg % NXCD, xcd = wgid % NXCD, off = wgid / NXCD; wgid = (xcd < r ? xcd * (q + 1) : r * (q + 1) + (xcd - r) * q) + off; }
        const int nig = WGM * nN, gid = wgid / nig, fm = gid * WGM, gsz = (nM - fm) < WGM ? (nM - fm) : WGM;
        u.pm = fm + ((wgid % nig) % gsz); u.pn = (wgid % nig) / gsz; return true;
    }
    __device__ __forceinline__ void a_ready(const Unit&) const {}
    __device__ __forceinline__ void done(const Unit&) const {}
};

__device__ __forceinline__ unsigned cvt_pk_bf16(float lo, float hi) { unsigned r; asm volatile("v_cvt_pk_bf16_f32 %0, %1, %2" : "=v"(r) : "v"(lo), "v"(hi)); return r; }
template <class Epi, class Sched, bool ALIGN_EPI = false, bool SP2 = false>
__device__ __forceinline__ void gemm_phase(PG8_LAS unsigned char* lds, const Gemm g, const Sched& S, const Epi& E) {
    const int tid = threadIdx.x, wid = __builtin_amdgcn_readfirstlane(tid >> 6), lane = tid & 63, wr = wid >> 2, wc = wid & 3, fr = lane & 15, fq = lane >> 4;
    const int K = g.K, nt = g.KT;
    unsigned voffA[2], voffB[2];
#pragma unroll
    for (int i = 0; i < 2; ++i) { int R, C; stage_rc(tid * 16 + i * 8192, R, C); const int Rb = Epi::PERM ? ((R & ~31) + perm32(R & 31)) : R;
        voffA[i] = (unsigned)(R * K + C) * 2u; voffB[i] = (unsigned)(Rb * K + C) * 2u; }
    const size_t kstep = (size_t)(BK * 2);
    const size_t hstep = (size_t)HALF * K * 2;
    const size_t tstep = 2 * hstep;
    const unsigned ldsw = (unsigned)wid * 1024u;
    const int aoff = lds_byte(wr * 64 + fr, fq * 8), boff = lds_byte(wc * 32 + fr, fq * 8);
#define PG8_SA(b, h) (((b) * 2 + (h)) * HTB)
#define PG8_SB(b, h) ((4 + (b) * 2 + (h)) * HTB)
#define PG8_STAGE(bufoff, gbase, voff) do { _Pragma("unroll") for (int _i = 0; _i < 2; ++_i) \
        __builtin_amdgcn_global_load_lds((const unsigned*)((const char*)(gbase) + (voff)[_i]), (PG8_LAS unsigned*)(lds + (bufoff) + ldsw + _i * 8192), 16, 0, 0); } while (0)
#define PG8_LDA(dst, b, h) do { _Pragma("unroll") for (int m = 0; m < 4; ++m) _Pragma("unroll") for (int k = 0; k < 2; ++k) dst[m][k] = *(const PG8_LAS bf16x8*)(lds + PG8_SA(b, h) + aoff + m * 2048 + k * 1024); } while (0)
#define PG8_LDB(dst, b, h) do { _Pragma("unroll") for (int n = 0; n < 2; ++n) _Pragma("unroll") for (int k = 0; k < 2; ++k) dst[n][k] = *(const PG8_LAS bf16x8*)(lds + PG8_SB(b, h) + boff + n * 2048 + k * 1024); } while (0)
#define PG8_MMA(ai, bj, At, Bt) do { __builtin_amdgcn_s_setprio(1); _Pragma("unroll") for (int m = 0; m < 4; ++m) _Pragma("unroll") for (int n = 0; n < 2; ++n) _Pragma("unroll") for (int k = 0; k < 2; ++k) \
        acc[ai][bj][m][n] = __builtin_amdgcn_mfma_f32_16x16x32_bf16(Bt[n][k], At[m][k], acc[ai][bj][m][n], 0, 0, 0); __builtin_amdgcn_s_setprio(0); } while (0)
#define PG8_WAIT_V(n) asm volatile("s_waitcnt vmcnt(" #n ")" ::: "memory")
#define PG8_WAIT_L(n) asm volatile("s_waitcnt lgkmcnt(" #n ")" ::: "memory")
#define PG8_BAR __builtin_amdgcn_s_barrier()
#define PG8_SCHED __builtin_amdgcn_sched_barrier(0)
    Unit cur, nxt; int ui = 0;
    if (!S.next(0, cur)) return;
    f32x4 acc[2][2][4][2];
#pragma unroll
    for (int a = 0; a < 2; ++a)
#pragma unroll
        for (int b = 0; b < 2; ++b)
#pragma unroll
            for (int m = 0; m < 4; ++m)
#pragma unroll
                for (int n = 0; n < 2; ++n) acc[a][b][m][n] = (f32x4){0.f, 0.f, 0.f, 0.f};
    bf16x8 At[4][2], B0[2][2], B1[2][2];
    const char* cA = (const char*)g.A + (size_t)cur.pm * tstep; const char* cB = (const char*)g.Bt + (size_t)cur.pn * tstep;
    S.a_ready(cur);
    if constexpr (SP2) {
        PG8_STAGE(PG8_SB(0, 0), cB, voffB); PG8_STAGE(PG8_SB(0, 1), cB + hstep, voffB); PG8_STAGE(PG8_SA(0, 0), cA, voffA); PG8_STAGE(PG8_SA(0, 1), cA + hstep, voffA);
        if (wr == 1) PG8_BAR;
        PG8_WAIT_V(2); PG8_BAR;
        PG8_STAGE(PG8_SB(1, 0), cB + kstep, voffB); PG8_STAGE(PG8_SA(1, 0), cA + kstep, voffA); PG8_STAGE(PG8_SB(1, 1), cB + hstep + kstep, voffB);
        PG8_WAIT_V(6); PG8_BAR;
    } else {
        PG8_STAGE(PG8_SB(0, 0), cB, voffB); PG8_STAGE(PG8_SA(0, 0), cA, voffA); PG8_STAGE(PG8_SB(0, 1), cB + hstep, voffB); PG8_STAGE(PG8_SA(0, 1), cA + hstep, voffA);
        if (wr == 1) PG8_BAR;
        PG8_WAIT_V(4); PG8_BAR;
        PG8_STAGE(PG8_SB(1, 0), cB + kstep, voffB); PG8_STAGE(PG8_SA(1, 0), cA + kstep, voffA); PG8_STAGE(PG8_SB(1, 1), cB + hstep + kstep, voffB);
        PG8_WAIT_V(6); PG8_BAR;
    }
    for (;;) {
        const bool has_next = S.next(ui + 1, nxt);
        const char* nA = has_next ? (const char*)g.A + (size_t)nxt.pm * tstep : cA; const char* nB = has_next ? (const char*)g.Bt + (size_t)nxt.pn * tstep : cB;
        for (int t = 0; t < nt; t += 2) {
            const bool last = (t == nt - 2);
            const char* a1 = cA + (size_t)(t + 1) * kstep;
            const char* a2 = last ? nA : cA + (size_t)(t + 2) * kstep; const char* b2 = last ? nB : cB + (size_t)(t + 2) * kstep;
            const char* a3 = a2 + kstep; const char* b3 = b2 + kstep;
            if (last && has_next) S.a_ready(nxt);
            if constexpr (SP2) {
            PG8_LDB(B0, 0, 0); PG8_LDB(B1, 0, 1); PG8_SCHED; PG8_LDA(At, 0, 0); PG8_STAGE(PG8_SA(1, 1), a1 + hstep, voffA);
            PG8_WAIT_V(8); PG8_WAIT_L(0); PG8_BAR; PG8_MMA(0, 0, At, B0); PG8_MMA(0, 1, At, B1); PG8_BAR; PG8_SCHED;
            PG8_LDA(At, 0, 1); PG8_STAGE(PG8_SB(0, 0), b2, voffB); PG8_STAGE(PG8_SB(0, 1), b2 + hstep, voffB); PG8_STAGE(PG8_SA(0, 0), a2, voffA);
            PG8_WAIT_V(8); PG8_WAIT_L(0); PG8_BAR; PG8_MMA(1, 0, At, B0); PG8_MMA(1, 1, At, B1); PG8_BAR; PG8_SCHED;
            PG8_LDB(B0, 1, 0); PG8_LDB(B1, 1, 1); PG8_SCHED; PG8_LDA(At, 1, 0); PG8_STAGE(PG8_SA(0, 1), a2 + hstep, voffA);
            PG8_WAIT_V(8); PG8_WAIT_L(0); PG8_BAR; PG8_MMA(0, 0, At, B0); PG8_MMA(0, 1, At, B1); PG8_BAR; PG8_SCHED;
            PG8_LDA(At, 1, 1); PG8_STAGE(PG8_SB(1, 0), b3, voffB); PG8_STAGE(PG8_SB(1, 1), b3 + hstep, voffB); PG8_STAGE(PG8_SA(1, 0), a3, voffA);
            PG8_WAIT_V(8); PG8_WAIT_L(0); PG8_BAR; PG8_MMA(1, 0, At, B0); PG8_MMA(1, 1, At, B1); PG8_BAR; PG8_SCHED;
            } else {
            PG8_LDB(B0, 0, 0); PG8_SCHED; PG8_LDA(At, 0, 0); PG8_STAGE(PG8_SA(1, 1), a1 + hstep, voffA);
            PG8_WAIT_L(8); PG8_BAR; PG8_WAIT_L(0); PG8_MMA(0, 0, At, B0); PG8_BAR; PG8_SCHED;
            PG8_LDB(B1, 0, 1); PG8_STAGE(PG8_SB(0, 0), b2, voffB);
            PG8_BAR; PG8_WAIT_L(0); PG8_MMA(0, 1, At, B1); PG8_BAR;
            PG8_LDA(At, 0, 1); PG8_STAGE(PG8_SA(0, 0), a2, voffA);
            PG8_BAR; PG8_WAIT_L(0); PG8_MMA(1, 0, At, B0); PG8_BAR; PG8_SCHED;
            PG8_STAGE(PG8_SB(0, 1), b2 + hstep, voffB);
            PG8_WAIT_V(6); PG8_BAR; PG8_MMA(1, 1, At, B1); PG8_BAR;
            PG8_LDB(B0, 1, 0); PG8_SCHED; PG8_LDA(At, 1, 0); PG8_STAGE(PG8_SA(0, 1), a2 + hstep, voffA);
            PG8_WAIT_L(8); PG8_BAR; PG8_WAIT_L(0); PG8_MMA(0, 0, At, B0); PG8_BAR; PG8_SCHED;
            PG8_LDB(B1, 1, 1); PG8_STAGE(PG8_SB(1, 0), b3, voffB);
            PG8_BAR; PG8_WAIT_L(0); PG8_MMA(0, 1, At, B1); PG8_BAR;
            PG8_LDA(At, 1, 1); PG8_STAGE(PG8_SA(1, 0), a3, voffA);
            PG8_BAR; PG8_WAIT_L(0); PG8_MMA(1, 0, At, B0); PG8_BAR; PG8_SCHED;
            PG8_STAGE(PG8_SB(1, 1), b3 + hstep, voffB);
            PG8_WAIT_V(6); PG8_BAR; PG8_MMA(1, 1, At, B1); PG8_BAR;
            }
        }
        if constexpr (ALIGN_EPI) { if (wr == 0) PG8_BAR; }
        if constexpr (!Epi::AFTER_DRAIN) { E(acc, cur, wr, wc, fr, fq); S.done(cur); }
        if (!has_next) break;
#pragma unroll
        for (int a = 0; a < 2; ++a)
#pragma unroll
            for (int b = 0; b < 2; ++b)
#pragma unroll
                for (int m = 0; m < 4; ++m)
#pragma unroll
                    for (int n = 0; n < 2; ++n) acc[a][b][m][n] = (f32x4){0.f, 0.f, 0.f, 0.f};
        cur = nxt; cA = nA; cB = nB; ++ui;
        if constexpr (ALIGN_EPI) { if (wr == 1) PG8_BAR; }
    }
    PG8_WAIT_V(0);
    if constexpr (!ALIGN_EPI) { if (wr == 0) PG8_BAR; }
    PG8_BAR;
    if constexpr (Epi::AFTER_DRAIN) { E.fused(acc, cur, wr, wc, fr, fq, lds, wid, lane); S.done(cur); }
#undef PG8_SA
#undef PG8_SB
#undef PG8_STAGE
#undef PG8_LDA
#undef PG8_LDB
#undef PG8_MMA
#undef PG8_WAIT_V
#undef PG8_WAIT_L
#undef PG8_BAR
#undef PG8_SCHED
}
}

#define LAS __attribute__((address_space(3)))
#ifndef PROBE
#define PROBE 0
#endif
typedef unsigned short bf16_t;
typedef short bf16x8 __attribute__((ext_vector_type(8)));
typedef float f32x4 __attribute__((ext_vector_type(4)));
typedef unsigned u32x4 __attribute__((ext_vector_type(4)));
typedef unsigned u32x2 __attribute__((ext_vector_type(2)));

constexpr int D = 1024, FF = 2816, NLAT = 16384, NCTX = 512, MROWS = NLAT + NCTX, NIN = 3616, NINP = 3840, PP = 3584  ;
constexpr int NMODS = 9 * D;
constexpr float EPS = 1e-6f;
constexpr int NTHREADS = 512;
constexpr int LDS_BYTES = 144 * 1024;

constexpr size_t MiB = 1u << 20;
constexpr size_t WS_PART = 0;
constexpr size_t WS_BAR  = WS_PART + 1792 * 1024;
constexpr size_t WS_CNT  = WS_BAR + 64 * 1024;
constexpr size_t WS_MODS = WS_PART + 2 * MiB;
constexpr size_t WS_LR   = WS_MODS + 128 * 1024;
constexpr size_t WS_X1C  = WS_LR + (size_t)MROWS * 32 * 4 + 0;
constexpr size_t WS_DG   = WS_X1C + 2 * MiB;
constexpr size_t WS_W13  = WS_DG + 1 * MiB;
constexpr size_t WS_W2   = WS_W13 + (size_t)2 * FF * D * 2;
constexpr size_t WS_WIN  = WS_W2 + (size_t)FF * D * 2;
constexpr size_t WS_WOUT = WS_WIN + (size_t)NINP * D * 2;
constexpr size_t WS_H    = WS_WOUT + (size_t)D * D * 2;
constexpr size_t WS_GP   = WS_H + (size_t)MROWS * D * 2;
constexpr size_t WS_SR   = WS_GP + (size_t)MROWS * PP * 2;
constexpr size_t WS_SG   = WS_SR + (size_t)16 * 66 * 16384 * 2;
constexpr size_t WS_END  = WS_SG + (size_t)16 * 132 * 8192 * 2;
static_assert(WS_END <= 256 * MiB, "workspace over 256 MiB");
static_assert(WS_LR % 256 == 0 && WS_X1C % 256 == 0 && WS_W13 % 256 == 0 && WS_H % 256 == 0 && WS_GP % 256 == 0 && WS_SR % 256 == 0 && WS_SG % 256 == 0, "align");

__device__ __forceinline__ unsigned f2bf(float f) { unsigned u = __builtin_bit_cast(unsigned, f); return (u + 0x7fffu + ((u >> 16) & 1u)) >> 16; }
__device__ __forceinline__ unsigned pk2(float lo, float hi) { return f2bf(lo) | (f2bf(hi) << 16); }
__device__ __forceinline__ unsigned cvtpk(float lo, float hi) { unsigned r; asm("v_cvt_pk_bf16_f32 %0, %1, %2" : "=v"(r) : "v"(lo), "v"(hi)); return r; }
__device__ __forceinline__ float bflo(unsigned u) { return __builtin_bit_cast(float, u << 16); }
__device__ __forceinline__ float bfhi(unsigned u) { return __builtin_bit_cast(float, u & 0xffff0000u); }
__device__ __forceinline__ float bf2f(bf16_t h) { return __builtin_bit_cast(float, (unsigned)h << 16); }
__device__ __forceinline__ float silu_f(float v) { return v * __builtin_amdgcn_rcpf(1.0f + __expf(-v)); }
__device__ __forceinline__ float wave_sum(float v) {
#pragma unroll
    for (int o = 1; o < 64; o <<= 1) v += __shfl_xor(v, o);
    return v;
}
#define LDS_WAIT() asm volatile("s_waitcnt lgkmcnt(0)" ::: "memory")

typedef float f32x2 __attribute__((ext_vector_type(2)));
__device__ __forceinline__ f32x2 swiglu2(f32x2 g, f32x2 u) {
    const f32x2 t = g * (-1.4426950408889634f);
    f32x2 e; e.x = __builtin_amdgcn_exp2f(t.x); e.y = __builtin_amdgcn_exp2f(t.y);
    const f32x2 dn = e + 1.0f;
    f32x2 r; r.x = __builtin_amdgcn_rcpf(dn.x); r.y = __builtin_amdgcn_rcpf(dn.y);
    return (g * u) * r;
}
struct EpiSwiglu {
    static constexpr bool PERM = true, AFTER_DRAIN = false;
    bf16_t* G;
    __device__ __forceinline__ void operator()(const f32x4 (&acc)[2][2][4][2], const pg8::Unit& u, int wr, int wc, int fr, int fq) const {
        const int row0 = u.pm * 256 + wr * 64 + fr, col0 = u.pn * 128 + wc * 32 + 8 * fq;
#pragma unroll
        for (int ai = 0; ai < 2; ++ai)
#pragma unroll
            for (int m = 0; m < 4; ++m) {
                bf16_t* p = G + (size_t)(row0 + ai * 128 + m * 16) * FF + col0;
                const f32x4 g0 = acc[ai][0][m][0], g1 = acc[ai][0][m][1], u0 = acc[ai][1][m][0], u1 = acc[ai][1][m][1];
                const f32x2 a = swiglu2((f32x2){g0[0], g0[1]}, (f32x2){u0[0], u0[1]}), b = swiglu2((f32x2){g0[2], g0[3]}, (f32x2){u0[2], u0[3]});
                const f32x2 c = swiglu2((f32x2){g1[0], g1[1]}, (f32x2){u1[0], u1[1]}), d = swiglu2((f32x2){g1[2], g1[3]}, (f32x2){u1[2], u1[3]});
                u32x4 w;
                w.x = pg8::cvt_pk_bf16(a.x, a.y); w.y = pg8::cvt_pk_bf16(b.x, b.y); w.z = pg8::cvt_pk_bf16(c.x, c.y); w.w = pg8::cvt_pk_bf16(d.x, d.y);
                *(u32x4*)p = w;
            }
    }
};
struct EpiResid {
    static constexpr bool PERM = false, AFTER_DRAIN = false;
    const float* src_lat; const float* src_ctx; float* dst_lat; float* dst_ctx; const float* mods; int midx; float scale;
    __device__ __forceinline__ void operator()(const f32x4 (&acc)[2][2][4][2], const pg8::Unit& u, int wr, int wc, int fr, int fq) const {
        const int cond = u.pm < 32 ? 0 : (u.pm < 64 ? 1 : 2);
        const int col0 = u.pn * 256 + wc * 32 + 4 * fq;
        const float* mrow = mods + cond * NMODS + midx * D + col0;
        f32x4 mv[2][2];
#pragma unroll
        for (int bj = 0; bj < 2; ++bj)
#pragma unroll
            for (int n = 0; n < 2; ++n) mv[bj][n] = *(const f32x4*)(mrow + bj * 128 + n * 16) * scale;
        const bool lat = u.pm < 64;
        const int rbase = (lat ? u.pm * 256 : (u.pm - 64) * 256) + wr * 64 + fr;
        const float* sb = lat ? src_lat : src_ctx; float* db = lat ? dst_lat : dst_ctx;
#pragma unroll
        for (int ai = 0; ai < 2; ++ai)
#pragma unroll
            for (int m = 0; m < 4; ++m) {
                const size_t ro = (size_t)(rbase + ai * 128 + m * 16) * D + col0;
#pragma unroll
                for (int bj = 0; bj < 2; ++bj)
#pragma unroll
                    for (int n = 0; n < 2; ++n) {
                        const f32x4 s = *(const f32x4*)(sb + ro + bj * 128 + n * 16);
                        *(f32x4*)(db + ro + bj * 128 + n * 16) = s + mv[bj][n] * acc[ai][bj][m][n];
                    }
                asm volatile("" ::: "memory");
            }
    }
};
struct EpiWin {
    static constexpr bool PERM = true, AFTER_DRAIN = false;
    bf16_t* P; float* LR;
    __device__ __forceinline__ void operator()(const f32x4 (&acc)[2][2][4][2], const pg8::Unit& u, int wr, int wc, int fr, int fq) const {
        const int pn = u.pn; const int rowb = u.pm * 256 + wr * 64 + fr;
        if (pn == 14) {
            if (wc == 0) {
#pragma unroll
                for (int ai = 0; ai < 2; ++ai)
#pragma unroll
                    for (int m = 0; m < 4; ++m) { float* p = LR + (size_t)(rowb + ai * 128 + m * 16) * 32 + 8 * fq; *(f32x4*)p = acc[ai][0][m][0]; *(f32x4*)(p + 4) = acc[ai][0][m][1]; }
            }
            return;
        }
        const bool rope = (pn < 4) && (u.pm < 64);
        const bool dosilu = (pn == 6) || (pn == 7) || (pn == 12) || (pn == 13);
        const float sc = pn < 2 ? 0.08838834764831845f : (pn == 8 ? 0.125f : 1.0f);
        const int col0 = pn * 256 + wc * 32 + 8 * fq;
        float frq[4];
#pragma unroll
        for (int j = 0; j < 4; ++j) frq[j] = exp2f(-(float)(16 * (wc & 1) + 4 * fq + j) * (13.287712379549449f / 32.0f));
#pragma unroll
        for (int ai = 0; ai < 2; ++ai)
#pragma unroll
            for (int m = 0; m < 4; ++m) {
                const int row = rowb + ai * 128 + m * 16;
                const int tok = row & 8191;
                const float pos = (float)((wc < 2) ? (tok >> 6) : (tok & 63));
#pragma unroll
                for (int bj = 0; bj < 2; ++bj) {
                    f32x4 v0 = acc[ai][bj][m][0] * sc, v1 = acc[ai][bj][m][1] * sc;
                    if (rope) {
#pragma unroll
                        for (int j = 0; j < 4; ++j) { const float ang = pos * frq[j]; const float sn = __sinf(ang), cs = __cosf(ang); const float a = v0[j], b = v1[j]; v0[j] = a * cs - b * sn; v1[j] = a * sn + b * cs; }
                    }
                    if (dosilu) {
#pragma unroll
                        for (int j = 0; j < 4; ++j) { v0[j] = silu_f(v0[j]); v1[j] = silu_f(v1[j]); }
                    }
                    u32x4 w; w.x = pg8::cvt_pk_bf16(v0[0], v0[1]); w.y = pg8::cvt_pk_bf16(v0[2], v0[3]); w.z = pg8::cvt_pk_bf16(v1[0], v1[1]); w.w = pg8::cvt_pk_bf16(v1[2], v1[3]);
                    *(u32x4*)(P + (size_t)row * PP + col0 + bj * 128) = w;
                }
            }
    }
};

struct CtxFirstOrder {
    int nN, nwg, G, c; unsigned* cnt; LAS unsigned* lcnt;
    __device__ void init(int G_, int c_, unsigned* cnt_, LAS unsigned* lcnt_) { nN = 22; nwg = 64 * 22; G = G_; c = c_; cnt = cnt_; lcnt = lcnt_; }
    __device__ bool next(int i, pg8::Unit& u) const {
        long L = (long)i * G + c;
        if (L < 44) { u.pm = 64 + (L >= 22 ? 1 : 0); u.pn = (int)(L % 22); return true; }
        L -= 44; if (L >= nwg) return false;
        int wgid = (int)L; { const int q = nwg / pg8::NXCD, r = nwg % pg8::NXCD, xcd = wgid % pg8::NXCD, off = wgid / pg8::NXCD; wgid = (xcd < r ? xcd * (q + 1) : r * (q + 1) + (xcd - r) * q) + off; }
        const int nig = pg8::WGM * nN, gid = wgid / nig, fm = gid * pg8::WGM, gsz = (64 - fm) < pg8::WGM ? (64 - fm) : pg8::WGM;
        u.pm = fm + ((wgid % nig) % gsz); u.pn = (wgid % nig) / gsz; return true;
    }
    __device__ __forceinline__ void a_ready(const pg8::Unit&) const {}
    __device__ __forceinline__ void done(const pg8::Unit& u) const {
        if (u.pm >= 64) {
            asm volatile("s_waitcnt vmcnt(0)" ::: "memory");
            unsigned old = 0u;
            if ((threadIdx.x & 63) == 0) old = __hip_atomic_fetch_add((LAS unsigned*)lcnt, 1u, __ATOMIC_RELAXED, __HIP_MEMORY_SCOPE_WORKGROUP);
            old = (unsigned)__builtin_amdgcn_readfirstlane((int)old);
            if ((old & 7u) == 7u) { __builtin_amdgcn_fence(__ATOMIC_RELEASE, "agent"); asm volatile("s_waitcnt vmcnt(0)" ::: "memory");
                if ((threadIdx.x & 63) == 0) __hip_atomic_fetch_add(cnt, 8u, __ATOMIC_RELAXED, __HIP_MEMORY_SCOPE_AGENT); }
        }
    }
};
struct OneUnit { int pm, pn;
    __device__ bool next(int i, pg8::Unit& u) const { if (i != 0) return false; u.pm = pm; u.pn = pn; return true; }
    __device__ __forceinline__ void a_ready(const pg8::Unit&) const {}
    __device__ __forceinline__ void done(const pg8::Unit&) const {}
};
struct EpiCtxAtomic {
    static constexpr bool PERM = false, AFTER_DRAIN = false;
    float* slab; const float* mods;
    __device__ __forceinline__ void operator()(const f32x4 (&acc)[2][2][4][2], const pg8::Unit& u, int wr, int wc, int fr, int fq) const {
        const int col0 = u.pn * 256 + wc * 32 + 4 * fq;
        const float* mrow = mods + 2 * NMODS + 2 * D + col0;
        f32x4 mv[2][2];
#pragma unroll
        for (int bj = 0; bj < 2; ++bj)
#pragma unroll
            for (int n = 0; n < 2; ++n) mv[bj][n] = *(const f32x4*)(mrow + bj * 128 + n * 16) * 0.5f;
#pragma unroll
        for (int ai = 0; ai < 2; ++ai)
#pragma unroll
            for (int m = 0; m < 4; ++m) {
                float* rp = slab + (size_t)(u.pm * 256 + ai * 128 + wr * 64 + m * 16 + fr) * D + col0;
#pragma unroll
                for (int bj = 0; bj < 2; ++bj)
#pragma unroll
                    for (int n = 0; n < 2; ++n) *(f32x4*)(rp + bj * 128 + n * 16) = mv[bj][n] * acc[ai][bj][m][n];
            }
    }
};

template <int MODE> struct EpiResidNorm {
    static constexpr bool PERM = false, AFTER_DRAIN = true;
    static constexpr int RMIDX = MODE == 0 ? 8 : (MODE == 1 ? 2 : 5), SH = MODE == 1 ? 3 : 6, SC = MODE == 1 ? 4 : 7, NWI = MODE == 0 ? 25 : (MODE == 1 ? 10 : 21);
    static constexpr float scale = MODE == 2 ? 1.0f : 0.5f;
    __device__ __forceinline__ void operator()(const f32x4 (&)[2][2][4][2], const pg8::Unit&, int, int, int, int) const {}
    __device__ __forceinline__ void fused(f32x4 (&acc)[2][2][4][2], const pg8::Unit& u, int wr, int wc, int fr, int fq, PG8_LAS unsigned char* lds, int wid, int lane) const {
        const __attribute__((address_space(4))) char* ka = (const __attribute__((address_space(4))) char*)__builtin_amdgcn_kernarg_segment_ptr();
        float* dst = *(float* const __attribute__((address_space(4)))*)(ka + 8 * 26);
        const float* src = *(const float* const __attribute__((address_space(4)))*)(ka + 8 * 0);
        unsigned char* wsb = *(unsigned char* const __attribute__((address_space(4)))*)(ka + 8 * 27);
        const bf16_t* srcb = MODE == 2 ? (const bf16_t*)dst : (const bf16_t*)(wsb + WS_SR);
        bf16_t* dstb = MODE == 1 ? (bf16_t*)dst : (bf16_t*)(wsb + WS_SR);
        const float* nw = *(const float* const __attribute__((address_space(4)))*)(ka + 8 * NWI);
        const float* mods = (const float*)(wsb + WS_MODS); float* xbuf = (float*)(wsb + WS_PART) + MODE * 65536; unsigned* pcnt = (unsigned*)(wsb + WS_CNT + 1024) + MODE * 4096;
        const int cond = u.pm < 32 ? 0 : 1;
        const int col0 = u.pn * 256 + wc * 32 + 4 * fq;
        const float* mrow = mods + cond * NMODS + RMIDX * D + col0;
        PG8_LAS float* P = (PG8_LAS float*)lds;
        PG8_LAS float* S = (PG8_LAS float*)(lds + 8192);
        {
            f32x4 mv[2][2];
#pragma unroll
            for (int bj = 0; bj < 2; ++bj)
#pragma unroll
                for (int n = 0; n < 2; ++n) mv[bj][n] = *(const f32x4*)(mrow + bj * 128 + n * 16) * scale;
#pragma unroll
            for (int ai = 0; ai < 2; ++ai)
#pragma unroll
                for (int m = 0; m < 4; ++m) {
                    const int r = ai * 128 + wr * 64 + m * 16 + fr;
                    const size_t ro = (size_t)(u.pm * 256 + r) * D + col0;
                    float sq = 0.f;
#pragma unroll
                    for (int bj = 0; bj < 2; ++bj)
#pragma unroll
                        for (int n = 0; n < 2; ++n) {
                            f32x4 xin;
                            if (MODE == 1) xin = __builtin_nontemporal_load((const f32x4*)(src + ro + bj * 128 + n * 16));
                            else { const u32x2 t = *(const u32x2*)(srcb + ro + bj * 128 + n * 16); xin = (f32x4){bflo(t.x), bfhi(t.x), bflo(t.y), bfhi(t.y)}; }
                            const f32x4 x = xin + mv[bj][n] * acc[ai][bj][m][n]; acc[ai][bj][m][n] = x; sq += (x[0] * x[0] + x[1] * x[1]) + (x[2] * x[2] + x[3] * x[3]);
                            if (MODE != 0) { u32x2 o; o.x = cvtpk(x[0], x[1]); o.y = cvtpk(x[2], x[3]); *(u32x2*)(dstb + ro + bj * 128 + n * 16) = o; } }
                    sq += __shfl_xor(sq, 16); sq += __shfl_xor(sq, 32);
                    if (fq == 0) P[r * 4 + wc] = sq;
                    asm volatile("" ::: "memory");
                }
        }
        asm volatile("s_waitcnt lgkmcnt(0)" ::: "memory"); __builtin_amdgcn_s_barrier(); asm volatile("" ::: "memory");
        const int row = wid * 32 + (lane & 31);
        if (lane < 32) {
            const float t = (P[row * 4 + 0] + P[row * 4 + 1]) + (P[row * 4 + 2] + P[row * 4 + 3]);
            __hip_atomic_store(xbuf + ((size_t)(u.pm * 256 + row) * 4 + u.pn), t, __ATOMIC_RELAXED, __HIP_MEMORY_SCOPE_AGENT);
        }
        asm volatile("s_waitcnt vmcnt(0)" ::: "memory");
        if (lane == 0) __hip_atomic_fetch_add(pcnt + 64 * u.pm, 1u, __ATOMIC_RELAXED, __HIP_MEMORY_SCOPE_AGENT);
        if (wid == 0) {
            unsigned spins = 0;
            while ((unsigned)__builtin_amdgcn_readfirstlane((int)__hip_atomic_load(pcnt + 64 * u.pm, __ATOMIC_RELAXED, __HIP_MEMORY_SCOPE_AGENT)) < 32u) { __builtin_amdgcn_s_sleep(2); if (++spins > (1u << 22)) break; }
            __builtin_amdgcn_fence(__ATOMIC_ACQUIRE, "agent");
        }
        asm volatile("s_waitcnt vmcnt(0) lgkmcnt(0)" ::: "memory"); __builtin_amdgcn_s_barrier(); asm volatile("" ::: "memory");
        if (lane < 32) {
            const unsigned long long* slot = (const unsigned long long*)(xbuf + (size_t)(u.pm * 256 + row) * 4);
            const unsigned long long s01 = __hip_atomic_load(slot, __ATOMIC_RELAXED, __HIP_MEMORY_SCOPE_AGENT), s23 = __hip_atomic_load(slot + 1, __ATOMIC_RELAXED, __HIP_MEMORY_SCOPE_AGENT);
            const float ss = (__builtin_bit_cast(float, (unsigned)s01) + __builtin_bit_cast(float, (unsigned)(s01 >> 32))) + (__builtin_bit_cast(float, (unsigned)s23) + __builtin_bit_cast(float, (unsigned)(s23 >> 32)));
            S[row] = 1.0f / sqrtf(ss * (1.0f / D) + EPS);
        }
        asm volatile("s_waitcnt lgkmcnt(0)" ::: "memory"); __builtin_amdgcn_s_barrier(); asm volatile("" ::: "memory");
        f32x4 wv[2][2], shv[2][2];
#pragma unroll
        for (int bj = 0; bj < 2; ++bj)
#pragma unroll
            for (int n = 0; n < 2; ++n) { wv[bj][n] = *(const f32x4*)(nw + col0 + bj * 128 + n * 16);
                if (MODE != 0) { wv[bj][n] = wv[bj][n] * (*(const f32x4*)(mods + cond * NMODS + SC * D + col0 + bj * 128 + n * 16) + 1.0f); shv[bj][n] = *(const f32x4*)(mods + cond * NMODS + SH * D + col0 + bj * 128 + n * 16); } }
        bf16_t* Hb = (bf16_t*)(wsb + WS_H);
#pragma unroll
        for (int ai = 0; ai < 2; ++ai)
#pragma unroll
            for (int m = 0; m < 4; ++m) {
                const int r = ai * 128 + wr * 64 + m * 16 + fr; const float rs = S[r];
                const size_t ro = (size_t)(u.pm * 256 + r) * D + col0;
#pragma unroll
                for (int bj = 0; bj < 2; ++bj)
#pragma unroll
                    for (int n = 0; n < 2; ++n) {
                        if (MODE == 0) __builtin_nontemporal_store(acc[ai][bj][m][n] * rs * wv[bj][n], (f32x4*)(dst + ro + bj * 128 + n * 16));
                        else { const f32x4 hh = acc[ai][bj][m][n] * rs * wv[bj][n] + shv[bj][n]; u32x2 o; o.x = pk2(hh[0], hh[1]); o.y = pk2(hh[2], hh[3]); *(u32x2*)(Hb + ro + bj * 128 + n * 16) = o; }
                    }
            }
    }
};

template <int MODE> __device__ __forceinline__ int dest_row(int n, int row_off) {
    if (MODE == 0) return n + row_off;
    if (MODE == 1) return (n >> 7) * 256 + (n & 127) + row_off;
    if (n >= 1024) return n;
    const int d = n & 127, half = d >> 6, x = (d >> 5) & 1, i = d & 31;
    const int wc = 2 * half + (i >> 4), fq = (i >> 2) & 3, j = i & 3;
    return (n & ~127) + 32 * wc + 8 * fq + 4 * x + j;
}
template <int MODE> __device__ __forceinline__ void transpose_item(const float* W, int K, int N, bf16_t* WT, int row_off, LAS float* scr, int item, int lane) {
    const int nblk = N / 32, kb = item / nblk, nb = item % nblk, k0 = 64 * kb, n0 = 32 * nb;
    float wv[32];
#pragma unroll
    for (int i = 0; i < 32; ++i) { const int kk = 2 * i + (lane >> 5); wv[i] = __builtin_nontemporal_load(W + (size_t)(k0 + kk) * N + n0 + (lane & 31)); }
#pragma unroll
    for (int i = 0; i < 32; ++i) { const int kk = 2 * i + (lane >> 5); scr[kk * 33 + (lane & 31)] = wv[i]; }
    LDS_WAIT();
    const int c = lane & 7;
#pragma unroll
    for (int j = 0; j < 4; ++j) { const int n = (lane >> 3) + 8 * j; const LAS float* s = scr + (8 * c) * 33 + n;
        u32x4 o; o.x = pk2(s[0 * 33], s[1 * 33]); o.y = pk2(s[2 * 33], s[3 * 33]); o.z = pk2(s[4 * 33], s[5 * 33]); o.w = pk2(s[6 * 33], s[7 * 33]);
        *(u32x4*)(WT + (size_t)dest_row<MODE>(n0 + n, row_off) * K + k0 + 8 * c) = o; }
    LDS_WAIT();
}
__device__ __forceinline__ void convert_ffn(const float* w1, const float* w3, const float* w2, bf16_t* W13, bf16_t* W2, LAS float* scr, int gw, int NGW, int lane) {
    constexpr int I13 = (D / 64) * (FF / 32), I2 = (FF / 64) * (D / 32);
    for (int it = gw; it < 2 * I13 + I2; it += NGW) {
        int r = it;
        if (r < I13) { transpose_item<1>(w1, D, FF, W13, 0, scr, r, lane); continue; } r -= I13;
        if (r < I13) { transpose_item<1>(w3, D, FF, W13, 128, scr, r, lane); continue; } r -= I13;
        transpose_item<0>(w2, FF, D, W2, 0, scr, r, lane);
    }
}

template <bool FROM_PART, bool FINAL>
__device__ __forceinline__ void norm_phase(LAS unsigned char* lds, const float* src_lat, const float* src_ctx, int nrows, const float* nw, const float* part, const float* ada_b, const float* mods,
                                           int shift_idx, int scale_idx, bf16_t* H, float* outf, int gw, int NGW, int tid, int lane, int row_begin = 0, const float* slabs = nullptr) {
    LAS float* tab = (LAS float*)lds;
    if (!FINAL) {
        for (int i4 = tid; i4 < 1536; i4 += NTHREADS) {
            const int idx = 4 * i4, cond = idx >> 11, which = (idx >> 10) & 1, col = idx & 1023, mi = which ? scale_idx : shift_idx;
            if (row_begin >= NLAT && cond != 2) continue;
            f32x4 v;
            if (FROM_PART) { v = *(const f32x4*)(ada_b + mi * D + col);
#pragma unroll
                for (int s = 0; s < 16; ++s) v += *(const f32x4*)(part + (size_t)(s * 3 + cond) * NMODS + mi * D + col); }
            else v = *(const f32x4*)(mods + cond * NMODS + mi * D + col);
            *(LAS f32x4*)(tab + idx) = v;
        }
        __syncthreads();
    }
    f32x4 wv[4];
#pragma unroll
    for (int j = 0; j < 4; ++j) wv[j] = *((const f32x4*)nw + 64 * j + lane);
    for (int row = row_begin + gw; row < nrows; row += 2 * NGW) {
        const int row2 = row + NGW; const bool has2 = row2 < nrows; const int r2 = has2 ? row2 : row;
        const float* xr = row < NLAT ? src_lat + (size_t)row * D : src_ctx + (size_t)(row - NLAT) * D;
        const float* xr2 = r2 < NLAT ? src_lat + (size_t)r2 * D : src_ctx + (size_t)(r2 - NLAT) * D;
        f32x4 v[2][4]; float s[2] = {0.f, 0.f};
#pragma unroll
        for (int j = 0; j < 4; ++j) { v[0][j] = __builtin_nontemporal_load((const f32x4*)xr + 64 * j + lane); v[1][j] = __builtin_nontemporal_load((const f32x4*)xr2 + 64 * j + lane); }
        if (slabs) {
#pragma unroll
            for (int q = 0; q < 2; ++q) { const size_t ro = (size_t)((q ? r2 : row) - NLAT) * D;
#pragma unroll
                for (int j = 0; j < 4; ++j)
#pragma unroll
                    for (int pt = 0; pt < 3; ++pt) v[q][j] += *((const f32x4*)(slabs + (size_t)pt * NCTX * D + ro) + 64 * j + lane); }
        }
#pragma unroll
        for (int q = 0; q < 2; ++q)
#pragma unroll
            for (int j = 0; j < 4; ++j) s[q] += (v[q][j].x * v[q][j].x + v[q][j].y * v[q][j].y) + (v[q][j].z * v[q][j].z + v[q][j].w * v[q][j].w);
#pragma unroll
        for (int q = 0; q < 2; ++q) {
            if (q == 1 && !has2) break;
            const int rr = q ? row2 : row;
            const float rstd = 1.0f / sqrtf(wave_sum(s[q]) * (1.0f / D) + EPS);
            if (FINAL) {
#pragma unroll
                for (int j = 0; j < 4; ++j) *((f32x4*)(outf + (size_t)rr * D) + 64 * j + lane) = v[q][j] * rstd * wv[j];
            } else {
                const int cond = rr < 8192 ? 0 : (rr < NLAT ? 1 : 2);
#pragma unroll
                for (int j = 0; j < 4; ++j) {
                    const f32x4 sh = *((const LAS f32x4*)(tab + (cond * 2 + 0) * 1024) + 64 * j + lane), scl = *((const LAS f32x4*)(tab + (cond * 2 + 1) * 1024) + 64 * j + lane);
                    const f32x4 hh = v[q][j] * rstd * wv[j] * (scl + 1.0f) + sh;
                    u32x2 o; o.x = pk2(hh.x, hh.y); o.y = pk2(hh.z, hh.w);
                    *((u32x2*)(H + (size_t)rr * D) + 64 * j + lane) = o;
                }
            }
        }
    }
}

__device__ __forceinline__ bf16x8 mk8(u32x2 lo, u32x2 hi) { u32x4 t; t.x = lo.x; t.y = lo.y; t.z = hi.x; t.w = hi.y; return __builtin_bit_cast(bf16x8, t); }
__device__ __forceinline__ bf16x8 row_frag(const LAS unsigned char* img, int pitch, int r0, int k0, int fr, int fq) { return *(const LAS bf16x8*)(img + (r0 + fr) * pitch + (k0 + 8 * fq) * 2); }
__device__ __forceinline__ void tr1(unsigned a0, unsigned a1, bf16x8& o) {
    u32x2 l0, h0;
    asm volatile("ds_read_b64_tr_b16 %0, %2\n\tds_read_b64_tr_b16 %1, %3\n\ts_waitcnt lgkmcnt(0)" : "=&v"(l0), "=&v"(h0) : "v"(a0), "v"(a1) : "memory");
    o = mk8(l0, h0);
}
__device__ __forceinline__ void tr2(unsigned a0, unsigned a1, bf16x8 (&o)[2]) {
    u32x2 l0, l1, h0, h1;
    asm volatile("ds_read_b64_tr_b16 %0, %4\n\tds_read_b64_tr_b16 %1, %4 offset:32\n\tds_read_b64_tr_b16 %2, %5\n\tds_read_b64_tr_b16 %3, %5 offset:32\n\ts_waitcnt lgkmcnt(0)"
                 : "=&v"(l0), "=&v"(l1), "=&v"(h0), "=&v"(h1) : "v"(a0), "v"(a1) : "memory");
    o[0] = mk8(l0, h0); o[1] = mk8(l1, h1);
}
__device__ __forceinline__ void tr4(unsigned a0, unsigned a1, bf16x8 (&o)[4]) {
    u32x2 l0, l1, l2, l3, h0, h1, h2, h3;
    asm volatile("ds_read_b64_tr_b16 %0, %8\n\tds_read_b64_tr_b16 %1, %8 offset:32\n\tds_read_b64_tr_b16 %2, %8 offset:64\n\tds_read_b64_tr_b16 %3, %8 offset:96\n\t"
                 "ds_read_b64_tr_b16 %4, %9\n\tds_read_b64_tr_b16 %5, %9 offset:32\n\tds_read_b64_tr_b16 %6, %9 offset:64\n\tds_read_b64_tr_b16 %7, %9 offset:96\n\ts_waitcnt lgkmcnt(0)"
                 : "=&v"(l0), "=&v"(l1), "=&v"(l2), "=&v"(l3), "=&v"(h0), "=&v"(h1), "=&v"(h2), "=&v"(h3) : "v"(a0), "v"(a1) : "memory");
    o[0] = mk8(l0, h0); o[1] = mk8(l1, h1); o[2] = mk8(l2, h2); o[3] = mk8(l3, h3);
}
__device__ __forceinline__ void tr8(unsigned a0, unsigned a1, bf16x8 (&o)[8]) {
    u32x2 l0, l1, l2, l3, l4, l5, l6, l7, h0, h1, h2, h3, h4, h5, h6, h7;
    asm volatile("ds_read_b64_tr_b16 %0, %16\n\tds_read_b64_tr_b16 %1, %16 offset:32\n\tds_read_b64_tr_b16 %2, %16 offset:64\n\tds_read_b64_tr_b16 %3, %16 offset:96\n\t"
                 "ds_read_b64_tr_b16 %4, %16 offset:128\n\tds_read_b64_tr_b16 %5, %16 offset:160\n\tds_read_b64_tr_b16 %6, %16 offset:192\n\tds_read_b64_tr_b16 %7, %16 offset:224\n\t"
                 "ds_read_b64_tr_b16 %8, %17\n\tds_read_b64_tr_b16 %9, %17 offset:32\n\tds_read_b64_tr_b16 %10, %17 offset:64\n\tds_read_b64_tr_b16 %11, %17 offset:96\n\t"
                 "ds_read_b64_tr_b16 %12, %17 offset:128\n\tds_read_b64_tr_b16 %13, %17 offset:160\n\tds_read_b64_tr_b16 %14, %17 offset:192\n\tds_read_b64_tr_b16 %15, %17 offset:224\n\ts_waitcnt lgkmcnt(0)"
                 : "=&v"(l0), "=&v"(l1), "=&v"(l2), "=&v"(l3), "=&v"(l4), "=&v"(l5), "=&v"(l6), "=&v"(l7), "=&v"(h0), "=&v"(h1), "=&v"(h2), "=&v"(h3), "=&v"(h4), "=&v"(h5), "=&v"(h6), "=&v"(h7)
                 : "v"(a0), "v"(a1) : "memory");
    o[0] = mk8(l0, h0); o[1] = mk8(l1, h1); o[2] = mk8(l2, h2); o[3] = mk8(l3, h3); o[4] = mk8(l4, h4); o[5] = mk8(l5, h5); o[6] = mk8(l6, h6); o[7] = mk8(l7, h7);
}
#define MFMA16(a, b, c) __builtin_amdgcn_mfma_f32_16x16x32_bf16((a), (b), (c), 0, 0, 0)

constexpr int PT128 = 288;
constexpr int PT64 = 160;
constexpr int IMG128 = 128 * PT128;
constexpr int IMG64 = 128 * PT64;

__device__ __forceinline__ float logsig(float z) { return fminf(z, 0.f) - __logf(1.0f + __expf(-fabsf(z))); }
__device__ __forceinline__ u32x4 scale8(u32x4 v, float s) {
    u32x4 o;
    o.x = cvtpk(bflo(v.x) * s, bfhi(v.x) * s); o.y = cvtpk(bflo(v.y) * s, bfhi(v.y) * s);
    o.z = cvtpk(bflo(v.z) * s, bfhi(v.z) * s); o.w = cvtpk(bflo(v.w) * s, bfhi(v.w) * s);
    return o;
}
__device__ __forceinline__ void stage128(LAS unsigned char* img, const bf16_t* src, int tid) {
#pragma unroll
    for (int i = 0; i < 4; ++i) { const int v = tid + NTHREADS * i, tok = v >> 4, ch = v & 15;
        *(LAS u32x4*)(img + tok * PT128 + ch * 16) = *(const u32x4*)(src + (size_t)tok * PP + ch * 8); }
}

__device__ __forceinline__ void p6_ret_item(LAS unsigned char* lds, const bf16_t* P, bf16_t* SR, const float* dec_f, const float* dec_b, int item, int tid, int wave, int lane) {
    asm volatile("" : "+v"(tid), "+v"(lane));
    const int tc = item % 66, bh = item / 66, h = bh & 3, b = bh >> 2;
    const int row0 = tc < 2 ? (NLAT + b * 256 + tc * 128) : (b * 8192 + (tc - 2) * 128);
    const float lgf = ((const LAS float*)(lds + LDS_BYTES - 128))[h], lgb = ((const LAS float*)(lds + LDS_BYTES - 128))[4 + h];
    LAS unsigned char* KF = lds; LAS unsigned char* KB = lds + IMG128; LAS unsigned char* V = lds + 2 * IMG128;
    for (int rep1 = 0; rep1 < (PROBE == 19 ? 2 : 1); ++rep1) {
    u32x4 kvr[4], vvr[4];
#pragma unroll
    for (int i = 0; i < 4; ++i) { const int v = tid + NTHREADS * i, tok = v >> 4, ch = v & 15;
        const bf16_t* prow = P + (size_t)(row0 + tok) * PP + h * 128 + ch * 8;
        kvr[i] = *(const u32x4*)(prow + 512); vvr[i] = *(const u32x4*)(prow + 1024); }
#pragma unroll
    for (int i = 0; i < 4; ++i) { const int v = tid + NTHREADS * i, tok = v >> 4, ch = v & 15;
        const float sf = __expf((float)(127 - tok) * lgf), sb = __expf((float)tok * lgb);
        *(LAS u32x4*)(KF + tok * PT128 + ch * 16) = scale8(kvr[i], sf);
        *(LAS u32x4*)(KB + tok * PT128 + ch * 16) = scale8(kvr[i], sb);
        *(LAS u32x4*)(V + tok * PT128 + ch * 16) = vvr[i]; }
    __syncthreads();
    }
    const int g = lane >> 4, q = (lane & 15) >> 2, p = lane & 3, fr = lane & 15, fq = g;
    const int rb = wave >> 1, cb = wave & 1;
    const unsigned base = (unsigned)(size_t)lds;
    f32x4 af[2][4], ab[2][4];
#pragma unroll
    for (int x = 0; x < 2; ++x)
#pragma unroll
        for (int y = 0; y < 4; ++y) { af[x][y] = (f32x4){0.f, 0.f, 0.f, 0.f}; ab[x][y] = (f32x4){0.f, 0.f, 0.f, 0.f}; }
    for (int rep2 = 0; rep2 < (PROBE == 20 ? 2 : 1); ++rep2)
#pragma unroll
    for (int ks = 0; ks < 4; ++ks) {
        const unsigned rofs = (unsigned)((32 * ks + 8 * g + q) * PT128 + 8 * p);
        bf16x8 vf[4], kf[2], kb[2];
        tr4(base + 2 * IMG128 + rofs + 128 * cb, base + 2 * IMG128 + rofs + 128 * cb + 4 * PT128, vf);
        tr2(base + rofs + 64 * rb, base + rofs + 64 * rb + 4 * PT128, kf);
        tr2(base + IMG128 + rofs + 64 * rb, base + IMG128 + rofs + 64 * rb + 4 * PT128, kb);
#pragma unroll
        for (int x = 0; x < 2; ++x)
#pragma unroll
            for (int y = 0; y < 4; ++y) { af[x][y] = MFMA16(kf[x], vf[y], af[x][y]); ab[x][y] = MFMA16(kb[x], vf[y], ab[x][y]); }
    }
    if (PROBE == 20) {
#pragma unroll
        for (int x = 0; x < 2; ++x)
#pragma unroll
            for (int y = 0; y < 4; ++y) { af[x][y] *= 0.5f; ab[x][y] *= 0.5f; } }
    bf16_t* Uf = SR + ((size_t)((0 * 2 + b) * 4 + h) * 66 + tc) * 16384;
    bf16_t* Ub = SR + ((size_t)((1 * 2 + b) * 4 + h) * 66 + tc) * 16384;
    for (int rep3 = 0; rep3 < (PROBE == 21 ? 2 : 1); ++rep3)
#pragma unroll
    for (int x = 0; x < 2; ++x)
#pragma unroll
        for (int y = 0; y < 4; ++y) {
            const int dk = 32 * rb + 16 * x + 4 * fq, dv = 64 * cb + 16 * y + fr;
#ifdef TEST_CLAMP
#pragma unroll
            for (int e = 0; e < 4; ++e) { af[x][y][e] = fminf(fmaxf(af[x][y][e], -1e4f), 1e4f); ab[x][y][e] = fminf(fmaxf(ab[x][y][e], -1e4f), 1e4f); }
#endif
            u32x2 o; o.x = pk2(af[x][y][0], af[x][y][1]); o.y = pk2(af[x][y][2], af[x][y][3]);
            *(u32x2*)(Uf + dv * 128 + dk) = o;
            o.x = pk2(ab[x][y][0], ab[x][y][1]); o.y = pk2(ab[x][y][2], ab[x][y][3]);
            *(u32x2*)(Ub + dv * 128 + dk) = o;
        }
    __syncthreads();
}

constexpr int LRS_OFF = 122880;
__device__ __forceinline__ void gla_gates(LAS unsigned char* lds, LAS float* tot, const float* LR, const float* wf, const float* bfv, const float* wb, const float* bbv, int row0, int h, int tid, int wave,
                                          float (&bf)[16], float (&bb)[16], float& totf, float& totb) {
    const int d = tid & 63, col = h * 64 + d;
    LAS float* lrs = (LAS float*)(lds + LRS_OFF);
    { const f32x4* srcv = (const f32x4*)(LR + (size_t)row0 * 32); const f32x4 v0 = srcv[tid], v1 = srcv[tid + NTHREADS]; *((LAS f32x4*)lrs + tid) = v0; *((LAS f32x4*)lrs + tid + NTHREADS) = v1; }
    f32x2 wf2[8], wb2[8];
#pragma unroll
    for (int r = 0; r < 8; ++r) { wf2[r] = (f32x2){wf[(2 * r) * 256 + col], wf[(2 * r + 1) * 256 + col]}; wb2[r] = (f32x2){wb[(2 * r) * 256 + col], wb[(2 * r + 1) * 256 + col]}; }
    const float biasf = bfv[col], biasb = bbv[col];
    __syncthreads();
#pragma unroll
    for (int t = 0; t < 16; ++t) {
        const LAS float* lr = lrs + (16 * wave + t) * 32;
        f32x2 zf = (f32x2){biasf, 0.f}, zb = (f32x2){biasb, 0.f};
#pragma unroll
        for (int r4 = 0; r4 < 4; ++r4) { const f32x4 a = *(const LAS f32x4*)(lr + 4 * r4), c = *(const LAS f32x4*)(lr + 16 + 4 * r4);
            zf = __builtin_elementwise_fma((f32x2){a.x, a.y}, wf2[2 * r4], zf); zf = __builtin_elementwise_fma((f32x2){a.z, a.w}, wf2[2 * r4 + 1], zf);
            zb = __builtin_elementwise_fma((f32x2){c.x, c.y}, wb2[2 * r4], zb); zb = __builtin_elementwise_fma((f32x2){c.z, c.w}, wb2[2 * r4 + 1], zb); }
        bf[t] = logsig(zf.x + zf.y) * (1.0f / 16.0f); bb[t] = logsig(zb.x + zb.y) * (1.0f / 16.0f);
    }
#pragma unroll
    for (int t = 1; t < 16; ++t) bf[t] += bf[t - 1];
#pragma unroll
    for (int t = 14; t >= 0; --t) bb[t] += bb[t + 1];
    tot[wave * 64 + d] = bf[15]; tot[512 + wave * 64 + d] = bb[0];
    __syncthreads();
    const int sub = wave >> 2, gi = wave & 3;
    float pf = 0.f, sb = 0.f; totf = 0.f; totb = 0.f;
#pragma unroll
    for (int g2 = 0; g2 < 4; ++g2) { const float a = tot[(sub * 4 + g2) * 64 + d], c = tot[512 + (sub * 4 + g2) * 64 + d]; totf += a; totb += c; if (g2 < gi) pf += a; if (g2 > gi) sb += c; }
#pragma unroll
    for (int t = 0; t < 16; ++t) { bf[t] += pf; bb[t] += sb; }
}

__device__ __forceinline__ void p6_gla_item(LAS unsigned char* lds, const bf16_t* P, const float* LR, bf16_t* SG, float* DG, const float* wf, const float* bfv, const float* wb, const float* bbv,
                                            int item, int tid, int wave, int lane) {
    asm volatile("" : "+v"(tid), "+v"(lane));
    const int tc = item % 66, bh = item / 66, h = bh & 3, b = bh >> 2;
    const int row0 = tc < 2 ? (NLAT + b * 256 + tc * 128) : (b * 8192 + (tc - 2) * 128);
    LAS unsigned char* KF = lds; LAS unsigned char* KB = lds + IMG64; LAS unsigned char* V = lds + 2 * IMG64; LAS float* tot = (LAS float*)(lds + 2 * IMG64 + IMG128);
    stage128(V, P + (size_t)row0 * PP + 2560 + h * 128, tid);
    const int d = tid & 63, sub = wave >> 2;
    bf16_t kraw[16];
#pragma unroll
    for (int t = 0; t < 16; ++t) kraw[t] = P[(size_t)(row0 + 16 * wave + t) * PP + 2304 + h * 64 + d];
    float bf[16], bb[16], totf, totb;
    gla_gates(lds, tot, LR, wf, bfv, wb, bbv, row0, h, tid, wave, bf, bb, totf, totb);
    const int chf = (0 * 2 + b) * 4 + h, chb = (1 * 2 + b) * 4 + h, tc64 = 2 * tc + sub;
#pragma unroll
    for (int t = 0; t < 16; ++t) {
        const int tok = 16 * wave + t;
        const float kv = bf2f(kraw[t]);
        *(LAS bf16_t*)(KF + tok * PT64 + d * 2) = (bf16_t)cvtpk(kv * __expf(totf - bf[t]), 0.f);
        *(LAS bf16_t*)(KB + tok * PT64 + d * 2) = (bf16_t)cvtpk(kv * __expf(totb - bb[t]), 0.f);
    }
    if ((wave & 3) == 0) { DG[((size_t)chf * 132 + tc64) * 64 + d] = __expf(totf); DG[((size_t)chb * 132 + tc64) * 64 + d] = __expf(totb); }
    __syncthreads();
    const int g = lane >> 4, q = (lane & 15) >> 2, p = lane & 3, fr = lane & 15, fq = g, wl = wave & 3;
    const unsigned base = (unsigned)(size_t)lds;
    f32x4 af[8], ab[8];
#pragma unroll
    for (int y = 0; y < 8; ++y) { af[y] = (f32x4){0.f, 0.f, 0.f, 0.f}; ab[y] = (f32x4){0.f, 0.f, 0.f, 0.f}; }
#pragma unroll
    for (int ks = 0; ks < 2; ++ks) {
        const int r = sub * 64 + 32 * ks + 8 * g + q;
        bf16x8 vf[8], xf, xb;
        tr8(base + 2 * IMG64 + r * PT128 + 8 * p, base + 2 * IMG64 + (r + 4) * PT128 + 8 * p, vf);
        tr1(base + r * PT64 + 32 * wl + 8 * p, base + (r + 4) * PT64 + 32 * wl + 8 * p, xf);
        tr1(base + IMG64 + r * PT64 + 32 * wl + 8 * p, base + IMG64 + (r + 4) * PT64 + 32 * wl + 8 * p, xb);
#pragma unroll
        for (int y = 0; y < 8; ++y) { af[y] = MFMA16(xf, vf[y], af[y]); ab[y] = MFMA16(xb, vf[y], ab[y]); }
    }
    bf16_t* Uf = SG + ((size_t)chf * 132 + tc64) * 8192;
    bf16_t* Ub = SG + ((size_t)chb * 132 + tc64) * 8192;
#pragma unroll
    for (int y = 0; y < 8; ++y) {
        const int dk = 16 * wl + 4 * fq, dv = 16 * y + fr;
        u32x2 o; o.x = pk2(af[y][0], af[y][1]); o.y = pk2(af[y][2], af[y][3]);
        *(u32x2*)(Uf + dv * 64 + dk) = o;
        o.x = pk2(ab[y][0], ab[y][1]); o.y = pk2(ab[y][2], ab[y][3]);
        *(u32x2*)(Ub + dv * 64 + dk) = o;
    }
    __syncthreads();
}

__device__ __forceinline__ void p7_scan(bf16_t* SR, bf16_t* SG, const float* DG, const float* dec_f, const float* dec_b, int gtid, int gthreads) {
    for (int task = gtid; task < 65536 + 32768; task += gthreads) {
        if (task < 65536) {
            const int chain = task >> 12, e4 = task & 4095, dir = chain >> 3, h = chain & 3;
            const float lg = -log1pf(expf(-(dir ? dec_b[h] : dec_f[h])));
            const float dec = expf(128.0f * lg);
            bf16_t* basep = SR + (size_t)chain * 66 * 16384 + e4 * 4;
            f32x4 s = (f32x4){0.f, 0.f, 0.f, 0.f};
            for (int n0 = 0; n0 < 66; n0 += 11) {
                u32x2 u[11];
#pragma unroll
                for (int i = 0; i < 11; ++i) { const int n = n0 + i; const int tc = dir ? (n < 2 ? 1 - n : 67 - n) : n; u[i] = __builtin_nontemporal_load((const u32x2*)(basep + (size_t)tc * 16384)); }
#pragma unroll
                for (int i = 0; i < 11; ++i) { const int n = n0 + i; const int tc = dir ? (n < 2 ? 1 - n : 67 - n) : n;
                    u32x2 o; o.x = pk2(s.x, s.y); o.y = pk2(s.z, s.w);
                    *(u32x2*)(basep + (size_t)tc * 16384) = o;
                    s.x = dec * s.x + bflo(u[i].x); s.y = dec * s.y + bfhi(u[i].x); s.z = dec * s.z + bflo(u[i].y); s.w = dec * s.w + bfhi(u[i].y); }
            }
        } else {
            const int t2 = task - 65536, chain = t2 >> 11, e4 = t2 & 2047, dir = chain >> 3, dk0 = (e4 * 4) & 63;
            bf16_t* basep = SG + (size_t)chain * 132 * 8192 + e4 * 4;
            const float* dgp = DG + (size_t)chain * 132 * 64 + dk0;
            f32x4 s = (f32x4){0.f, 0.f, 0.f, 0.f};
            for (int n0 = 0; n0 < 132; n0 += 11) {
                u32x2 u[11]; f32x4 dc[11];
#pragma unroll
                for (int i = 0; i < 11; ++i) { const int n = n0 + i; const int tc = dir ? (n < 4 ? 3 - n : 135 - n) : n; u[i] = __builtin_nontemporal_load((const u32x2*)(basep + (size_t)tc * 8192)); dc[i] = *(const f32x4*)(dgp + tc * 64); }
#pragma unroll
                for (int i = 0; i < 11; ++i) { const int n = n0 + i; const int tc = dir ? (n < 4 ? 3 - n : 135 - n) : n;
                    u32x2 o; o.x = pk2(s.x, s.y); o.y = pk2(s.z, s.w);
                    *(u32x2*)(basep + (size_t)tc * 8192) = o;
                    s.x = dc[i].x * s.x + bflo(u[i].x); s.y = dc[i].y * s.y + bfhi(u[i].x); s.z = dc[i].z * s.z + bflo(u[i].y); s.w = dc[i].w * s.w + bfhi(u[i].y); }
            }
        }
    }
}

__device__ __forceinline__ void p8_ret_item(LAS unsigned char* lds, const bf16_t* P, const bf16_t* SR, bf16_t* Hm, const float* dec_f, const float* dec_b, const float* normw,
                                            int item, int tid, int wave, int lane) {
    asm volatile("" : "+v"(tid), "+v"(lane));
    const int c = item & 63, bh = item >> 6, h = bh & 3, b = bh >> 2;
    const int row0 = b * 8192 + c * 128, tc = c + 2;
    const float lgf = ((const LAS float*)(lds + LDS_BYTES - 128))[h], lgb = ((const LAS float*)(lds + LDS_BYTES - 128))[4 + h];
    LAS unsigned char* Q = lds; LAS unsigned char* K = lds + IMG128; LAS unsigned char* V = lds + 2 * IMG128;
    stage128(Q, P + (size_t)row0 * PP + h * 128, tid);
    stage128(K, P + (size_t)row0 * PP + 512 + h * 128, tid);
    stage128(V, P + (size_t)row0 * PP + 1024 + h * 128, tid);
    const bf16_t* Sf = SR + ((size_t)((0 * 2 + b) * 4 + h) * 66 + tc) * 16384;
    const bf16_t* Sb = SR + ((size_t)((1 * 2 + b) * 4 + h) * 66 + tc) * 16384;
    u32x4 sfr[4], sbr[4];
#pragma unroll
    for (int i = 0; i < 4; ++i) { sfr[i] = *(const u32x4*)(Sf + (size_t)(tid + NTHREADS * i) * 8); sbr[i] = *(const u32x4*)(Sb + (size_t)(tid + NTHREADS * i) * 8); }
    __syncthreads();
    const int g = lane >> 4, q = (lane & 15) >> 2, p = lane & 3, fr = lane & 15, fq = g;
    const int i0 = 16 * wave;
    const unsigned base = (unsigned)(size_t)lds;
    bf16x8 qf[4];
#pragma unroll
    for (int ks = 0; ks < 4; ++ks) qf[ks] = row_frag(Q, PT128, i0, 32 * ks, fr, fq);
    u32x2 scp[8];
#pragma unroll
    for (int jb = 0; jb < 8; ++jb) {
        f32x4 a = (f32x4){0.f, 0.f, 0.f, 0.f};
#pragma unroll
        for (int ks = 0; ks < 4; ++ks) a = MFMA16(row_frag(K, PT128, 16 * jb, 32 * ks, fr, fq), qf[ks], a);
        const int i = i0 + fr;
#pragma unroll
        for (int e = 0; e < 4; ++e) { const float dd = (float)(i - (16 * jb + 4 * fq + e)); const float dcy = __expf(fmaxf(dd, 0.f) * lgf + fmaxf(-dd, 0.f) * lgb) * (2.0f - fminf(fabsf(dd), 1.0f)); a[e] *= dcy; }
        scp[jb].x = pg8::cvt_pk_bf16(a[0], a[1]); scp[jb].y = pg8::cvt_pk_bf16(a[2], a[3]);
        asm volatile("" ::: "memory");
    }
    f32x4 ao[8];
#pragma unroll
    for (int y = 0; y < 8; ++y) ao[y] = (f32x4){0.f, 0.f, 0.f, 0.f};
#pragma unroll
    for (int s2 = 0; s2 < 4; ++s2) {
        const bf16x8 xs = mk8(scp[2 * s2], scp[2 * s2 + 1]);
        const int r = 32 * s2 + 4 * g + q;
        bf16x8 vf[8];
        tr8(base + 2 * IMG128 + r * PT128 + 8 * p, base + 2 * IMG128 + (r + 16) * PT128 + 8 * p, vf);
#pragma unroll
        for (int y = 0; y < 8; ++y) ao[y] = MFMA16(vf[y], xs, ao[y]);
    }
    __syncthreads();
#pragma unroll
    for (int i = 0; i < 4; ++i) { const int v = tid + NTHREADS * i, dv = v >> 4, ch = v & 15;
        *(LAS u32x4*)(Q + dv * PT128 + ch * 16) = sfr[i]; *(LAS u32x4*)(K + dv * PT128 + ch * 16) = sbr[i]; }
    __syncthreads();
    const float qsf = __expf((float)(i0 + fr + 1) * lgf), qsb = __expf((float)(128 - i0 - fr) * lgb);
#pragma unroll
    for (int ks = 0; ks < 4; ++ks) {
        const bf16x8 xf = __builtin_bit_cast(bf16x8, scale8(__builtin_bit_cast(u32x4, qf[ks]), qsf)), xb = __builtin_bit_cast(bf16x8, scale8(__builtin_bit_cast(u32x4, qf[ks]), qsb));
#pragma unroll
        for (int y = 0; y < 8; ++y) ao[y] = MFMA16(row_frag(Q, PT128, 16 * y, 32 * ks, fr, fq), xf, ao[y]);
#pragma unroll
        for (int y = 0; y < 8; ++y) ao[y] = MFMA16(row_frag(K, PT128, 16 * y, 32 * ks, fr, fq), xb, ao[y]);
        asm volatile("" ::: "memory");
    }
    float s1 = 0.f, sq = 0.f;
#pragma unroll
    for (int y = 0; y < 8; ++y) s1 += (ao[y][0] + ao[y][1]) + (ao[y][2] + ao[y][3]);
    s1 += __shfl_xor(s1, 16); s1 += __shfl_xor(s1, 32);
    const float mu = s1 * (1.0f / 128.0f);
#pragma unroll
    for (int y = 0; y < 8; ++y)
#pragma unroll
        for (int e = 0; e < 4; ++e) { const float dlt = ao[y][e] - mu; sq += dlt * dlt; }
    sq += __shfl_xor(sq, 16); sq += __shfl_xor(sq, 32);
    const float rstd = 1.0f / sqrtf(sq * (1.0f / 128.0f) + EPS);
    const int row = row0 + i0 + fr;
    const bf16_t* gp = P + (size_t)row * PP + 1536 + h * 128 + 4 * fq;
    bf16_t* op = Hm + (size_t)row * D + h * 128 + 4 * fq;
    const float* wp = normw + h * 128 + 4 * fq;
#pragma unroll
    for (int y = 0; y < 8; ++y) {
        const u32x2 gt = *(const u32x2*)(gp + 16 * y); const f32x4 w = *(const f32x4*)(wp + 16 * y);
        u32x2 o;
        o.x = pk2((ao[y][0] - mu) * rstd * w.x * bflo(gt.x), (ao[y][1] - mu) * rstd * w.y * bfhi(gt.x));
        o.y = pk2((ao[y][2] - mu) * rstd * w.z * bflo(gt.y), (ao[y][3] - mu) * rstd * w.w * bfhi(gt.y));
        *(u32x2*)(op + 16 * y) = o;
    }
    __syncthreads();
}

__device__ __forceinline__ void p8_gla_item(LAS unsigned char* lds, const bf16_t* P, const float* LR, const bf16_t* SG, bf16_t* Hm, const float* wf, const float* bfv, const float* wb, const float* bbv,
                                            const float* normw, int item, int tid, int wave, int lane) {
    asm volatile("" : "+v"(tid), "+v"(lane));
    const int c = item & 63, bh = item >> 6, h = bh & 3, b = bh >> 2;
    const int row0 = b * 8192 + c * 128;
    LAS unsigned char* QF = lds; LAS unsigned char* KF = lds + IMG64; LAS unsigned char* QB = lds + 2 * IMG64; LAS unsigned char* KB = lds + 3 * IMG64; LAS unsigned char* V = lds + 4 * IMG64;
    LAS float* tot = (LAS float*)(lds + 4 * IMG64 + IMG128);
    stage128(V, P + (size_t)row0 * PP + 2560 + h * 128, tid);
    const bf16_t* Sf = SG + ((size_t)((0 * 2 + b) * 4 + h) * 132 + 4 + 2 * c) * 8192;
    const bf16_t* Sb = SG + ((size_t)((1 * 2 + b) * 4 + h) * 132 + 4 + 2 * c) * 8192;
    u32x4 sfr[4], sbr[4];
#pragma unroll
    for (int i = 0; i < 4; ++i) { sfr[i] = *(const u32x4*)(Sf + (size_t)(tid + NTHREADS * i) * 8); sbr[i] = *(const u32x4*)(Sb + (size_t)(tid + NTHREADS * i) * 8); }
    const int d = tid & 63, sub = wave >> 2, wl = wave & 3;
    bf16_t qraw[16], kraw[16];
#pragma unroll
    for (int t = 0; t < 16; ++t) { const bf16_t* pr = P + (size_t)(row0 + 16 * wave + t) * PP + h * 64 + d; qraw[t] = pr[2048]; kraw[t] = pr[2304]; }
    float bf[16], bb[16], totf, totb;
    gla_gates(lds, tot, LR, wf, bfv, wb, bbv, row0, h, tid, wave, bf, bb, totf, totb);
#pragma unroll
    for (int t = 0; t < 16; ++t) {
        const int tok = 16 * wave + t;
        const float qv = bf2f(qraw[t]), kv = bf2f(kraw[t]);
        const float ef = __expf(bf[t]), eb = __expf(bb[t]);
        *(LAS bf16_t*)(QF + tok * PT64 + d * 2) = (bf16_t)cvtpk(qv * ef, 0.f);
        *(LAS bf16_t*)(KF + tok * PT64 + d * 2) = (bf16_t)cvtpk(kv * __builtin_amdgcn_rcpf(ef), 0.f);
        *(LAS bf16_t*)(QB + tok * PT64 + d * 2) = (bf16_t)cvtpk(qv * eb, 0.f);
        *(LAS bf16_t*)(KB + tok * PT64 + d * 2) = (bf16_t)cvtpk(kv * __builtin_amdgcn_rcpf(eb), 0.f);
    }
    __syncthreads();
    const int g = lane >> 4, q = (lane & 15) >> 2, p = lane & 3, fr = lane & 15, fq = g;
    const int i0 = sub * 64 + 16 * wl;
    const unsigned base = (unsigned)(size_t)lds;
    bf16x8 qff[2], qbf[2];
#pragma unroll
    for (int ks = 0; ks < 2; ++ks) { qff[ks] = row_frag(QF, PT64, i0, 32 * ks, fr, fq); qbf[ks] = row_frag(QB, PT64, i0, 32 * ks, fr, fq); }
    u32x2 scp[4];
#pragma unroll
    for (int jb = 0; jb < 4; ++jb) {
        f32x4 a = (f32x4){0.f, 0.f, 0.f, 0.f}, a2 = (f32x4){0.f, 0.f, 0.f, 0.f};
#pragma unroll
        for (int ks = 0; ks < 2; ++ks) { a = MFMA16(row_frag(KF, PT64, sub * 64 + 16 * jb, 32 * ks, fr, fq), qff[ks], a); a2 = MFMA16(row_frag(KB, PT64, sub * 64 + 16 * jb, 32 * ks, fr, fq), qbf[ks], a2); }
        const int il = 16 * wl + fr;
        float v[4];
#pragma unroll
        for (int e = 0; e < 4; ++e) { const float dd = (float)(il - (16 * jb + 4 * fq + e)); v[e] = a[e] * fminf(fmaxf(dd + 1.0f, 0.f), 1.0f) + a2[e] * fminf(fmaxf(1.0f - dd, 0.f), 1.0f); }
        scp[jb].x = pg8::cvt_pk_bf16(v[0], v[1]); scp[jb].y = pg8::cvt_pk_bf16(v[2], v[3]);
        asm volatile("" ::: "memory");
    }
    f32x4 ao[8];
#pragma unroll
    for (int y = 0; y < 8; ++y) ao[y] = (f32x4){0.f, 0.f, 0.f, 0.f};
#pragma unroll
    for (int s2 = 0; s2 < 2; ++s2) {
        const bf16x8 xs = mk8(scp[2 * s2], scp[2 * s2 + 1]);
        const int r = sub * 64 + 32 * s2 + 4 * g + q;
        bf16x8 vf[8];
        tr8(base + 4 * IMG64 + r * PT128 + 8 * p, base + 4 * IMG64 + (r + 16) * PT128 + 8 * p, vf);
#pragma unroll
        for (int y = 0; y < 8; ++y) ao[y] = MFMA16(vf[y], xs, ao[y]);
    }
    __syncthreads();
#pragma unroll
    for (int i = 0; i < 4; ++i) { const int v = tid + NTHREADS * i, m = v >> 10, dv = (v >> 3) & 127, ch = v & 7;
        *(LAS u32x4*)(lds + m * IMG64 + dv * PT64 + ch * 16) = sfr[i]; *(LAS u32x4*)(lds + (2 + m) * IMG64 + dv * PT64 + ch * 16) = sbr[i]; }
    __syncthreads();
    const LAS unsigned char* SFI = lds + sub * IMG64; const LAS unsigned char* SBI = lds + (2 + sub) * IMG64;
#pragma unroll
    for (int ks = 0; ks < 2; ++ks) {
#pragma unroll
        for (int y = 0; y < 8; ++y) ao[y] = MFMA16(row_frag(SFI, PT64, 16 * y, 32 * ks, fr, fq), qff[ks], ao[y]);
#pragma unroll
        for (int y = 0; y < 8; ++y) ao[y] = MFMA16(row_frag(SBI, PT64, 16 * y, 32 * ks, fr, fq), qbf[ks], ao[y]);
        asm volatile("" ::: "memory");
    }
    float ss = 0.f;
#pragma unroll
    for (int y = 0; y < 8; ++y)
#pragma unroll
        for (int e = 0; e < 4; ++e) ss += ao[y][e] * ao[y][e];
    ss += __shfl_xor(ss, 16); ss += __shfl_xor(ss, 32);
    const float rstd = 1.0f / sqrtf(ss * (1.0f / 128.0f) + EPS);
    const int row = row0 + i0 + fr;
    const bf16_t* gp = P + (size_t)row * PP + 3072 + h * 128 + 4 * fq;
    bf16_t* op = Hm + (size_t)row * D + 512 + h * 128 + 4 * fq;
    const float* wp = normw + h * 128 + 4 * fq;
#pragma unroll
    for (int y = 0; y < 8; ++y) {
        const u32x2 gt = *(const u32x2*)(gp + 16 * y); const f32x4 w = *(const f32x4*)(wp + 16 * y);
        u32x2 o;
        o.x = pk2(ao[y][0] * rstd * w.x * bflo(gt.x), ao[y][1] * rstd * w.y * bfhi(gt.x));
        o.y = pk2(ao[y][2] * rstd * w.z * bflo(gt.y), ao[y][3] * rstd * w.w * bfhi(gt.y));
        *(u32x2*)(op + 16 * y) = o;
    }
    __syncthreads();
}

#define XB_TMO      128
#define XB_XCNT(j)  (256  + 64 * (j))
#define XB_XSUB(j)  (1280 + 64 * (j))
#define XB_XGEN(j)  (2304 + 64 * (j))
#define XB_TOP      3328
#define XB_TOPGEN   3392
#define XCD_BAR_WORDS 3456
#define XB_SPIN_CAP (1u << 18)

__device__ __forceinline__ unsigned xb_ld(unsigned* p)              { return __hip_atomic_load(p, __ATOMIC_RELAXED, __HIP_MEMORY_SCOPE_AGENT); }
__device__ __forceinline__ unsigned xb_add(unsigned* p, unsigned v) { return __hip_atomic_fetch_add(p, v, __ATOMIC_RELAXED, __HIP_MEMORY_SCOPE_AGENT); }
__device__ __forceinline__ unsigned xb_xcc_id() { return (unsigned)__builtin_amdgcn_s_getreg((3 << 11) | 20) & 0xFu; }
#define XB_SPIN(cond, bar) do { unsigned _sp = 0; while (cond) { __builtin_amdgcn_s_sleep(1); \
    if ((++_sp & 255u) == 0u) { if (xb_ld(&(bar)[XB_TMO])) break; if (_sp > XB_SPIN_CAP) { atomicAdd(&(bar)[XB_TMO], 1u); break; } } } } while (0)

struct XcdBarrier {
    unsigned* bar; unsigned x;
    volatile LAS unsigned* st;
};

__device__ __forceinline__ XcdBarrier xcd_barrier_post(unsigned* bar, volatile LAS unsigned* st) {
    XcdBarrier b; b.bar = bar; b.x = xb_xcc_id(); b.st = st;
    if (threadIdx.x == 0) (void)xb_add(&bar[XB_XCNT(b.x)], 1u);
    return b;
}
__device__ __forceinline__ void xcd_barrier_complete(unsigned* bar, unsigned x, unsigned& nloc, unsigned& nx) {
    const unsigned G = gridDim.x * gridDim.y * gridDim.z;
    unsigned sum, cnt, mine, sp = 0u;
    for (;;) {
        sum = 0u; cnt = 0u; mine = 0u;
#pragma unroll
        for (unsigned j = 0; j < 16; ++j) { const unsigned c = xb_ld(&bar[XB_XCNT(j)]); sum += c; cnt += (c > 0u) ? 1u : 0u; mine = (j == x) ? c : mine; }
        if (sum == G) break;
        __builtin_amdgcn_s_sleep(1);
        if ((++sp & 255u) == 0u) { if (xb_ld(&bar[XB_TMO])) break; if (sp > XB_SPIN_CAP) { atomicAdd(&bar[XB_TMO], 1u); break; } }
    }
    nloc = mine > 0u ? mine : 1u; nx = cnt > 0u ? cnt : 1u;
}

__device__ __forceinline__ void xcd_barrier(const XcdBarrier& b) {
    asm volatile("s_waitcnt vmcnt(0)" ::: "memory");
    __syncthreads();
    if (threadIdx.x == 0) {
        unsigned* bar = b.bar;
        __builtin_amdgcn_s_waitcnt(0);
        unsigned nloc = b.st[0], nx = b.st[1];
        if (nloc == 0u) { xcd_barrier_complete(bar, b.x, nloc, nx); b.st[0] = nloc; b.st[1] = nx; }
        const unsigned old = xb_add(&bar[XB_XSUB(b.x)], 1u);
        const unsigned gen = old / nloc;
        if (old + 1u == (gen + 1u) * nloc) {
            __builtin_amdgcn_fence(__ATOMIC_RELEASE, "agent");
            asm volatile("s_waitcnt vmcnt(0)" ::: "memory");
            const unsigned og = xb_add(&bar[XB_TOP], 1u);
            const unsigned tg = og / nx;
            if (og + 1u == (tg + 1u) * nx) xb_add(&bar[XB_TOPGEN], 1u);
            else XB_SPIN(xb_ld(&bar[XB_TOPGEN]) == tg, bar);
            __builtin_amdgcn_fence(__ATOMIC_ACQUIRE, "agent");
            xb_add(&bar[XB_XGEN(b.x)], 1u);
            asm volatile("s_waitcnt vmcnt(0)" ::: "memory");
        } else {
            XB_SPIN(xb_ld(&bar[XB_XGEN(b.x)]) == gen, bar);
            __builtin_amdgcn_fence(__ATOMIC_ACQUIRE, "agent");
            asm volatile("s_waitcnt vmcnt(0)" ::: "memory");
        }
    }
    __syncthreads();
}


__device__ __attribute__((noinline)) void xcd_barrier_ool(unsigned* barp, unsigned x, volatile LAS unsigned* st) { XcdBarrier b; b.bar = barp; b.x = x; b.st = st; xcd_barrier(b); }

#ifndef PHM
#define PHM 0xffff
#endif
struct Args { const float* in[26]; float* out; unsigned char* ws; };
enum { I_X = 0, I_C, I_CTX, I_CCTX, I_ADAW, I_ADAB, I_N1W, I_F1W1, I_F1W3, I_F1W2, I_N2W, I_WIN, I_RDF, I_RDB, I_RNW, I_GWF, I_GBF, I_GWB, I_GBB, I_GNW, I_WOUT, I_N3W, I_F2W1, I_F2W3, I_F2W2, I_FNW };

#ifndef P6SKIP
#define P6SKIP 0
#endif
#ifndef PROBE
#define PROBE 0
#endif
#ifndef PHSKIP
#define PHSKIP 0
#endif
template <int ph> __device__ __forceinline__ void run_phase(LAS unsigned char* lds, const int G, const int NGW, const bool probe_dst = false) {
    if (PHSKIP & (1 << ph)) return;
        int tid = threadIdx.x; asm volatile("" : "+v"(tid));
        int bid = blockIdx.x; asm volatile("" : "+s"(bid));
        const int lane = tid & 63, wave = __builtin_amdgcn_readfirstlane(tid >> 6), gw = bid * 8 + wave;
        const __attribute__((address_space(4))) char* kargs = (const __attribute__((address_space(4))) char*)__builtin_amdgcn_kernarg_segment_ptr(); asm volatile("" : "+s"(kargs));
        unsigned char* ws = *(unsigned char* const __attribute__((address_space(4)))*)(kargs + 8 * 27);
        float* out = *(float* const __attribute__((address_space(4)))*)(kargs + 8 * 26);
#define INP(i) (*(const float* const __attribute__((address_space(4)))*)(kargs + 8 * (i)))
        float* part = (float*)(ws + WS_PART); float* mods = (float*)(ws + WS_MODS); float* LR = (float*)(ws + WS_LR); float* X1C = (float*)(ws + WS_X1C); float* DG = (float*)(ws + WS_DG);
        bf16_t* W13 = (bf16_t*)(ws + WS_W13); bf16_t* W2 = (bf16_t*)(ws + WS_W2); bf16_t* WIN = (bf16_t*)(ws + WS_WIN); bf16_t* WOUT = (bf16_t*)(ws + WS_WOUT);
        bf16_t* H = (bf16_t*)(ws + WS_H); bf16_t* GP = (bf16_t*)(ws + WS_GP); bf16_t* SR = (bf16_t*)(ws + WS_SR); bf16_t* SG = (bf16_t*)(ws + WS_SG);
        if (ph == 0 && (PHM & 1)) {
            LAS float* scv = (LAS float*)lds;
            LAS f32x4* red = (LAS f32x4*)(lds + 1024);
            for (int it = bid; it < 288; it += G) {
                const int s = it / 18, cc = it % 18;
                if (tid < 192) { const int cond = tid >> 6, k = s * 64 + (tid & 63); const float v = cond < 2 ? INP(I_C)[cond * D + k] : INP(I_CCTX)[k]; scv[tid] = v / (1.0f + expf(-v)); }
                __syncthreads();
                const int cg4 = tid & 127, ks = tid >> 7;
                f32x4 acc[3] = {(f32x4){0.f, 0.f, 0.f, 0.f}, (f32x4){0.f, 0.f, 0.f, 0.f}, (f32x4){0.f, 0.f, 0.f, 0.f}};
                const float* wp = INP(I_ADAW) + (size_t)(s * 64 + ks * 16) * NMODS + cc * 512 + cg4 * 4;
#pragma unroll
                for (int kk = 0; kk < 16; ++kk) { const f32x4 w = __builtin_nontemporal_load((const f32x4*)(wp + (size_t)kk * NMODS));
#pragma unroll
                    for (int cnd = 0; cnd < 3; ++cnd) acc[cnd] += w * scv[cnd * 64 + ks * 16 + kk]; }
#pragma unroll
                for (int cnd = 0; cnd < 3; ++cnd) red[(ks * 3 + cnd) * 128 + cg4] = acc[cnd];
                __syncthreads();
                if (tid < 384) { const int cnd = tid >> 7, g4 = tid & 127;
                    const f32x4 r = (red[(0 * 3 + cnd) * 128 + g4] + red[(1 * 3 + cnd) * 128 + g4]) + (red[(2 * 3 + cnd) * 128 + g4] + red[(3 * 3 + cnd) * 128 + g4]);
                    *(f32x4*)(part + (size_t)(s * 3 + cnd) * NMODS + cc * 512 + g4 * 4) = r; }
                __syncthreads();
            }
            LAS float* scr = (LAS float*)(lds + wave * 16384);
            convert_ffn(INP(I_F1W1), INP(I_F1W3), INP(I_F1W2), W13, W2, scr, gw, NGW, lane);
            constexpr int IIN = (D / 64) * (NIN / 32), IOUT = (D / 64) * (D / 32);
            for (int it = gw; it < IIN + IOUT; it += NGW) {
                if (it < IIN) transpose_item<2>(INP(I_WIN), D, NIN, WIN, 0, scr, it, lane);
                else transpose_item<0>(INP(I_WOUT), D, D, WOUT, 0, scr, it - IIN, lane);
            }
            for (int v = bid * NTHREADS + tid; v < (NINP - NIN) * D / 8; v += G * NTHREADS) *((u32x4*)(WIN + (size_t)NIN * D) + v) = (u32x4){0u, 0u, 0u, 0u};
        } else if (ph == 1 && (PHM & 2)) {
            for (int g4 = bid * NTHREADS + tid; g4 < 3 * NMODS / 4; g4 += G * NTHREADS) { const int gid = 4 * g4, cond = gid / NMODS, rem = gid % NMODS; f32x4 v = *(const f32x4*)(INP(I_ADAB) + rem);
#pragma unroll
                for (int s = 0; s < 16; ++s) v += *(const f32x4*)(part + (size_t)(s * 3 + cond) * NMODS + rem);
                *(f32x4*)(mods + gid) = v; }
            norm_phase<true, false>(lds, INP(I_X), INP(I_CTX), MROWS, INP(I_N1W), part, INP(I_ADAB), mods, 0, 1, H, nullptr, gw, NGW, tid, lane);
        } else if (ph == 2 && (PHM & 4)) {
            unsigned* cnt = (unsigned*)(ws + WS_CNT);
            { pg8::Gemm g{H, W13, MROWS, 2 * FF, D, D / 64}; CtxFirstOrder S; S.init(G, bid, cnt, (LAS unsigned*)(lds + LDS_BYTES - 64 + 16));
              EpiSwiglu E{GP};
              pg8::gemm_phase<EpiSwiglu, CtxFirstOrder, true, true>(lds, g, S, E); }
            if (bid >= G - 24) {
                if (tid == 0) { while (__hip_atomic_load(cnt, __ATOMIC_RELAXED, __HIP_MEMORY_SCOPE_AGENT) < 44u * 8u) __builtin_amdgcn_s_sleep(4); }
                __builtin_amdgcn_fence(__ATOMIC_ACQUIRE, "agent");
                asm volatile("s_waitcnt vmcnt(0)" ::: "memory");
                __syncthreads();
                const int qd = bid - (G - 24), part3 = qd % 3, tile = qd / 3, k0 = part3 == 0 ? 0 : (part3 == 1 ? 16 * 64 : 30 * 64);
                pg8::Gemm g{GP + (size_t)NLAT * FF + k0, W2 + k0, NCTX, D, FF, part3 == 0 ? 16 : 14}; OneUnit S{tile >> 2, tile & 3};
                EpiCtxAtomic E{(float*)(ws + WS_SR) + (size_t)part3 * NCTX * D, mods};
                pg8::gemm_phase<EpiCtxAtomic, OneUnit, true, true>(lds, g, S, E);
            }
        } else if (ph == 11 && (PHM & 4)) {
            pg8::Gemm g{H, W13, NLAT, 2 * FF, D, D / 64}; pg8::StaticOrder S; S.init(NLAT, 2 * FF, G, bid);
            EpiSwiglu E{GP};
            pg8::gemm_phase<EpiSwiglu, pg8::StaticOrder, true, true>(lds, g, S, E);
        } else if (ph == 12 && (PHM & 8)) {
            pg8::Gemm g{GP, W2, NLAT, D, FF, FF / 64}; pg8::StaticOrder S; S.init(NLAT, D, G, bid);
            EpiResidNorm<0> E{};
            pg8::gemm_phase<EpiResidNorm<0>, pg8::StaticOrder, false, true>(lds, g, S, E);
        } else if (ph == 3 && (PHM & 8)) {
            norm_phase<false, false>(lds, out, INP(I_CTX), MROWS, INP(I_N2W), part, INP(I_ADAB), mods, 3, 4, H, nullptr, gw, NGW, tid, lane, NLAT, (const float*)(ws + WS_SR));
            __syncthreads();
            pg8::Gemm g{GP, W2, NLAT, D, FF, FF / 64}; pg8::StaticOrder S; S.init(NLAT, D, G, bid);
            EpiResidNorm<1> E{};
            pg8::gemm_phase<EpiResidNorm<1>, pg8::StaticOrder, false, true>(lds, g, S, E);
        } else if (ph == 9 && (PHM & 8)) {
            pg8::Gemm g{H, WOUT, NLAT, D, D, D / 64}; pg8::StaticOrder S; S.init(NLAT, D, G, bid);
            EpiResidNorm<2> E{};
            pg8::gemm_phase<EpiResidNorm<2>, pg8::StaticOrder, false, true>(lds, g, S, E);
        } else if (ph == 4 && (PHM & 16)) {
            norm_phase<false, false>(lds, out, X1C, MROWS, INP(I_N2W), part, INP(I_ADAB), mods, 3, 4, H, nullptr, gw, NGW, tid, lane);
        } else if (ph == 5 && (PHM & 32)) {
            pg8::Gemm g{H, WIN, MROWS, NINP, D, D / 64}; pg8::StaticOrder S; S.init(MROWS, NINP, G, bid);
            EpiWin E{GP, LR};
            pg8::gemm_phase<EpiWin, pg8::StaticOrder, true, true>(lds, g, S, E);
        } else if (ph == 6 && (PHM & 64)) {
            if (tid < 8) ((LAS float*)(lds + LDS_BYTES - 128))[tid] = -log1pf(expf(-(tid < 4 ? INP(I_RDF)[tid] : INP(I_RDB)[tid - 4])));
            __syncthreads();
            unsigned* qctr = (unsigned*)(ws + WS_CNT + 768);
            volatile LAS int* nx = (volatile LAS int*)(lds + LDS_BYTES - 64 + 32);
            int it = bid, k = 0;
            while (it < 1056) {
                if (tid == 0) nx[k & 1] = G + (int)__hip_atomic_fetch_add(qctr, 1u, __ATOMIC_RELAXED, __HIP_MEMORY_SCOPE_AGENT);
                if (it < 528) { if (!(P6SKIP & 2)) p6_gla_item(lds, GP, LR, SG, DG, INP(I_GWF), INP(I_GBF), INP(I_GWB), INP(I_GBB), it, tid, wave, lane); }
                else if (!(P6SKIP & 1)) p6_ret_item(lds, GP, SR, INP(I_RDF), INP(I_RDB), it - 528, tid, wave, lane);
                it = nx[k & 1]; ++k;
            }
        } else if (ph == 7 && (PHM & 128)) {
            p7_scan(SR, SG, DG, INP(I_RDF), INP(I_RDB), bid * NTHREADS + tid, G * NTHREADS);
            { LAS float* scr = (LAS float*)(lds + wave * 16384); convert_ffn(INP(I_F2W1), INP(I_F2W3), INP(I_F2W2), W13, W2, scr, gw, NGW, lane); }
        } else if (ph == 8 && (PHM & 256)) {
            if (tid < 8) ((LAS float*)(lds + LDS_BYTES - 128))[tid] = -log1pf(expf(-(tid < 4 ? INP(I_RDF)[tid] : INP(I_RDB)[tid - 4])));
            __syncthreads();
            for (int it = bid; it < 1024; it += G) for (int rep = 0; rep < (PROBE == 14 ? 2 : 1); ++rep) {
                if (it < 512) p8_ret_item(lds, GP, SR, H, INP(I_RDF), INP(I_RDB), INP(I_RNW), it, tid, wave, lane);
                else p8_gla_item(lds, GP, LR, SG, H, INP(I_GWF), INP(I_GBF), INP(I_GWB), INP(I_GBB), INP(I_GNW), it - 512, tid, wave, lane);
            }
        } else if (ph == 10 && (PHM & 512)) {
            norm_phase<false, false>(lds, out, X1C, NLAT, INP(I_N3W), part, INP(I_ADAB), mods, 6, 7, H, nullptr, gw, NGW, tid, lane);
        } else if (ph == 13 && (PHM & 1024)) {
            norm_phase<false, true>(lds, out, X1C, NLAT, INP(I_FNW), part, INP(I_ADAB), mods, 0, 0, nullptr, probe_dst ? (float*)(ws + WS_SR) : out, gw, NGW, tid, lane);
        }
}

__global__ void __launch_bounds__(NTHREADS, 2) mk_fwd(Args a) {
    extern __shared__ __attribute__((aligned(16))) unsigned char lds_raw[];
    LAS unsigned char* lds = (LAS unsigned char*)lds_raw;
    cg::grid_group grid = cg::this_grid();
    const int G = gridDim.x, NGW = G * 8;
#ifndef PROBE
#define PROBE 0
#endif
#ifndef PROBE
#define PROBE 0
#endif
    if (gridDim.y == 4242u) grid.sync();
    unsigned* barw = (unsigned*)(a.ws + WS_BAR);
    volatile LAS unsigned* bst = (volatile LAS unsigned*)(lds + LDS_BYTES - 64);
    if (threadIdx.x < 8) bst[threadIdx.x] = 0u;
    __syncthreads();
    XcdBarrier bar = xcd_barrier_post(barw, bst);
#define SEAM() xcd_barrier_ool(bar.bar, bar.x, bar.st)
    run_phase<0>(lds, G, NGW); SEAM();
    run_phase<1>(lds, G, NGW); SEAM();
    run_phase<2>(lds, G, NGW); SEAM();
    run_phase<3>(lds, G, NGW); SEAM();
    run_phase<5>(lds, G, NGW); SEAM();
    run_phase<6>(lds, G, NGW); SEAM();
    run_phase<7>(lds, G, NGW); SEAM();
    run_phase<8>(lds, G, NGW); SEAM();
    run_phase<9>(lds, G, NGW); SEAM();
    run_phase<11>(lds, G, NGW); SEAM();
    run_phase<12>(lds, G, NGW);
}

extern "C" void kernel_launch(void* const* d_in, const int* in_sizes, int n_in, void* d_out, int out_size, void* d_ws, size_t ws_size, hipStream_t stream) {
    static int grid = 0;
    if (grid == 0) {
        if (n_in != 26 || ws_size < WS_END) { fprintf(stderr, "kernel_launch: unexpected n_in %d or ws_size %zu (< %zu)\n", n_in, ws_size, (size_t)WS_END); grid = -1; return; }
        int dev = 0, cus = 0, per_cu = 0;
        hipGetDevice(&dev);
        hipDeviceGetAttribute(&cus, hipDeviceAttributeMultiprocessorCount, dev);
        hipFuncSetAttribute((const void*)mk_fwd, hipFuncAttributeMaxDynamicSharedMemorySize, LDS_BYTES);
        hipOccupancyMaxActiveBlocksPerMultiprocessor(&per_cu, (const void*)mk_fwd, NTHREADS, LDS_BYTES);
        if (per_cu < 1) { fprintf(stderr, "kernel_launch: occupancy query reports %d blocks per CU\n", per_cu); per_cu = 1; }
        grid = cus;
        (void)hipGetLastError();
    }
    if (grid < 0) return;
    if (hipMemsetAsync((char*)d_ws + WS_BAR, 0, 128 * 1024, stream) != hipSuccess) { fprintf(stderr, "kernel_launch: memset of the barrier words failed\n"); return; }
    Args a{};
    for (int i = 0; i < 26; ++i) a.in[i] = (const float*)d_in[i];
    a.out = (float*)d_out; a.ws = (unsigned char*)d_ws;
    void* args[] = {&a};
    hipError_t e = hipLaunchCooperativeKernel((const void*)mk_fwd, dim3(grid), dim3(NTHREADS), args, LDS_BYTES, stream);
    if (e != hipSuccess) fprintf(stderr, "cooperative launch failed: %s (grid %d)\n", hipGetErrorString(e), grid);
}
```

```cpp
#include <hip/hip_runtime.h>
#include <hip/hip_cooperative_groups.h>
#include <cstdio>
#include <cstdint>
namespace cg = cooperative_groups;
namespace pg8 {
#define PG8_LAS __attribute__((address_space(3)))
typedef unsigned short bf16_t;
typedef short bf16x8 __attribute__((ext_vector_type(8)));
typedef float f32x4 __attribute__((ext_vector_type(4)));
typedef unsigned u32x4 __attribute__((ext_vector_type(4)));
constexpr int BM = 256, BK = 64, HALF = 128, HTB = HALF * BK * 2  , STAGE_BYTES = 8 * HTB, NXCD = 8, WGM = 8;

__host__ __device__ __forceinline__ int lds_byte(int r, int c) { const int st = (r >> 4) * 2 + (c >> 5), rr = r & 15, cc = c & 31, ob = rr * 64 + cc * 2; return st * 1024 + (ob ^ (((ob >> 9) & 1) << 5)); }
__host__ __device__ __forceinline__ void stage_rc(int b, int& R, int& C) { const int st = b / 1024, sb = b % 1024, swz = sb ^ (((sb >> 9) & 1) << 5); R = (st >> 1) * 16 + swz / 64; C = (st & 1) * 32 + (swz % 64) / 2; }
__host__ __device__ __forceinline__ int perm32(int rho) { const int n = rho >> 4, i = rho & 15; return 8 * (i >> 2) + 4 * n + (i & 3); }

struct Unit { int pm, pn; };
struct Gemm { const bf16_t* A; const bf16_t* Bt; int M, N, K, KT; };

struct StaticOrder {
    int nM, nN, nwg, G, c;
    __host__ __device__ void init(int M, int N, int G_, int c_) { nM = M / BM; nN = N / BM; nwg = nM * nN; G = G_; c = c_; }
    __host__ __device__ bool next(int i, Unit& u) const {
        const long L = (long)i * G + c; if (L >= nwg) return false;
        int wgid = (int)L; { const int q = nwg / NXCD, r = nwg % NXCD, xcd = wgid % NXCD, off = wgid / NXCD; wgid = (xcd < r ? xcd * (q + 1) : r * (q + 1) + (xcd - r) * q) + off; }
        const int nig = WGM * nN, gid = wgid / nig, fm = gid * WGM, gsz = (nM - fm) < WGM ? (nM - fm) : WGM;
        u.pm = fm + ((wgid % nig) % gsz); u.pn = (wgid % nig) / gsz; return true;
    }
    __device__ __forceinline__ void a_ready(const Unit&) const {}
    __device__ __forceinline__ void done(const Unit&) const {}
};

__device__ __forceinline__ unsigned cvt_pk_bf16(float lo, float hi) { unsigned r; asm volatile("v_cvt_pk_bf16_f32 %0, %1, %2" : "=v"(r) : "v"(lo), "v"(hi)); return r; }
template <class Epi, class Sched, bool ALIGN_EPI = false, bool SP2 = false>
__device__ __forceinline__ void gemm_phase(PG8_LAS unsigned char* lds, const Gemm g, const Sched& S, const Epi& E) {
    const int tid = threadIdx.x, wid = __builtin_amdgcn_readfirstlane(tid >> 6), lane = tid & 63, wr = wid >> 2, wc = wid & 3, fr = lane & 15, fq = lane >> 4;
    const int K = g.K, nt = g.KT;
    unsigned voffA[2], voffB[2];
#pragma unroll
    for (int i = 0; i < 2; ++i) { int R, C; stage_rc(tid * 16 + i * 8192, R, C); const int Rb = Epi::PERM ? ((R & ~31) + perm32(R & 31)) : R;
        voffA[i] = (unsigned)(R * K + C) * 2u; voffB[i] = (unsigned)(Rb * K + C) * 2u; }
    const size_t kstep = (size_t)(BK * 2);
    const size_t hstep = (size_t)HALF * K * 2;
    const size_t tstep = 2 * hstep;
    const unsigned ldsw = (unsigned)wid * 1024u;
    const int aoff = lds_byte(wr * 64 + fr, fq * 8), boff = lds_byte(wc * 32 + fr, fq * 8);
#define PG8_SA(b, h) (((b) * 2 + (h)) * HTB)
#define PG8_SB(b, h) ((4 + (b) * 2 + (h)) * HTB)
#define PG8_STAGE(bufoff, gbase, voff) do { _Pragma("unroll") for (int _i = 0; _i < 2; ++_i) \
        __builtin_amdgcn_global_load_lds((const unsigned*)((const char*)(gbase) + (voff)[_i]), (PG8_LAS unsigned*)(lds + (bufoff) + ldsw + _i * 8192), 16, 0, 0); } while (0)
#define PG8_LDA(dst, b, h) do { _Pragma("unroll") for (int m = 0; m < 4; ++m) _Pragma("unroll") for (int k = 0; k < 2; ++k) dst[m][k] = *(const PG8_LAS bf16x8*)(lds + PG8_SA(b, h) + aoff + m * 2048 + k * 1024); } while (0)
#define PG8_LDB(dst, b, h) do { _Pragma("unroll") for (int n = 0; n < 2; ++n) _Pragma("unroll") for (int k = 0; k < 2; ++k) dst[n][k] = *(const PG8_LAS bf16x8*)(lds + PG8_SB(b, h) + boff + n * 2048 + k * 1024); } while (0)
#define PG8_MMA(ai, bj, At, Bt) do { __builtin_amdgcn_s_setprio(1); _Pragma("unroll") for (int m = 0; m < 4; ++m) _Pragma("unroll") for (int n = 0; n < 2; ++n) _Pragma("unroll") for (int k = 0; k < 2; ++k) \
        acc[ai][bj][m][n] = __builtin_amdgcn_mfma_f32_16x16x32_bf16(Bt[n][k], At[m][k], acc[ai][bj][m][n], 0, 0, 0); __builtin_amdgcn_s_setprio(0); } while (0)
#define PG8_WAIT_V(n) asm volatile("s_waitcnt vmcnt(" #n ")" ::: "memory")
#define PG8_WAIT_L(n) asm volatile("s_waitcnt lgkmcnt(" #n ")" ::: "memory")
#define PG8_BAR __builtin_amdgcn_s_barrier()
#define PG8_SCHED __builtin_amdgcn_sched_barrier(0)
    Unit cur, nxt; int ui = 0;
    if (!S.next(0, cur)) return;
    f32x4 acc[2][2][4][2];
#pragma unroll
    for (int a = 0; a < 2; ++a)
#pragma unroll
        for (int b = 0; b < 2; ++b)
#pragma unroll
            for (int m = 0; m < 4; ++m)
#pragma unroll
                for (int n = 0; n < 2; ++n) acc[a][b][m][n] = (f32x4){0.f, 0.f, 0.f, 0.f};
    bf16x8 At[4][2], B0[2][2], B1[2][2];
    const char* cA = (const char*)g.A + (size_t)cur.pm * tstep; const char* cB = (const char*)g.Bt + (size_t)cur.pn * tstep;
    S.a_ready(cur);
    if constexpr (SP2) {
        PG8_STAGE(PG8_SB(0, 0), cB, voffB); PG8_STAGE(PG8_SB(0, 1), cB + hstep, voffB); PG8_STAGE(PG8_SA(0, 0), cA, voffA); PG8_STAGE(PG8_SA(0, 1), cA + hstep, voffA);
        if (wr == 1) PG8_BAR;
        PG8_WAIT_V(2); PG8_BAR;
        PG8_STAGE(PG8_SB(1, 0), cB + kstep, voffB); PG8_STAGE(PG8_SA(1, 0), cA + kstep, voffA); PG8_STAGE(PG8_SB(1, 1), cB + hstep + kstep, voffB);
        PG8_WAIT_V(6); PG8_BAR;
    } else {
        PG8_STAGE(PG8_SB(0, 0), cB, voffB); PG8_STAGE(PG8_SA(0, 0), cA, voffA); PG8_STAGE(PG8_SB(0, 1), cB + hstep, voffB); PG8_STAGE(PG8_SA(0, 1), cA + hstep, voffA);
        if (wr == 1) PG8_BAR;
        PG8_WAIT_V(4); PG8_BAR;
        PG8_STAGE(PG8_SB(1, 0), cB + kstep, voffB); PG8_STAGE(PG8_SA(1, 0), cA + kstep, voffA); PG8_STAGE(PG8_SB(1, 1), cB + hstep + kstep, voffB);
        PG8_WAIT_V(6); PG8_BAR;
    }
    for (;;) {
        const bool has_next = S.next(ui + 1, nxt);
        const char* nA = has_next ? (const char*)g.A + (size_t)nxt.pm * tstep : cA; const char* nB = has_next ? (const char*)g.Bt + (size_t)nxt.pn * tstep : cB;
        for (int t = 0; t < nt; t += 2) {
            const bool last = (t == nt - 2);
            const char* a1 = cA + (size_t)(t + 1) * kstep;
            const char* a2 = last ? nA : cA + (size_t)(t + 2) * kstep; const char* b2 = last ? nB : cB + (size_t)(t + 2) * kstep;
            const char* a3 = a2 + kstep; const char* b3 = b2 + kstep;
            if (last && has_next) S.a_ready(nxt);
            if constexpr (SP2) {
            PG8_LDB(B0, 0, 0); PG8_LDB(B1, 0, 1); PG8_SCHED; PG8_LDA(At, 0, 0); PG8_STAGE(PG8_SA(1, 1), a1 + hstep, voffA);
            PG8_WAIT_V(8); PG8_WAIT_L(0); PG8_BAR; PG8_MMA(0, 0, At, B0); PG8_MMA(0, 1, At, B1); PG8_BAR; PG8_SCHED;
            PG8_LDA(At, 0, 1); PG8_STAGE(PG8_SB(0, 0), b2, voffB); PG8_STAGE(PG8_SB(0, 1), b2 + hstep, voffB); PG8_STAGE(PG8_SA(0, 0), a2, voffA);
            PG8_WAIT_V(8); PG8_WAIT_L(0); PG8_BAR; PG8_MMA(1, 0, At, B0); PG8_MMA(1, 1, At, B1); PG8_BAR; PG8_SCHED;
            PG8_LDB(B0, 1, 0); PG8_LDB(B1, 1, 1); PG8_SCHED; PG8_LDA(At, 1, 0); PG8_STAGE(PG8_SA(0, 1), a2 + hstep, voffA);
            PG8_WAIT_V(8); PG8_WAIT_L(0); PG8_BAR; PG8_MMA(0, 0, At, B0); PG8_MMA(0, 1, At, B1); PG8_BAR; PG8_SCHED;
            PG8_LDA(At, 1, 1); PG8_STAGE(PG8_SB(1, 0), b3, voffB); PG8_STAGE(PG8_SB(1, 1), b3 + hstep, voffB); PG8_STAGE(PG8_SA(1, 0), a3, voffA);
            PG8_WAIT_V(8); PG8_WAIT_L(0); PG8_BAR; PG8_MMA(1, 0, At, B0); PG8_MMA(1, 1, At, B1); PG8_BAR; PG8_SCHED;
            } else {
            PG8_LDB(B0, 0, 0); PG8_SCHED; PG8_LDA(At, 0, 0); PG8_STAGE(PG8_SA(1, 1), a1 + hstep, voffA);
            PG8_WAIT_L(8); PG8_BAR; PG8_WAIT_L(0); PG8_MMA(0, 0, At, B0); PG8_BAR; PG8_SCHED;
            PG8_LDB(B1, 0, 1); PG8_STAGE(PG8_SB(0, 0), b2, voffB);
            PG8_BAR; PG8_WAIT_L(0); PG8_MMA(0, 1, At, B1); PG8_BAR;
            PG8_LDA(At, 0, 1); PG8_STAGE(PG8_SA(0, 0), a2, voffA);
            PG8_BAR; PG8_WAIT_L(0); PG8_MMA(1, 0, At, B0); PG8_BAR; PG8_SCHED;
            PG8_STAGE(PG8_SB(0, 1), b2 + hstep, voffB);
            PG8_WAIT_V(6); PG8_BAR; PG8_MMA(1, 1, At, B1); PG8_BAR;
            PG8_LDB(B0, 1, 0); PG8_SCHED; PG8_LDA(At, 1, 0); PG8_STAGE(PG8_SA(0, 1), a2 + hstep, voffA);
            PG8_WAIT_L(8); PG8_BAR; PG8_WAIT_L(0); PG8_MMA(0, 0, At, B0); PG8_BAR; PG8_SCHED;
            PG8_LDB(B1, 1, 1); PG8_STAGE(PG8_SB(1, 0), b3, voffB);
            PG8_BAR; PG8_WAIT_L(0); PG8_MMA(0, 1, At, B1); PG8_BAR;
            PG8_LDA(At, 1, 1); PG8_STAGE(PG8_SA(1, 0), a3, voffA);
            PG8_BAR; PG8_WAIT_L(0); PG8_MMA(1, 0, At, B0); PG8_BAR; PG8_SCHED;
            PG8_STAGE(PG8_SB(1, 1), b3 + hstep, voffB);
            PG8_WAIT_V(6); PG8_BAR; PG8_MMA(1, 1, At, B1); PG8_BAR;
            }
        }
        if constexpr (ALIGN_EPI) { if (wr == 0) PG8_BAR; }
        if constexpr (!Epi::AFTER_DRAIN) { E(acc, cur, wr, wc, fr, fq); S.done(cur); }
        if (!has_next) break;
#pragma unroll
        for (int a = 0; a < 2; ++a)
#pragma unroll
            for (int b = 0; b < 2; ++b)
#pragma unroll
                for (int m = 0; m < 4; ++m)
#pragma unroll
                    for (int n = 0; n < 2; ++n) acc[a][b][m][n] = (f32x4){0.f, 0.f, 0.f, 0.f};
        cur = nxt; cA = nA; cB = nB; ++ui;
        if constexpr (ALIGN_EPI) { if (wr == 1) PG8_BAR; }
    }
    PG8_WAIT_V(0);
    if constexpr (!ALIGN_EPI) { if (wr == 0) PG8_BAR; }
    PG8_BAR;
    if constexpr (Epi::AFTER_DRAIN) { E.fused(acc, cur, wr, wc, fr, fq, lds, wid, lane); S.done(cur); }
#undef PG8_SA
#undef PG8_SB
#undef PG8_STAGE
#undef PG8_LDA
#undef PG8_LDB
#undef PG8_MMA
#undef PG8_WAIT_V
#undef PG8_WAIT_L
#undef PG8_BAR
#undef PG8_SCHED
}
}

#define LAS __attribute__((address_space(3)))
#ifndef PROBE
#define PROBE 0
#endif
typedef unsigned short bf16_t;
typedef short bf16x8 __attribute__((ext_vector_type(8)));
typedef float f32x4 __attribute__((ext_vector_type(4)));
typedef unsigned u32x4 __attribute__((ext_vector_type(4)));
typedef unsigned u32x2 __attribute__((ext_vector_type(2)));

constexpr int D = 1024, FF = 2816, NLAT = 16384, NCTX = 512, MROWS = NLAT + NCTX, NIN = 3616, NINP = 3840, PP = 3584  ;
constexpr int NMODS = 9 * D;
constexpr float EPS = 1e-6f;
constexpr int NTHREADS = 512;
constexpr int LDS_BYTES = 144 * 1024;

constexpr size_t MiB = 1u << 20;
constexpr size_t WS_PART = 0;
constexpr size_t WS_BAR  = WS_PART + 1792 * 1024;
constexpr size_t WS_CNT  = WS_BAR + 64 * 1024;
constexpr size_t WS_MODS = WS_PART + 2 * MiB;
constexpr size_t WS_LR   = WS_MODS + 128 * 1024;
constexpr size_t WS_X1C  = WS_LR + (size_t)MROWS * 32 * 4 + 0;
constexpr size_t WS_DG   = WS_X1C + 2 * MiB;
constexpr size_t WS_W13  = WS_DG + 1 * MiB;
constexpr size_t WS_W2   = WS_W13 + (size_t)2 * FF * D * 2;
constexpr size_t WS_WIN  = WS_W2 + (size_t)FF * D * 2;
constexpr size_t WS_WOUT = WS_WIN + (size_t)NINP * D * 2;
constexpr size_t WS_H    = WS_WOUT + (size_t)D * D * 2;
constexpr size_t WS_GP   = WS_H + (size_t)MROWS * D * 2;
constexpr size_t WS_SR   = WS_GP + (size_t)MROWS * PP * 2;
constexpr size_t WS_SG   = WS_SR + (size_t)16 * 66 * 16384 * 2;
constexpr size_t WS_END  = WS_SG + (size_t)16 * 132 * 8192 * 2;
static_assert(WS_END <= 256 * MiB, "workspace over 256 MiB");
static_assert(WS_LR % 256 == 0 && WS_X1C % 256 == 0 && WS_W13 % 256 == 0 && WS_H % 256 == 0 && WS_GP % 256 == 0 && WS_SR % 256 == 0 && WS_SG % 256 == 0, "align");

__device__ __forceinline__ unsigned f2bf(float f) { unsigned u = __builtin_bit_cast(unsigned, f); return (u + 0x7fffu + ((u >> 16) & 1u)) >> 16; }
__device__ __forceinline__ unsigned pk2(float lo, float hi) { return f2bf(lo) | (f2bf(hi) << 16); }
__device__ __forceinline__ unsigned cvtpk(float lo, float hi) { unsigned r; asm("v_cvt_pk_bf16_f32 %0, %1, %2" : "=v"(r) : "v"(lo), "v"(hi)); return r; }
__device__ __forceinline__ float bflo(unsigned u) { return __builtin_bit_cast(float, u << 16); }
__device__ __forceinline__ float bfhi(unsigned u) { return __builtin_bit_cast(float, u & 0xffff0000u); }
__device__ __forceinline__ float bf2f(bf16_t h) { return __builtin_bit_cast(float, (unsigned)h << 16); }
__device__ __forceinline__ float silu_f(float v) { return v * __builtin_amdgcn_rcpf(1.0f + __expf(-v)); }
__device__ __forceinline__ float wave_sum(float v) {
#pragma unroll
    for (int o = 1; o < 64; o <<= 1) v += __shfl_xor(v, o);
    return v;
}
#define LDS_WAIT() asm volatile("s_waitcnt lgkmcnt(0)" ::: "memory")

typedef float f32x2 __attribute__((ext_vector_type(2)));
__device__ __forceinline__ f32x2 swiglu2(f32x2 g, f32x2 u) {
    const f32x2 t = g * (-1.4426950408889634f);
    f32x2 e; e.x = __builtin_amdgcn_exp2f(t.x); e.y = __builtin_amdgcn_exp2f(t.y);
    const f32x2 dn = e + 1.0f;
    f32x2 r; r.x = __builtin_amdgcn_rcpf(dn.x); r.y = __builtin_amdgcn_rcpf(dn.y);
    return (g * u) * r;
}
struct EpiSwiglu {
    static constexpr bool PERM = true, AFTER_DRAIN = false;
    bf16_t* G;
    __device__ __forceinline__ void operator()(const f32x4 (&acc)[2][2][4][2], const pg8::Unit& u, int wr, int wc, int fr, int fq) const {
        const int row0 = u.pm * 256 + wr * 64 + fr, col0 = u.pn * 128 + wc * 32 + 8 * fq;
#pragma unroll
        for (int ai = 0; ai < 2; ++ai)
#pragma unroll
            for (int m = 0; m < 4; ++m) {
                bf16_t* p = G + (size_t)(row0 + ai * 128 + m * 16) * FF + col0;
                const f32x4 g0 = acc[ai][0][m][0], g1 = acc[ai][0][m][1], u0 = acc[ai][1][m][0], u1 = acc[ai][1][m][1];
                const f32x2 a = swiglu2((f32x2){g0[0], g0[1]}, (f32x2){u0[0], u0[1]}), b = swiglu2((f32x2){g0[2], g0[3]}, (f32x2){u0[2], u0[3]});
                const f32x2 c = swiglu2((f32x2){g1[0], g1[1]}, (f32x2){u1[0], u1[1]}), d = swiglu2((f32x2){g1[2], g1[3]}, (f32x2){u1[2], u1[3]});
                u32x4 w;
                w.x = pg8::cvt_pk_bf16(a.x, a.y); w.y = pg8::cvt_pk_bf16(b.x, b.y); w.z = pg8::cvt_pk_bf16(c.x, c.y); w.w = pg8::cvt_pk_bf16(d.x, d.y);
                *(u32x4*)p = w;
            }
    }
};
struct EpiResid {
    static constexpr bool PERM = false, AFTER_DRAIN = false;
    const float* src_lat; const float* src_ctx; float* dst_lat; float* dst_ctx; const float* mods; int midx; float scale;
    __device__ __forceinline__ void operator()(const f32x4 (&acc)[2][2][4][2], const pg8::Unit& u, int wr, int wc, int fr, int fq) const {
        const int cond = u.pm < 32 ? 0 : (u.pm < 64 ? 1 : 2);
        const int col0 = u.pn * 256 + wc * 32 + 4 * fq;
        const float* mrow = mods + cond * NMODS + midx * D + col0;
        f32x4 mv[2][2];
#pragma unroll
        for (int bj = 0; bj < 2; ++bj)
#pragma unroll
            for (int n = 0; n < 2; ++n) mv[bj][n] = *(const f32x4*)(mrow + bj * 128 + n * 16) * scale;
        const bool lat = u.pm < 64;
        const int rbase = (lat ? u.pm * 256 : (u.pm - 64) * 256) + wr * 64 + fr;
        const float* sb = lat ? src_lat : src_ctx; float* db = lat ? dst_lat : dst_ctx;
#pragma unroll
        for (int ai = 0; ai < 2; ++ai)
#pragma unroll
            for (int m = 0; m < 4; ++m) {
                const size_t ro = (size_t)(rbase + ai * 128 + m * 16) * D + col0;
#pragma unroll
                for (int bj = 0; bj < 2; ++bj)
#pragma unroll
                    for (int n = 0; n < 2; ++n) {
                        const f32x4 s = *(const f32x4*)(sb + ro + bj * 128 + n * 16);
                        *(f32x4*)(db + ro + bj * 128 + n * 16) = s + mv[bj][n] * acc[ai][bj][m][n];
                    }
                asm volatile("" ::: "memory");
            }
    }
};
struct EpiWin {
    static constexpr bool PERM = true, AFTER_DRAIN = false;
    bf16_t* P; float* LR;
    __device__ __forceinline__ void operator()(const f32x4 (&acc)[2][2][4][2], const pg8::Unit& u, int wr, int wc, int fr, int fq) const {
        const int pn = u.pn; const int rowb = u.pm * 256 + wr * 64 + fr;
        if (pn == 14) {
            if (wc == 0) {
#pragma unroll
                for (int ai = 0; ai < 2; ++ai)
#pragma unroll
                    for (int m = 0; m < 4; ++m) { float* p = LR + (size_t)(rowb + ai * 128 + m * 16) * 32 + 8 * fq; *(f32x4*)p = acc[ai][0][m][0]; *(f32x4*)(p + 4) = acc[ai][0][m][1]; }
            }
            return;
        }
        const bool rope = (pn < 4) && (u.pm < 64);
        const bool dosilu = (pn == 6) || (pn == 7) || (pn == 12) || (pn == 13);
        const float sc = pn < 2 ? 0.08838834764831845f : (pn == 8 ? 0.125f : 1.0f);
        const int col0 = pn * 256 + wc * 32 + 8 * fq;
        float frq[4];
#pragma unroll
        for (int j = 0; j < 4; ++j) frq[j] = exp2f(-(float)(16 * (wc & 1) + 4 * fq + j) * (13.287712379549449f / 32.0f));
#pragma unroll
        for (int ai = 0; ai < 2; ++ai)
#pragma unroll
            for (int m = 0; m < 4; ++m) {
                const int row = rowb + ai * 128 + m * 16;
                const int tok = row & 8191;
                const float pos = (float)((wc < 2) ? (tok >> 6) : (tok & 63));
#pragma unroll
                for (int bj = 0; bj < 2; ++bj) {
                    f32x4 v0 = acc[ai][bj][m][0] * sc, v1 = acc[ai][bj][m][1] * sc;
                    if (rope) {
#pragma unroll
                        for (int j = 0; j < 4; ++j) { const float ang = pos * frq[j]; const float sn = __sinf(ang), cs = __cosf(ang); const float a = v0[j], b = v1[j]; v0[j] = a * cs - b * sn; v1[j] = a * sn + b * cs; }
                    }
                    if (dosilu) {
#pragma unroll
                        for (int j = 0; j < 4; ++j) { v0[j] = silu_f(v0[j]); v1[j] = silu_f(v1[j]); }
                    }
                    u32x4 w; w.x = pg8::cvt_pk_bf16(v0[0], v0[1]); w.y = pg8::cvt_pk_bf16(v0[2], v0[3]); w.z = pg8::cvt_pk_bf16(v1[0], v1[1]); w.w = pg8::cvt_pk_bf16(v1[2], v1[3]);
                    *(u32x4*)(P + (size_t)row * PP + col0 + bj * 128) = w;
                }
            }
    }
};

struct CtxFirstOrder {
    int nN, nwg, G, c; unsigned* cnt; LAS unsigned* lcnt;
    __device__ void init(int G_, int c_, unsigned* cnt_, LAS unsigned* lcnt_) { nN = 22; nwg = 64 * 22; G = G_; c = c_; cnt = cnt_; lcnt = lcnt_; }
    __device__ bool next(int i, pg8::Unit& u) const {
        long L = (long)i * G + c;
        if (L < 44) { u.pm = 64 + (L >= 22 ? 1 : 0); u.pn = (int)(L % 22); return true; }
        L -= 44; if (L >= nwg) return false;
        int wgid = (int)L; { const int q = nwg / pg8::NXCD, r = nwg % pg8::NXCD, xcd = wgid % pg8::NXCD, off = wgid / pg8::NXCD; wgid = (xcd < r ? xcd * (q + 1) : r * (q + 1) + (xcd - r) * q) + off; }
        const int nig = pg8::WGM * nN, gid = wgid / nig, fm = gid * pg8::WGM, gsz = (64 - fm) < pg8::WGM ? (64 - fm) : pg8::WGM;
        u.pm = fm + ((wgid % nig) % gsz); u.pn = (wgid % nig) / gsz; return true;
    }
    __device__ __forceinline__ void a_ready(const pg8::Unit&) const {}
    __device__ __forceinline__ void done(const pg8::Unit& u) const {
        if (u.pm >= 64) {
            asm volatile("s_waitcnt vmcnt(0)" ::: "memory");
            unsigned old = 0u;
            if ((threadIdx.x & 63) == 0) old = __hip_atomic_fetch_add((LAS unsigned*)lcnt, 1u, __ATOMIC_RELAXED, __HIP_MEMORY_SCOPE_WORKGROUP);
            old = (unsigned)__builtin_amdgcn_readfirstlane((int)old);
            if ((old & 7u) == 7u) { __builtin_amdgcn_fence(__ATOMIC_RELEASE, "agent"); asm volatile("s_waitcnt vmcnt(0)" ::: "memory");
                if ((threadIdx.x & 63) == 0) __hip_atomic_fetch_add(cnt, 8u, __ATOMIC_RELAXED, __HIP_MEMORY_SCOPE_AGENT); }
        }
    }
};
struct OneUnit { int pm, pn;
    __device__ bool next(int i, pg8::Unit& u) const { if (i != 0) return false; u.pm = pm; u.pn = pn; return true; }
    __device__ __forceinline__ void a_ready(const pg8::Unit&) const {}
    __device__ __forceinline__ void done(const pg8::Unit&) const {}
};
struct EpiCtxAtomic {
    static constexpr bool PERM = false, AFTER_DRAIN = false;
    float* slab; const float* mods;
    __device__ __forceinline__ void operator()(const f32x4 (&acc)[2][2][4][2], const pg8::Unit& u, int wr, int wc, int fr, int fq) const {
        const int col0 = u.pn * 256 + wc * 32 + 4 * fq;
        const float* mrow = mods + 2 * NMODS + 2 * D + col0;
        f32x4 mv[2][2];
#pragma unroll
        for (int bj = 0; bj < 2; ++bj)
#pragma unroll
            for (int n = 0; n < 2; ++n) mv[bj][n] = *(const f32x4*)(mrow + bj * 128 + n * 16) * 0.5f;
#pragma unroll
        for (int ai = 0; ai < 2; ++ai)
#pragma unroll
            for (int m = 0; m < 4; ++m) {
                float* rp = slab + (size_t)(u.pm * 256 + ai * 128 + wr * 64 + m * 16 + fr) * D + col0;
#pragma unroll
                for (int bj = 0; bj < 2; ++bj)
#pragma unroll
                    for (int n = 0; n < 2; ++n) *(f32x4*)(rp + bj * 128 + n * 16) = mv[bj][n] * acc[ai][bj][m][n];
            }
    }
};

template <int MODE> struct EpiResidNorm {
    static constexpr bool PERM = false, AFTER_DRAIN = true;
    static constexpr int RMIDX = MODE == 0 ? 8 : (MODE == 1 ? 2 : 5), SH = MODE == 1 ? 3 : 6, SC = MODE == 1 ? 4 : 7, NWI = MODE == 0 ? 25 : (MODE == 1 ? 10 : 21);
    static constexpr float scale = MODE == 2 ? 1.0f : 0.5f;
    __device__ __forceinline__ void operator()(const f32x4 (&)[2][2][4][2], const pg8::Unit&, int, int, int, int) const {}
    __device__ __forceinline__ void fused(f32x4 (&acc)[2][2][4][2], const pg8::Unit& u, int wr, int wc, int fr, int fq, PG8_LAS unsigned char* lds, int wid, int lane) const {
        const __attribute__((address_space(4))) char* ka = (const __attribute__((address_space(4))) char*)__builtin_amdgcn_kernarg_segment_ptr();
        float* dst = *(float* const __attribute__((address_space(4)))*)(ka + 8 * 26);
        const float* src = *(const float* const __attribute__((address_space(4)))*)(ka + 8 * 0);
        unsigned char* wsb = *(unsigned char* const __attribute__((address_space(4)))*)(ka + 8 * 27);
        const bf16_t* srcb = MODE == 2 ? (const bf16_t*)dst : (const bf16_t*)(wsb + WS_SR);
        bf16_t* dstb = MODE == 1 ? (bf16_t*)dst : (bf16_t*)(wsb + WS_SR);
        const float* nw = *(const float* const __attribute__((address_space(4)))*)(ka + 8 * NWI);
        const float* mods = (const float*)(wsb + WS_MODS); float* xbuf = (float*)(wsb + WS_PART) + MODE * 65536; unsigned* pcnt = (unsigned*)(wsb + WS_CNT + 1024) + MODE * 4096;
        const int cond = u.pm < 32 ? 0 : 1;
        const int col0 = u.pn * 256 + wc * 32 + 4 * fq;
        const float* mrow = mods + cond * NMODS + RMIDX * D + col0;
        PG8_LAS float* P = (PG8_LAS float*)lds;
        PG8_LAS float* S = (PG8_LAS float*)(lds + 8192);
        {
            f32x4 mv[2][2];
#pragma unroll
            for (int bj = 0; bj < 2; ++bj)
#pragma unroll
                for (int n = 0; n < 2; ++n) mv[bj][n] = *(const f32x4*)(mrow + bj * 128 + n * 16) * scale;
#pragma unroll
            for (int ai = 0; ai < 2; ++ai)
#pragma unroll
                for (int m = 0; m < 4; ++m) {
                    const int r = ai * 128 + wr * 64 + m * 16 + fr;
                    const size_t ro = (size_t)(u.pm * 256 + r) * D + col0;
                    float sq = 0.f;
#pragma unroll
                    for (int bj = 0; bj < 2; ++bj)
#pragma unroll
                        for (int n = 0; n < 2; ++n) {
                            f32x4 xin;
                            if (MODE == 1) xin = __builtin_nontemporal_load((const f32x4*)(src + ro + bj * 128 + n * 16));
                            else { const u32x2 t = *(const u32x2*)(srcb + ro + bj * 128 + n * 16); xin = (f32x4){bflo(t.x), bfhi(t.x), bflo(t.y), bfhi(t.y)}; }
                            const f32x4 x = xin + mv[bj][n] * acc[ai][bj][m][n]; acc[ai][bj][m][n] = x; sq += (x[0] * x[0] + x[1] * x[1]) + (x[2] * x[2] + x[3] * x[3]);
                            if (MODE != 0) { u32x2 o; o.x = cvtpk(x[0], x[1]); o.y = cvtpk(x[2], x[3]); *(u32x2*)(dstb + ro + bj * 128 + n * 16) = o; } }
                    sq += __shfl_xor(sq, 16); sq += __shfl_xor(sq, 32);
                    if (fq == 0) P[r * 4 + wc] = sq;
                    asm volatile("" ::: "memory");
                }
        }
        asm volatile("s_waitcnt lgkmcnt(0)" ::: "memory"); __builtin_amdgcn_s_barrier(); asm volatile("" ::: "memory");
        const int row = wid * 32 + (lane & 31);
        if (lane < 32) {
            const float t = (P[row * 4 + 0] + P[row * 4 + 1]) + (P[row * 4 + 2] + P[row * 4 + 3]);
            __hip_atomic_store(xbuf + ((size_t)(u.pm * 256 + row) * 4 + u.pn), t, __ATOMIC_RELAXED, __HIP_MEMORY_SCOPE_AGENT);
        }
        asm volatile("s_waitcnt vmcnt(0)" ::: "memory");
        if (lane == 0) __hip_atomic_fetch_add(pcnt + 64 * u.pm, 1u, __ATOMIC_RELAXED, __HIP_MEMORY_SCOPE_AGENT);
        if (wid == 0) {
            unsigned spins = 0;
            while ((unsigned)__builtin_amdgcn_readfirstlane((int)__hip_atomic_load(pcnt + 64 * u.pm, __ATOMIC_RELAXED, __HIP_MEMORY_SCOPE_AGENT)) < 32u) { __builtin_amdgcn_s_sleep(2); if (++spins > (1u << 22)) break; }
            __builtin_amdgcn_fence(__ATOMIC_ACQUIRE, "agent");
        }
        asm volatile("s_waitcnt vmcnt(0) lgkmcnt(0)" ::: "memory"); __builtin_amdgcn_s_barrier(); asm volatile("" ::: "memory");
        if (lane < 32) {
            const unsigned long long* slot = (const unsigned long long*)(xbuf + (size_t)(u.pm * 256 + row) * 4);
            const unsigned long long s01 = __hip_atomic_load(slot, __ATOMIC_RELAXED, __HIP_MEMORY_SCOPE_AGENT), s23 = __hip_atomic_load(slot + 1, __ATOMIC_RELAXED, __HIP_MEMORY_SCOPE_AGENT);
            const float ss = (__builtin_bit_cast(float, (unsigned)s01) + __builtin_bit_cast(float, (unsigned)(s01 >> 32))) + (__builtin_bit_cast(float, (unsigned)s23) + __builtin_bit_cast(float, (unsigned)(s23 >> 32)));
            S[row] = 1.0f / sqrtf(ss * (1.0f / D) + EPS);
        }
        asm volatile("s_waitcnt lgkmcnt(0)" ::: "memory"); __builtin_amdgcn_s_barrier(); asm volatile("" ::: "memory");
        f32x4 wv[2][2], shv[2][2];
#pragma unroll
        for (int bj = 0; bj < 2; ++bj)
#pragma unroll
            for (int n = 0; n < 2; ++n) { wv[bj][n] = *(const f32x4*)(nw + col0 + bj * 128 + n * 16);
                if (MODE != 0) { wv[bj][n] = wv[bj][n] * (*(const f32x4*)(mods + cond * NMODS + SC * D + col0 + bj * 128 + n * 16) + 1.0f); shv[bj][n] = *(const f32x4*)(mods + cond * NMODS + SH * D + col0 + bj * 128 + n * 16); } }
        bf16_t* Hb = (bf16_t*)(wsb + WS_H);
#pragma unroll
        for (int ai = 0; ai < 2; ++ai)
#pragma unroll
            for (int m = 0; m < 4; ++m) {
                const int r = ai * 128 + wr * 64 + m * 16 + fr; const float rs = S[r];
                const size_t ro = (size_t)(u.pm * 256 + r) * D + col0;
#pragma unroll
                for (int bj = 0; bj < 2; ++bj)
#pragma unroll
                    for (int n = 0; n < 2; ++n) {
                        if (MODE == 0) __builtin_nontemporal_store(acc[ai][bj][m][n] * rs * wv[bj][n], (f32x4*)(dst + ro + bj * 128 + n * 16));
                        else { const f32x4 hh = acc[ai][bj][m][n] * rs * wv[bj][n] + shv[bj][n]; u32x2 o; o.x = pk2(hh[0], hh[1]); o.y = pk2(hh[2], hh[3]); *(u32x2*)(Hb + ro + bj * 128 + n * 16) = o; }
                    }
            }
    }
};

template <int MODE> __device__ __forceinline__ int dest_row(int n, int row_off) {
    if (MODE == 0) return n + row_off;
    if (MODE == 1) return (n >> 7) * 256 + (n & 127) + row_off;
    if (n >= 1024) return n;
    const int d = n & 127, half = d >> 6, x = (d >> 5) & 1, i = d & 31;
    const int wc = 2 * half + (i >> 4), fq = (i >> 2) & 3, j = i & 3;
    return (n & ~127) + 32 * wc + 8 * fq + 4 * x + j;
}
template <int MODE> __device__ __forceinline__ void transpose_item(const float* W, int K, int N, bf16_t* WT, int row_off, LAS float* scr, int item, int lane) {
    const int nblk = N / 32, kb = item / nblk, nb = item % nblk, k0 = 64 * kb, n0 = 32 * nb;
    float wv[32];
#pragma unroll
    for (int i = 0; i < 32; ++i) { const int kk = 2 * i + (lane >> 5); wv[i] = __builtin_nontemporal_load(W + (size_t)(k0 + kk) * N + n0 + (lane & 31)); }
#pragma unroll
    for (int i = 0; i < 32; ++i) { const int kk = 2 * i + (lane >> 5); scr[kk * 33 + (lane & 31)] = wv[i]; }
    LDS_WAIT();
    const int c = lane & 7;
#pragma unroll
    for (int j = 0; j < 4; ++j) { const int n = (lane >> 3) + 8 * j; const LAS float* s = scr + (8 * c) * 33 + n;
        u32x4 o; o.x = pk2(s[0 * 33], s[1 * 33]); o.y = pk2(s[2 * 33], s[3 * 33]); o.z = pk2(s[4 * 33], s[5 * 33]); o.w = pk2(s[6 * 33], s[7 * 33]);
        *(u32x4*)(WT + (size_t)dest_row<MODE>(n0 + n, row_off) * K + k0 + 8 * c) = o; }
    LDS_WAIT();
}
__device__ __forceinline__ void convert_ffn(const float* w1, const float* w3, const float* w2, bf16_t* W13, bf16_t* W2, LAS float* scr, int gw, int NGW, int lane) {
    constexpr int I13 = (D / 64) * (FF / 32), I2 = (FF / 64) * (D / 32);
    for (int it = gw; it < 2 * I13 + I2; it += NGW) {
        int r = it;
        if (r < I13) { transpose_item<1>(w1, D, FF, W13, 0, scr, r, lane); continue; } r -= I13;
        if (r < I13) { transpose_item<1>(w3, D, FF, W13, 128, scr, r, lane); continue; } r -= I13;
        transpose_item<0>(w2, FF, D, W2, 0, scr, r, lane);
    }
}

template <bool FROM_PART, bool FINAL>
__device__ __forceinline__ void norm_phase(LAS unsigned char* lds, const float* src_lat, const float* src_ctx, int nrows, const float* nw, const float* part, const float* ada_b, const float* mods,
                                           int shift_idx, int scale_idx, bf16_t* H, float* outf, int gw, int NGW, int tid, int lane, int row_begin = 0, const float* slabs = nullptr) {
    LAS float* tab = (LAS float*)lds;
    if (!FINAL) {
        for (int i4 = tid; i4 < 1536; i4 += NTHREADS) {
            const int idx = 4 * i4, cond = idx >> 11, which = (idx >> 10) & 1, col = idx & 1023, mi = which ? scale_idx : shift_idx;
            if (row_begin >= NLAT && cond != 2) continue;
            f32x4 v;
            if (FROM_PART) { v = *(const f32x4*)(ada_b + mi * D + col);
#pragma unroll
                for (int s = 0; s < 16; ++s) v += *(const f32x4*)(part + (size_t)(s * 3 + cond) * NMODS + mi * D + col); }
            else v = *(const f32x4*)(mods + cond * NMODS + mi * D + col);
            *(LAS f32x4*)(tab + idx) = v;
        }
        __syncthreads();
    }
    f32x4 wv[4];
#pragma unroll
    for (int j = 0; j < 4; ++j) wv[j] = *((const f32x4*)nw + 64 * j + lane);
    for (int row = row_begin + gw; row < nrows; row += 2 * NGW) {
        const int row2 = row + NGW; const bool has2 = row2 < nrows; const int r2 = has2 ? row2 : row;
        const float* xr = row < NLAT ? src_lat + (size_t)row * D : src_ctx + (size_t)(row - NLAT) * D;
        const float* xr2 = r2 < NLAT ? src_lat + (size_t)r2 * D : src_ctx + (size_t)(r2 - NLAT) * D;
        f32x4 v[2][4]; float s[2] = {0.f, 0.f};
#pragma unroll
        for (int j = 0; j < 4; ++j) { v[0][j] = __builtin_nontemporal_load((const f32x4*)xr + 64 * j + lane); v[1][j] = __builtin_nontemporal_load((const f32x4*)xr2 + 64 * j + lane); }
        if (slabs) {
#pragma unroll
            for (int q = 0; q < 2; ++q) { const size_t ro = (size_t)((q ? r2 : row) - NLAT) * D;
#pragma unroll
                for (int j = 0; j < 4; ++j)
#pragma unroll
                    for (int pt = 0; pt < 3; ++pt) v[q][j] += *((const f32x4*)(slabs + (size_t)pt * NCTX * D + ro) + 64 * j + lane); }
        }
#pragma unroll
        for (int q = 0; q < 2; ++q)
#pragma unroll
            for (int j = 0; j < 4; ++j) s[q] += (v[q][j].x * v[q][j].x + v[q][j].y * v[q][j].y) + (v[q][j].z * v[q][j].z + v[q][j].w * v[q][j].w);
#pragma unroll
        for (int q = 0; q < 2; ++q) {
            if (q == 1 && !has2) break;
            const int rr = q ? row2 : row;
            const float rstd = 1.0f / sqrtf(wave_sum(s[q]) * (1.0f / D) + EPS);
            if (FINAL) {
#pragma unroll
                for (int j = 0; j < 4; ++j) *((f32x4*)(outf + (size_t)rr * D) + 64 * j + lane) = v[q][j] * rstd * wv[j];
            } else {
                const int cond = rr < 8192 ? 0 : (rr < NLAT ? 1 : 2);
#pragma unroll
                for (int j = 0; j < 4; ++j) {
                    const f32x4 sh = *((const LAS f32x4*)(tab + (cond * 2 + 0) * 1024) + 64 * j + lane), scl = *((const LAS f32x4*)(tab + (cond * 2 + 1) * 1024) + 64 * j + lane);
                    const f32x4 hh = v[q][j] * rstd * wv[j] * (scl + 1.0f) + sh;
                    u32x2 o; o.x = pk2(hh.x, hh.y); o.y = pk2(hh.z, hh.w);
                    *((u32x2*)(H + (size_t)rr * D) + 64 * j + lane) = o;
                }
            }
        }
    }
}

__device__ __forceinline__ bf16x8 mk8(u32x2 lo, u32x2 hi) { u32x4 t; t.x = lo.x; t.y = lo.y; t.z = hi.x; t.w = hi.y; return __builtin_bit_cast(bf16x8, t); }
__device__ __forceinline__ bf16x8 row_frag(const LAS unsigned char* img, int pitch, int r0, int k0, int fr, int fq) { return *(const LAS bf16x8*)(img + (r0 + fr) * pitch + (k0 + 8 * fq) * 2); }
__device__ __forceinline__ void tr1(unsigned a0, unsigned a1, bf16x8& o) {
    u32x2 l0, h0;
    asm volatile("ds_read_b64_tr_b16 %0, %2\n\tds_read_b64_tr_b16 %1, %3\n\ts_waitcnt lgkmcnt(0)" : "=&v"(l0), "=&v"(h0) : "v"(a0), "v"(a1) : "memory");
    o = mk8(l0, h0);
}
__device__ __forceinline__ void tr2(unsigned a0, unsigned a1, bf16x8 (&o)[2]) {
    u32x2 l0, l1, h0, h1;
    asm volatile("ds_read_b64_tr_b16 %0, %4\n\tds_read_b64_tr_b16 %1, %4 offset:32\n\tds_read_b64_tr_b16 %2, %5\n\tds_read_b64_tr_b16 %3, %5 offset:32\n\ts_waitcnt lgkmcnt(0)"
                 : "=&v"(l0), "=&v"(l1), "=&v"(h0), "=&v"(h1) : "v"(a0), "v"(a1) : "memory");
    o[0] = mk8(l0, h0); o[1] = mk8(l1, h1);
}
__device__ __forceinline__ void tr4(unsigned a0, unsigned a1, bf16x8 (&o)[4]) {
    u32x2 l0, l1, l2, l3, h0, h1, h2, h3;
    asm volatile("ds_read_b64_tr_b16 %0, %8\n\tds_read_b64_tr_b16 %1, %8 offset:32\n\tds_read_b64_tr_b16 %2, %8 offset:64\n\tds_read_b64_tr_b16 %3, %8 offset:96\n\t"
                 "ds_read_b64_tr_b16 %4, %9\n\tds_read_b64_tr_b16 %5, %9 offset:32\n\tds_read_b64_tr_b16 %6, %9 offset:64\n\tds_read_b64_tr_b16 %7, %9 offset:96\n\ts_waitcnt lgkmcnt(0)"
                 : "=&v"(l0), "=&v"(l1), "=&v"(l2), "=&v"(l3), "=&v"(h0), "=&v"(h1), "=&v"(h2), "=&v"(h3) : "v"(a0), "v"(a1) : "memory");
    o[0] = mk8(l0, h0); o[1] = mk8(l1, h1); o[2] = mk8(l2, h2); o[3] = mk8(l3, h3);
}
__device__ __forceinline__ void tr8(unsigned a0, unsigned a1, bf16x8 (&o)[8]) {
    u32x2 l0, l1, l2, l3, l4, l5, l6, l7, h0, h1, h2, h3, h4, h5, h6, h7;
    asm volatile("ds_read_b64_tr_b16 %0, %16\n\tds_read_b64_tr_b16 %1, %16 offset:32\n\tds_read_b64_tr_b16 %2, %16 offset:64\n\tds_read_b64_tr_b16 %3, %16 offset:96\n\t"
                 "ds_read_b64_tr_b16 %4, %16 offset:128\n\tds_read_b64_tr_b16 %5, %16 offset:160\n\tds_read_b64_tr_b16 %6, %16 offset:192\n\tds_read_b64_tr_b16 %7, %16 offset:224\n\t"
                 "ds_read_b64_tr_b16 %8, %17\n\tds_read_b64_tr_b16 %9, %17 offset:32\n\tds_read_b64_tr_b16 %10, %17 offset:64\n\tds_read_b64_tr_b16 %11, %17 offset:96\n\t"
                 "ds_read_b64_tr_b16 %12, %17 offset:128\n\tds_read_b64_tr_b16 %13, %17 offset:160\n\tds_read_b64_tr_b16 %14, %17 offset:192\n\tds_read_b64_tr_b16 %15, %17 offset:224\n\ts_waitcnt lgkmcnt(0)"
                 : "=&v"(l0), "=&v"(l1), "=&v"(l2), "=&v"(l3), "=&v"(l4), "=&v"(l5), "=&v"(l6), "=&v"(l7), "=&v"(h0), "=&v"(h1), "=&v"(h2), "=&v"(h3), "=&v"(h4), "=&v"(h5), "=&v"(h6), "=&v"(h7)
                 : "v"(a0), "v"(a1) : "memory");
    o[0] = mk8(l0, h0); o[1] = mk8(l1, h1); o[2] = mk8(l2, h2); o[3] = mk8(l3, h3); o[4] = mk8(l4, h4); o[5] = mk8(l5, h5); o[6] = mk8(l6, h6); o[7] = mk8(l7, h7);
}
#define MFMA16(a, b, c) __builtin_amdgcn_mfma_f32_16x16x32_bf16((a), (b), (c), 0, 0, 0)

constexpr int PT128 = 288;
constexpr int PT64 = 160;
constexpr int IMG128 = 128 * PT128;
constexpr int IMG64 = 128 * PT64;

__device__ __forceinline__ float logsig(float z) { return fminf(z, 0.f) - __logf(1.0f + __expf(-fabsf(z))); }
__device__ __forceinline__ u32x4 scale8(u32x4 v, float s) {
    u32x4 o;
    o.x = cvtpk(bflo(v.x) * s, bfhi(v.x) * s); o.y = cvtpk(bflo(v.y) * s, bfhi(v.y) * s);
    o.z = cvtpk(bflo(v.z) * s, bfhi(v.z) * s); o.w = cvtpk(bflo(v.w) * s, bfhi(v.w) * s);
    return o;
}
__device__ __forceinline__ void stage128(LAS unsigned char* img, const bf16_t* src, int tid) {
#pragma unroll
    for (int i = 0; i < 4; ++i) { const int v = tid + NTHREADS * i, tok = v >> 4, ch = v & 15;
        *(LAS u32x4*)(img + tok * PT128 + ch * 16) = *(const u32x4*)(src + (size_t)tok * PP + ch * 8); }
}

__device__ __forceinline__ void p6_ret_item(LAS unsigned char* lds, const bf16_t* P, bf16_t* SR, const float* dec_f, const float* dec_b, int item, int tid, int wave, int lane) {
    asm volatile("" : "+v"(tid), "+v"(lane));
    const int tc = item % 66, bh = item / 66, h = bh & 3, b = bh >> 2;
    const int row0 = tc < 2 ? (NLAT + b * 256 + tc * 128) : (b * 8192 + (tc - 2) * 128);
    const float lgf = ((const LAS float*)(lds + LDS_BYTES - 128))[h], lgb = ((const LAS float*)(lds + LDS_BYTES - 128))[4 + h];
    LAS unsigned char* KF = lds; LAS unsigned char* KB = lds + IMG128; LAS unsigned char* V = lds + 2 * IMG128;
    for (int rep1 = 0; rep1 < (PROBE == 19 ? 2 : 1); ++rep1) {
    u32x4 kvr[4], vvr[4];
#pragma unroll
    for (int i = 0; i < 4; ++i) { const int v = tid + NTHREADS * i, tok = v >> 4, ch = v & 15;
        const bf16_t* prow = P + (size_t)(row0 + tok) * PP + h * 128 + ch * 8;
        kvr[i] = *(const u32x4*)(prow + 512); vvr[i] = *(const u32x4*)(prow + 1024); }
#pragma unroll
    for (int i = 0; i < 4; ++i) { const int v = tid + NTHREADS * i, tok = v >> 4, ch = v & 15;
        const float sf = __expf((float)(127 - tok) * lgf), sb = __expf((float)tok * lgb);
        *(LAS u32x4*)(KF + tok * PT128 + ch * 16) = scale8(kvr[i], sf);
        *(LAS u32x4*)(KB + tok * PT128 + ch * 16) = scale8(kvr[i], sb);
        *(LAS u32x4*)(V + tok * PT128 + ch * 16) = vvr[i]; }
    __syncthreads();
    }
    const int g = lane >> 4, q = (lane & 15) >> 2, p = lane & 3, fr = lane & 15, fq = g;
    const int rb = wave >> 1, cb = wave & 1;
    const unsigned base = (unsigned)(size_t)lds;
    f32x4 af[2][4], ab[2][4];
#pragma unroll
    for (int x = 0; x < 2; ++x)
#pragma unroll
        for (int y = 0; y < 4; ++y) { af[x][y] = (f32x4){0.f, 0.f, 0.f, 0.f}; ab[x][y] = (f32x4){0.f, 0.f, 0.f, 0.f}; }
    for (int rep2 = 0; rep2 < (PROBE == 20 ? 2 : 1); ++rep2)
#pragma unroll
    for (int ks = 0; ks < 4; ++ks) {
        const unsigned rofs = (unsigned)((32 * ks + 8 * g + q) * PT128 + 8 * p);
        bf16x8 vf[4], kf[2], kb[2];
        tr4(base + 2 * IMG128 + rofs + 128 * cb, base + 2 * IMG128 + rofs + 128 * cb + 4 * PT128, vf);
        tr2(base + rofs + 64 * rb, base + rofs + 64 * rb + 4 * PT128, kf);
        tr2(base + IMG128 + rofs + 64 * rb, base + IMG128 + rofs + 64 * rb + 4 * PT128, kb);
#pragma unroll
        for (int x = 0; x < 2; ++x)
#pragma unroll
            for (int y = 0; y < 4; ++y) { af[x][y] = MFMA16(kf[x], vf[y], af[x][y]); ab[x][y] = MFMA16(kb[x], vf[y], ab[x][y]); }
    }
    if (PROBE == 20) {
#pragma unroll
        for (int x = 0; x < 2; ++x)
#pragma unroll
            for (int y = 0; y < 4; ++y) { af[x][y] *= 0.5f; ab[x][y] *= 0.5f; } }
    bf16_t* Uf = SR + ((size_t)((0 * 2 + b) * 4 + h) * 66 + tc) * 16384;
    bf16_t* Ub = SR + ((size_t)((1 * 2 + b) * 4 + h) * 66 + tc) * 16384;
    for (int rep3 = 0; rep3 < (PROBE == 21 ? 2 : 1); ++rep3)
#pragma unroll
    for (int x = 0; x < 2; ++x)
#pragma unroll
        for (int y = 0; y < 4; ++y) {
            const int dk = 32 * rb + 16 * x + 4 * fq, dv = 64 * cb + 16 * y + fr;
#ifdef TEST_CLAMP
#pragma unroll
            for (int e = 0; e < 4; ++e) { af[x][y][e] = fminf(fmaxf(af[x][y][e], -1e4f), 1e4f); ab[x][y][e] = fminf(fmaxf(ab[x][y][e], -1e4f), 1e4f); }
#endif
            u32x2 o; o.x = pk2(af[x][y][0], af[x][y][1]); o.y = pk2(af[x][y][2], af[x][y][3]);
            *(u32x2*)(Uf + dv * 128 + dk) = o;
            o.x = pk2(ab[x][y][0], ab[x][y][1]); o.y = pk2(ab[x][y][2], ab[x][y][3]);
            *(u32x2*)(Ub + dv * 128 + dk) = o;
        }
    __syncthreads();
}

constexpr int LRS_OFF = 122880;
constexpr int DTAB_OFF = LRS_OFF + 16384;
__device__ __forceinline__ void gla_gates(LAS unsigned char* lds, LAS float* tot, const float* LR, const float* wf, const float* bfv, const float* wb, const float* bbv, int row0, int h, int tid, int wave,
                                          float (&bf)[16], float (&bb)[16], float& totf, float& totb) {
    const int d = tid & 63, col = h * 64 + d;
    LAS float* lrs = (LAS float*)(lds + LRS_OFF);
    { const f32x4* srcv = (const f32x4*)(LR + (size_t)row0 * 32); const f32x4 v0 = srcv[tid], v1 = srcv[tid + NTHREADS]; *((LAS f32x4*)lrs + tid) = v0; *((LAS f32x4*)lrs + tid + NTHREADS) = v1; }
    f32x2 wf2[8], wb2[8];
#pragma unroll
    for (int r = 0; r < 8; ++r) { wf2[r] = (f32x2){wf[(2 * r) * 256 + col], wf[(2 * r + 1) * 256 + col]}; wb2[r] = (f32x2){wb[(2 * r) * 256 + col], wb[(2 * r + 1) * 256 + col]}; }
    const float biasf = bfv[col], biasb = bbv[col];
    __syncthreads();
#pragma unroll
    for (int t = 0; t < 16; ++t) {
        const LAS float* lr = lrs + (16 * wave + t) * 32;
        f32x2 zf = (f32x2){biasf, 0.f}, zb = (f32x2){biasb, 0.f};
#pragma unroll
        for (int r4 = 0; r4 < 4; ++r4) { const f32x4 a = *(const LAS f32x4*)(lr + 4 * r4), c = *(const LAS f32x4*)(lr + 16 + 4 * r4);
            zf = __builtin_elementwise_fma((f32x2){a.x, a.y}, wf2[2 * r4], zf); zf = __builtin_elementwise_fma((f32x2){a.z, a.w}, wf2[2 * r4 + 1], zf);
            zb = __builtin_elementwise_fma((f32x2){c.x, c.y}, wb2[2 * r4], zb); zb = __builtin_elementwise_fma((f32x2){c.z, c.w}, wb2[2 * r4 + 1], zb); }
        bf[t] = logsig(zf.x + zf.y) * (1.0f / 16.0f); bb[t] = logsig(zb.x + zb.y) * (1.0f / 16.0f);
    }
#pragma unroll
    for (int t = 1; t < 16; ++t) bf[t] += bf[t - 1];
#pragma unroll
    for (int t = 14; t >= 0; --t) bb[t] += bb[t + 1];
    tot[wave * 64 + d] = bf[15]; tot[512 + wave * 64 + d] = bb[0];
    __syncthreads();
    const int sub = wave >> 2, gi = wave & 3;
    float pf = 0.f, sb = 0.f; totf = 0.f; totb = 0.f;
#pragma unroll
    for (int g2 = 0; g2 < 4; ++g2) { const float a = tot[(sub * 4 + g2) * 64 + d], c = tot[512 + (sub * 4 + g2) * 64 + d]; totf += a; totb += c; if (g2 < gi) pf += a; if (g2 > gi) sb += c; }
#pragma unroll
    for (int t = 0; t < 16; ++t) { bf[t] += pf; bb[t] += sb; }
}

__device__ __forceinline__ void p6_gla_item(LAS unsigned char* lds, const bf16_t* P, const float* LR, bf16_t* SG, float* DG, const float* wf, const float* bfv, const float* wb, const float* bbv,
                                            int item, int tid, int wave, int lane) {
    asm volatile("" : "+v"(tid), "+v"(lane));
    const int tc = item % 66, bh = item / 66, h = bh & 3, b = bh >> 2;
    const int row0 = tc < 2 ? (NLAT + b * 256 + tc * 128) : (b * 8192 + (tc - 2) * 128);
    LAS unsigned char* KF = lds; LAS unsigned char* KB = lds + IMG64; LAS unsigned char* V = lds + 2 * IMG64; LAS float* tot = (LAS float*)(lds + 2 * IMG64 + IMG128);
    stage128(V, P + (size_t)row0 * PP + 2560 + h * 128, tid);
    const int d = tid & 63, sub = wave >> 2;
    bf16_t kraw[16];
#pragma unroll
    for (int t = 0; t < 16; ++t) kraw[t] = P[(size_t)(row0 + 16 * wave + t) * PP + 2304 + h * 64 + d];
    float bf[16], bb[16], totf, totb;
    gla_gates(lds, tot, LR, wf, bfv, wb, bbv, row0, h, tid, wave, bf, bb, totf, totb);
    const int chf = (0 * 2 + b) * 4 + h, chb = (1 * 2 + b) * 4 + h, tc64 = 2 * tc + sub;
#pragma unroll
    for (int t = 0; t < 16; ++t) {
        const int tok = 16 * wave + t;
        const float kv = bf2f(kraw[t]);
        *(LAS bf16_t*)(KF + tok * PT64 + d * 2) = (bf16_t)cvtpk(kv * __expf(totf - bf[t]), 0.f);
        *(LAS bf16_t*)(KB + tok * PT64 + d * 2) = (bf16_t)cvtpk(kv * __expf(totb - bb[t]), 0.f);
    }
    if ((wave & 3) == 0) { DG[((size_t)chf * 132 + tc64) * 64 + d] = __expf(totf); DG[((size_t)chb * 132 + tc64) * 64 + d] = __expf(totb); }
    __syncthreads();
    const int g = lane >> 4, q = (lane & 15) >> 2, p = lane & 3, fr = lane & 15, fq = g, wl = wave & 3;
    const unsigned base = (unsigned)(size_t)lds;
    f32x4 af[8], ab[8];
#pragma unroll
    for (int y = 0; y < 8; ++y) { af[y] = (f32x4){0.f, 0.f, 0.f, 0.f}; ab[y] = (f32x4){0.f, 0.f, 0.f, 0.f}; }
#pragma unroll
    for (int ks = 0; ks < 2; ++ks) {
        const int r = sub * 64 + 32 * ks + 8 * g + q;
        bf16x8 vf[8], xf, xb;
        tr8(base + 2 * IMG64 + r * PT128 + 8 * p, base + 2 * IMG64 + (r + 4) * PT128 + 8 * p, vf);
        tr1(base + r * PT64 + 32 * wl + 8 * p, base + (r + 4) * PT64 + 32 * wl + 8 * p, xf);
        tr1(base + IMG64 + r * PT64 + 32 * wl + 8 * p, base + IMG64 + (r + 4) * PT64 + 32 * wl + 8 * p, xb);
#pragma unroll
        for (int y = 0; y < 8; ++y) { af[y] = MFMA16(xf, vf[y], af[y]); ab[y] = MFMA16(xb, vf[y], ab[y]); }
    }
    bf16_t* Uf = SG + ((size_t)chf * 132 + tc64) * 8192;
    bf16_t* Ub = SG + ((size_t)chb * 132 + tc64) * 8192;
#pragma unroll
    for (int y = 0; y < 8; ++y) {
        const int dk = 16 * wl + 4 * fq, dv = 16 * y + fr;
        u32x2 o; o.x = pk2(af[y][0], af[y][1]); o.y = pk2(af[y][2], af[y][3]);
        *(u32x2*)(Uf + dv * 64 + dk) = o;
        o.x = pk2(ab[y][0], ab[y][1]); o.y = pk2(ab[y][2], ab[y][3]);
        *(u32x2*)(Ub + dv * 64 + dk) = o;
    }
    __syncthreads();
}

__device__ __forceinline__ void p7_scan(bf16_t* SR, bf16_t* SG, const float* DG, const float* dec_f, const float* dec_b, int gtid, int gthreads) {
    for (int task = gtid; task < 65536 + 32768; task += gthreads) {
        if (task < 65536) {
            const int chain = task >> 12, e4 = task & 4095, dir = chain >> 3, h = chain & 3;
            const float lg = -log1pf(expf(-(dir ? dec_b[h] : dec_f[h])));
            const float dec = expf(128.0f * lg);
            bf16_t* basep = SR + (size_t)chain * 66 * 16384 + e4 * 4;
            f32x4 s = (f32x4){0.f, 0.f, 0.f, 0.f};
            for (int n0 = 0; n0 < 66; n0 += 11) {
                u32x2 u[11];
#pragma unroll
                for (int i = 0; i < 11; ++i) { const int n = n0 + i; const int tc = dir ? (n < 2 ? 1 - n : 67 - n) : n; u[i] = __builtin_nontemporal_load((const u32x2*)(basep + (size_t)tc * 16384)); }
#pragma unroll
                for (int i = 0; i < 11; ++i) { const int n = n0 + i; const int tc = dir ? (n < 2 ? 1 - n : 67 - n) : n;
                    u32x2 o; o.x = pk2(s.x, s.y); o.y = pk2(s.z, s.w);
                    *(u32x2*)(basep + (size_t)tc * 16384) = o;
                    s.x = dec * s.x + bflo(u[i].x); s.y = dec * s.y + bfhi(u[i].x); s.z = dec * s.z + bflo(u[i].y); s.w = dec * s.w + bfhi(u[i].y); }
            }
        } else {
            const int t2 = task - 65536, chain = t2 >> 11, e4 = t2 & 2047, dir = chain >> 3, dk0 = (e4 * 4) & 63;
            bf16_t* basep = SG + (size_t)chain * 132 * 8192 + e4 * 4;
            const float* dgp = DG + (size_t)chain * 132 * 64 + dk0;
            f32x4 s = (f32x4){0.f, 0.f, 0.f, 0.f};
            for (int n0 = 0; n0 < 132; n0 += 11) {
                u32x2 u[11]; f32x4 dc[11];
#pragma unroll
                for (int i = 0; i < 11; ++i) { const int n = n0 + i; const int tc = dir ? (n < 4 ? 3 - n : 135 - n) : n; u[i] = __builtin_nontemporal_load((const u32x2*)(basep + (size_t)tc * 8192)); dc[i] = *(const f32x4*)(dgp + tc * 64); }
#pragma unroll
                for (int i = 0; i < 11; ++i) { const int n = n0 + i; const int tc = dir ? (n < 4 ? 3 - n : 135 - n) : n;
                    u32x2 o; o.x = pk2(s.x, s.y); o.y = pk2(s.z, s.w);
                    *(u32x2*)(basep + (size_t)tc * 8192) = o;
                    s.x = dc[i].x * s.x + bflo(u[i].x); s.y = dc[i].y * s.y + bfhi(u[i].x); s.z = dc[i].z * s.z + bflo(u[i].y); s.w = dc[i].w * s.w + bfhi(u[i].y); }
            }
        }
    }
}

__device__ __forceinline__ void p8_ret_item(LAS unsigned char* lds, const bf16_t* P, const bf16_t* SR, bf16_t* Hm, const float* dec_f, const float* dec_b, const float* normw,
                                            int item, int tid, int wave, int lane) {
    asm volatile("" : "+v"(tid), "+v"(lane));
    const int c = item & 63, bh = item >> 6, h = bh & 3, b = bh >> 2;
    const int row0 = b * 8192 + c * 128, tc = c + 2;
    const float lgf = ((const LAS float*)(lds + LDS_BYTES - 128))[h], lgb = ((const LAS float*)(lds + LDS_BYTES - 128))[4 + h];
    LAS unsigned char* Q = lds; LAS unsigned char* K = lds + IMG128; LAS unsigned char* V = lds + 2 * IMG128;
    const LAS float* dtab = (const LAS float*)(lds + DTAB_OFF) + h * 256 + 127;
    stage128(Q, P + (size_t)row0 * PP + h * 128, tid);
    stage128(K, P + (size_t)row0 * PP + 512 + h * 128, tid);
    stage128(V, P + (size_t)row0 * PP + 1024 + h * 128, tid);
    const bf16_t* Sf = SR + ((size_t)((0 * 2 + b) * 4 + h) * 66 + tc) * 16384;
    const bf16_t* Sb = SR + ((size_t)((1 * 2 + b) * 4 + h) * 66 + tc) * 16384;
    u32x4 sfr[4], sbr[4];
#pragma unroll
    for (int i = 0; i < 4; ++i) { sfr[i] = *(const u32x4*)(Sf + (size_t)(tid + NTHREADS * i) * 8); sbr[i] = *(const u32x4*)(Sb + (size_t)(tid + NTHREADS * i) * 8); }
    __syncthreads();
    const int g = lane >> 4, q = (lane & 15) >> 2, p = lane & 3, fr = lane & 15, fq = g;
    const int i0 = 16 * wave;
    const unsigned base = (unsigned)(size_t)lds;
    bf16x8 qf[4];
#pragma unroll
    for (int ks = 0; ks < 4; ++ks) qf[ks] = row_frag(Q, PT128, i0, 32 * ks, fr, fq);
    u32x2 scp[8];
#pragma unroll
    for (int jb = 0; jb < 8; ++jb) {
        f32x4 a = (f32x4){0.f, 0.f, 0.f, 0.f};
#pragma unroll
        for (int ks = 0; ks < 4; ++ks) a = MFMA16(row_frag(K, PT128, 16 * jb, 32 * ks, fr, fq), qf[ks], a);
        const int i = i0 + fr;
#pragma unroll
        for (int e = 0; e < 4; ++e) a[e] *= dtab[i - (16 * jb + 4 * fq + e)];
        scp[jb].x = pg8::cvt_pk_bf16(a[0], a[1]); scp[jb].y = pg8::cvt_pk_bf16(a[2], a[3]);
        asm volatile("" ::: "memory");
    }
    f32x4 ao[8];
#pragma unroll
    for (int y = 0; y < 8; ++y) ao[y] = (f32x4){0.f, 0.f, 0.f, 0.f};
#pragma unroll
    for (int s2 = 0; s2 < 4; ++s2) {
        const bf16x8 xs = mk8(scp[2 * s2], scp[2 * s2 + 1]);
        const int r = 32 * s2 + 4 * g + q;
        bf16x8 vf[8];
        tr8(base + 2 * IMG128 + r * PT128 + 8 * p, base + 2 * IMG128 + (r + 16) * PT128 + 8 * p, vf);
#pragma unroll
        for (int y = 0; y < 8; ++y) ao[y] = MFMA16(vf[y], xs, ao[y]);
    }
    __syncthreads();
#pragma unroll
    for (int i = 0; i < 4; ++i) { const int v = tid + NTHREADS * i, dv = v >> 4, ch = v & 15;
        *(LAS u32x4*)(Q + dv * PT128 + ch * 16) = sfr[i]; *(LAS u32x4*)(K + dv * PT128 + ch * 16) = sbr[i]; }
    __syncthreads();
    const float qsf = __expf((float)(i0 + fr + 1) * lgf), qsb = __expf((float)(128 - i0 - fr) * lgb);
#pragma unroll
    for (int ks = 0; ks < 4; ++ks) {
        const bf16x8 xf = __builtin_bit_cast(bf16x8, scale8(__builtin_bit_cast(u32x4, qf[ks]), qsf)), xb = __builtin_bit_cast(bf16x8, scale8(__builtin_bit_cast(u32x4, qf[ks]), qsb));
#pragma unroll
        for (int y = 0; y < 8; ++y) ao[y] = MFMA16(row_frag(Q, PT128, 16 * y, 32 * ks, fr, fq), xf, ao[y]);
#pragma unroll
        for (int y = 0; y < 8; ++y) ao[y] = MFMA16(row_frag(K, PT128, 16 * y, 32 * ks, fr, fq), xb, ao[y]);
        asm volatile("" ::: "memory");
    }
    float s1 = 0.f, sq = 0.f;
#pragma unroll
    for (int y = 0; y < 8; ++y) s1 += (ao[y][0] + ao[y][1]) + (ao[y][2] + ao[y][3]);
    s1 += __shfl_xor(s1, 16); s1 += __shfl_xor(s1, 32);
    const float mu = s1 * (1.0f / 128.0f);
#pragma unroll
    for (int y = 0; y < 8; ++y)
#pragma unroll
        for (int e = 0; e < 4; ++e) { const float dlt = ao[y][e] - mu; sq += dlt * dlt; }
    sq += __shfl_xor(sq, 16); sq += __shfl_xor(sq, 32);
    const float rstd = 1.0f / sqrtf(sq * (1.0f / 128.0f) + EPS);
    const int row = row0 + i0 + fr;
    const bf16_t* gp = P + (size_t)row * PP + 1536 + h * 128 + 4 * fq;
    bf16_t* op = Hm + (size_t)row * D + h * 128 + 4 * fq;
    const float* wp = normw + h * 128 + 4 * fq;
#pragma unroll
    for (int y = 0; y < 8; ++y) {
        const u32x2 gt = *(const u32x2*)(gp + 16 * y); const f32x4 w = *(const f32x4*)(wp + 16 * y);
        u32x2 o;
        o.x = pk2((ao[y][0] - mu) * rstd * w.x * bflo(gt.x), (ao[y][1] - mu) * rstd * w.y * bfhi(gt.x));
        o.y = pk2((ao[y][2] - mu) * rstd * w.z * bflo(gt.y), (ao[y][3] - mu) * rstd * w.w * bfhi(gt.y));
        *(u32x2*)(op + 16 * y) = o;
    }
    __syncthreads();
}

__device__ __forceinline__ void p8_gla_item(LAS unsigned char* lds, const bf16_t* P, const float* LR, const bf16_t* SG, bf16_t* Hm, const float* wf, const float* bfv, const float* wb, const float* bbv,
                                            const float* normw, int item, int tid, int wave, int lane) {
    asm volatile("" : "+v"(tid), "+v"(lane));
    const int c = item & 63, bh = item >> 6, h = bh & 3, b = bh >> 2;
    const int row0 = b * 8192 + c * 128;
    LAS unsigned char* QF = lds; LAS unsigned char* KF = lds + IMG64; LAS unsigned char* QB = lds + 2 * IMG64; LAS unsigned char* KB = lds + 3 * IMG64; LAS unsigned char* V = lds + 4 * IMG64;
    LAS float* tot = (LAS float*)(lds + 4 * IMG64 + IMG128);
    stage128(V, P + (size_t)row0 * PP + 2560 + h * 128, tid);
    const bf16_t* Sf = SG + ((size_t)((0 * 2 + b) * 4 + h) * 132 + 4 + 2 * c) * 8192;
    const bf16_t* Sb = SG + ((size_t)((1 * 2 + b) * 4 + h) * 132 + 4 + 2 * c) * 8192;
    u32x4 sfr[4], sbr[4];
#pragma unroll
    for (int i = 0; i < 4; ++i) { sfr[i] = *(const u32x4*)(Sf + (size_t)(tid + NTHREADS * i) * 8); sbr[i] = *(const u32x4*)(Sb + (size_t)(tid + NTHREADS * i) * 8); }
    const int d = tid & 63, sub = wave >> 2, wl = wave & 3;
    bf16_t qraw[16], kraw[16];
#pragma unroll
    for (int t = 0; t < 16; ++t) { const bf16_t* pr = P + (size_t)(row0 + 16 * wave + t) * PP + h * 64 + d; qraw[t] = pr[2048]; kraw[t] = pr[2304]; }
    float bf[16], bb[16], totf, totb;
    gla_gates(lds, tot, LR, wf, bfv, wb, bbv, row0, h, tid, wave, bf, bb, totf, totb);
#pragma unroll
    for (int t = 0; t < 16; ++t) {
        const int tok = 16 * wave + t;
        const float qv = bf2f(qraw[t]), kv = bf2f(kraw[t]);
        const float ef = __expf(bf[t]), eb = __expf(bb[t]);
        *(LAS bf16_t*)(QF + tok * PT64 + d * 2) = (bf16_t)cvtpk(qv * ef, 0.f);
        *(LAS bf16_t*)(KF + tok * PT64 + d * 2) = (bf16_t)cvtpk(kv * __builtin_amdgcn_rcpf(ef), 0.f);
        *(LAS bf16_t*)(QB + tok * PT64 + d * 2) = (bf16_t)cvtpk(qv * eb, 0.f);
        *(LAS bf16_t*)(KB + tok * PT64 + d * 2) = (bf16_t)cvtpk(kv * __builtin_amdgcn_rcpf(eb), 0.f);
    }
    __syncthreads();
    const int g = lane >> 4, q = (lane & 15) >> 2, p = lane & 3, fr = lane & 15, fq = g;
    const int i0 = sub * 64 + 16 * wl;
    const unsigned base = (unsigned)(size_t)lds;
    bf16x8 qff[2], qbf[2];
#pragma unroll
    for (int ks = 0; ks < 2; ++ks) { qff[ks] = row_frag(QF, PT64, i0, 32 * ks, fr, fq); qbf[ks] = row_frag(QB, PT64, i0, 32 * ks, fr, fq); }
    u32x2 scp[4];
#pragma unroll
    for (int jb = 0; jb < 4; ++jb) {
        f32x4 a = (f32x4){0.f, 0.f, 0.f, 0.f}, a2 = (f32x4){0.f, 0.f, 0.f, 0.f};
#pragma unroll
        for (int ks = 0; ks < 2; ++ks) { a = MFMA16(row_frag(KF, PT64, sub * 64 + 16 * jb, 32 * ks, fr, fq), qff[ks], a); a2 = MFMA16(row_frag(KB, PT64, sub * 64 + 16 * jb, 32 * ks, fr, fq), qbf[ks], a2); }
        const int il = 16 * wl + fr;
        float v[4];
#pragma unroll
        for (int e = 0; e < 4; ++e) { const float dd = (float)(il - (16 * jb + 4 * fq + e)); v[e] = a[e] * fminf(fmaxf(dd + 1.0f, 0.f), 1.0f) + a2[e] * fminf(fmaxf(1.0f - dd, 0.f), 1.0f); }
        scp[jb].x = pg8::cvt_pk_bf16(v[0], v[1]); scp[jb].y = pg8::cvt_pk_bf16(v[2], v[3]);
        asm volatile("" ::: "memory");
    }
    f32x4 ao[8];
#pragma unroll
    for (int y = 0; y < 8; ++y) ao[y] = (f32x4){0.f, 0.f, 0.f, 0.f};
#pragma unroll
    for (int s2 = 0; s2 < 2; ++s2) {
        const bf16x8 xs = mk8(scp[2 * s2], scp[2 * s2 + 1]);
        const int r = sub * 64 + 32 * s2 + 4 * g + q;
        bf16x8 vf[8];
        tr8(base + 4 * IMG64 + r * PT128 + 8 * p, base + 4 * IMG64 + (r + 16) * PT128 + 8 * p, vf);
#pragma unroll
        for (int y = 0; y < 8; ++y) ao[y] = MFMA16(vf[y], xs, ao[y]);
    }
    __syncthreads();
#pragma unroll
    for (int i = 0; i < 4; ++i) { const int v = tid + NTHREADS * i, m = v >> 10, dv = (v >> 3) & 127, ch = v & 7;
        *(LAS u32x4*)(lds + m * IMG64 + dv * PT64 + ch * 16) = sfr[i]; *(LAS u32x4*)(lds + (2 + m) * IMG64 + dv * PT64 + ch * 16) = sbr[i]; }
    __syncthreads();
    const LAS unsigned char* SFI = lds + sub * IMG64; const LAS unsigned char* SBI = lds + (2 + sub) * IMG64;
#pragma unroll
    for (int ks = 0; ks < 2; ++ks) {
#pragma unroll
        for (int y = 0; y < 8; ++y) ao[y] = MFMA16(row_frag(SFI, PT64, 16 * y, 32 * ks, fr, fq), qff[ks], ao[y]);
#pragma unroll
        for (int y = 0; y < 8; ++y) ao[y] = MFMA16(row_frag(SBI, PT64, 16 * y, 32 * ks, fr, fq), qbf[ks], ao[y]);
        asm volatile("" ::: "memory");
    }
    float ss = 0.f;
#pragma unroll
    for (int y = 0; y < 8; ++y)
#pragma unroll
        for (int e = 0; e < 4; ++e) ss += ao[y][e] * ao[y][e];
    ss += __shfl_xor(ss, 16); ss += __shfl_xor(ss, 32);
    const float rstd = 1.0f / sqrtf(ss * (1.0f / 128.0f) + EPS);
    const int row = row0 + i0 + fr;
    const bf16_t* gp = P + (size_t)row * PP + 3072 + h * 128 + 4 * fq;
    bf16_t* op = Hm + (size_t)row * D + 512 + h * 128 + 4 * fq;
    const float* wp = normw + h * 128 + 4 * fq;
#pragma unroll
    for (int y = 0; y < 8; ++y) {
        const u32x2 gt = *(const u32x2*)(gp + 16 * y); const f32x4 w = *(const f32x4*)(wp + 16 * y);
        u32x2 o;
        o.x = pk2(ao[y][0] * rstd * w.x * bflo(gt.x), ao[y][1] * rstd * w.y * bfhi(gt.x));
        o.y = pk2(ao[y][2] * rstd * w.z * bflo(gt.y), ao[y][3] * rstd * w.w * bfhi(gt.y));
        *(u32x2*)(op + 16 * y) = o;
    }
    __syncthreads();
}

#define XB_TMO      128
#define XB_XCNT(j)  (256  + 64 * (j))
#define XB_XSUB(j)  (1280 + 64 * (j))
#define XB_XGEN(j)  (2304 + 64 * (j))
#define XB_TOP      3328
#define XB_TOPGEN   3392
#define XCD_BAR_WORDS 3456
#define XB_SPIN_CAP (1u << 18)

__device__ __forceinline__ unsigned xb_ld(unsigned* p)              { return __hip_atomic_load(p, __ATOMIC_RELAXED, __HIP_MEMORY_SCOPE_AGENT); }
__device__ __forceinline__ unsigned xb_add(unsigned* p, unsigned v) { return __hip_atomic_fetch_add(p, v, __ATOMIC_RELAXED, __HIP_MEMORY_SCOPE_AGENT); }
__device__ __forceinline__ unsigned xb_xcc_id() { return (unsigned)__builtin_amdgcn_s_getreg((3 << 11) | 20) & 0xFu; }
#define XB_SPIN(cond, bar) do { unsigned _sp = 0; while (cond) { __builtin_amdgcn_s_sleep(1); \
    if ((++_sp & 255u) == 0u) { if (xb_ld(&(bar)[XB_TMO])) break; if (_sp > XB_SPIN_CAP) { atomicAdd(&(bar)[XB_TMO], 1u); break; } } } } while (0)

struct XcdBarrier {
    unsigned* bar; unsigned x;
    volatile LAS unsigned* st;
};

__device__ __forceinline__ XcdBarrier xcd_barrier_post(unsigned* bar, volatile LAS unsigned* st) {
    XcdBarrier b; b.bar = bar; b.x = xb_xcc_id(); b.st = st;
    if (threadIdx.x == 0) (void)xb_add(&bar[XB_XCNT(b.x)], 1u);
    return b;
}
__device__ __forceinline__ void xcd_barrier_complete(unsigned* bar, unsigned x, unsigned& nloc, unsigned& nx) {
    const unsigned G = gridDim.x * gridDim.y * gridDim.z;
    unsigned sum, cnt, mine, sp = 0u;
    for (;;) {
        sum = 0u; cnt = 0u; mine = 0u;
#pragma unroll
        for (unsigned j = 0; j < 16; ++j) { const unsigned c = xb_ld(&bar[XB_XCNT(j)]); sum += c; cnt += (c > 0u) ? 1u : 0u; mine = (j == x) ? c : mine; }
        if (sum == G) break;
        __builtin_amdgcn_s_sleep(1);
        if ((++sp & 255u) == 0u) { if (xb_ld(&bar[XB_TMO])) break; if (sp > XB_SPIN_CAP) { atomicAdd(&bar[XB_TMO], 1u); break; } }
    }
    nloc = mine > 0u ? mine : 1u; nx = cnt > 0u ? cnt : 1u;
}

__device__ __forceinline__ void xcd_barrier(const XcdBarrier& b) {
    asm volatile("s_waitcnt vmcnt(0)" ::: "memory");
    __syncthreads();
    if (threadIdx.x == 0) {
        unsigned* bar = b.bar;
        __builtin_amdgcn_s_waitcnt(0);
        unsigned nloc = b.st[0], nx = b.st[1];
        if (nloc == 0u) { xcd_barrier_complete(bar, b.x, nloc, nx); b.st[0] = nloc; b.st[1] = nx; }
        const unsigned old = xb_add(&bar[XB_XSUB(b.x)], 1u);
        const unsigned gen = old / nloc;
        if (old + 1u == (gen + 1u) * nloc) {
            __builtin_amdgcn_fence(__ATOMIC_RELEASE, "agent");
            asm volatile("s_waitcnt vmcnt(0)" ::: "memory");
            const unsigned og = xb_add(&bar[XB_TOP], 1u);
            const unsigned tg = og / nx;
            if (og + 1u == (tg + 1u) * nx) xb_add(&bar[XB_TOPGEN], 1u);
            else XB_SPIN(xb_ld(&bar[XB_TOPGEN]) == tg, bar);
            __builtin_amdgcn_fence(__ATOMIC_ACQUIRE, "agent");
            xb_add(&bar[XB_XGEN(b.x)], 1u);
            asm volatile("s_waitcnt vmcnt(0)" ::: "memory");
        } else {
            XB_SPIN(xb_ld(&bar[XB_XGEN(b.x)]) == gen, bar);
            __builtin_amdgcn_fence(__ATOMIC_ACQUIRE, "agent");
            asm volatile("s_waitcnt vmcnt(0)" ::: "memory");
        }
    }
    __syncthreads();
}


__device__ __attribute__((noinline)) void xcd_barrier_ool(unsigned* barp, unsigned x, volatile LAS unsigned* st) { XcdBarrier b; b.bar = barp; b.x = x; b.st = st; xcd_barrier(b); }

#ifndef PHM
#define PHM 0xffff
#endif
struct Args { const float* in[26]; float* out; unsigned char* ws; };
enum { I_X = 0, I_C, I_CTX, I_CCTX, I_ADAW, I_ADAB, I_N1W, I_F1W1, I_F1W3, I_F1W2, I_N2W, I_WIN, I_RDF, I_RDB, I_RNW, I_GWF, I_GBF, I_GWB, I_GBB, I_GNW, I_WOUT, I_N3W, I_F2W1, I_F2W3, I_F2W2, I_FNW };

#ifndef P6SKIP
#define P6SKIP 0
#endif
#ifndef PROBE
#define PROBE 0
#endif
#ifndef PHSKIP
#define PHSKIP 0
#endif
template <int ph> __device__ __forceinline__ void run_phase(LAS unsigned char* lds, const int G, const int NGW, const bool probe_dst = false) {
    if (PHSKIP & (1 << ph)) return;
        int tid = threadIdx.x; asm volatile("" : "+v"(tid));
        int bid = blockIdx.x; asm volatile("" : "+s"(bid));
        const int lane = tid & 63, wave = __builtin_amdgcn_readfirstlane(tid >> 6), gw = bid * 8 + wave;
        const __attribute__((address_space(4))) char* kargs = (const __attribute__((address_space(4))) char*)__builtin_amdgcn_kernarg_segment_ptr(); asm volatile("" : "+s"(kargs));
        unsigned char* ws = *(unsigned char* const __attribute__((address_space(4)))*)(kargs + 8 * 27);
        float* out = *(float* const __attribute__((address_space(4)))*)(kargs + 8 * 26);
#define INP(i) (*(const float* const __attribute__((address_space(4)))*)(kargs + 8 * (i)))
        float* part = (float*)(ws + WS_PART); float* mods = (float*)(ws + WS_MODS); float* LR = (float*)(ws + WS_LR); float* X1C = (float*)(ws + WS_X1C); float* DG = (float*)(ws + WS_DG);
        bf16_t* W13 = (bf16_t*)(ws + WS_W13); bf16_t* W2 = (bf16_t*)(ws + WS_W2); bf16_t* WIN = (bf16_t*)(ws + WS_WIN); bf16_t* WOUT = (bf16_t*)(ws + WS_WOUT);
        bf16_t* H = (bf16_t*)(ws + WS_H); bf16_t* GP = (bf16_t*)(ws + WS_GP); bf16_t* SR = (bf16_t*)(ws + WS_SR); bf16_t* SG = (bf16_t*)(ws + WS_SG);
        if (ph == 0 && (PHM & 1)) {
            LAS float* scv = (LAS float*)lds;
            LAS f32x4* red = (LAS f32x4*)(lds + 1024);
            for (int it = bid; it < 288; it += G) {
                const int s = it / 18, cc = it % 18;
                if (tid < 192) { const int cond = tid >> 6, k = s * 64 + (tid & 63); const float v = cond < 2 ? INP(I_C)[cond * D + k] : INP(I_CCTX)[k]; scv[tid] = v / (1.0f + expf(-v)); }
                __syncthreads();
                const int cg4 = tid & 127, ks = tid >> 7;
                f32x4 acc[3] = {(f32x4){0.f, 0.f, 0.f, 0.f}, (f32x4){0.f, 0.f, 0.f, 0.f}, (f32x4){0.f, 0.f, 0.f, 0.f}};
                const float* wp = INP(I_ADAW) + (size_t)(s * 64 + ks * 16) * NMODS + cc * 512 + cg4 * 4;
#pragma unroll
                for (int kk = 0; kk < 16; ++kk) { const f32x4 w = __builtin_nontemporal_load((const f32x4*)(wp + (size_t)kk * NMODS));
#pragma unroll
                    for (int cnd = 0; cnd < 3; ++cnd) acc[cnd] += w * scv[cnd * 64 + ks * 16 + kk]; }
#pragma unroll
                for (int cnd = 0; cnd < 3; ++cnd) red[(ks * 3 + cnd) * 128 + cg4] = acc[cnd];
                __syncthreads();
                if (tid < 384) { const int cnd = tid >> 7, g4 = tid & 127;
                    const f32x4 r = (red[(0 * 3 + cnd) * 128 + g4] + red[(1 * 3 + cnd) * 128 + g4]) + (red[(2 * 3 + cnd) * 128 + g4] + red[(3 * 3 + cnd) * 128 + g4]);
                    *(f32x4*)(part + (size_t)(s * 3 + cnd) * NMODS + cc * 512 + g4 * 4) = r; }
                __syncthreads();
            }
            LAS float* scr = (LAS float*)(lds + wave * 16384);
            convert_ffn(INP(I_F1W1), INP(I_F1W3), INP(I_F1W2), W13, W2, scr, gw, NGW, lane);
            constexpr int IIN = (D / 64) * (NIN / 32), IOUT = (D / 64) * (D / 32);
            for (int it = gw; it < IIN + IOUT; it += NGW) {
                if (it < IIN) transpose_item<2>(INP(I_WIN), D, NIN, WIN, 0, scr, it, lane);
                else transpose_item<0>(INP(I_WOUT), D, D, WOUT, 0, scr, it - IIN, lane);
            }
            for (int v = bid * NTHREADS + tid; v < (NINP - NIN) * D / 8; v += G * NTHREADS) *((u32x4*)(WIN + (size_t)NIN * D) + v) = (u32x4){0u, 0u, 0u, 0u};
        } else if (ph == 1 && (PHM & 2)) {
            for (int g4 = bid * NTHREADS + tid; g4 < 3 * NMODS / 4; g4 += G * NTHREADS) { const int gid = 4 * g4, cond = gid / NMODS, rem = gid % NMODS; f32x4 v = *(const f32x4*)(INP(I_ADAB) + rem);
#pragma unroll
                for (int s = 0; s < 16; ++s) v += *(const f32x4*)(part + (size_t)(s * 3 + cond) * NMODS + rem);
                *(f32x4*)(mods + gid) = v; }
            norm_phase<true, false>(lds, INP(I_X), INP(I_CTX), MROWS, INP(I_N1W), part, INP(I_ADAB), mods, 0, 1, H, nullptr, gw, NGW, tid, lane);
        } else if (ph == 2 && (PHM & 4)) {
            unsigned* cnt = (unsigned*)(ws + WS_CNT);
            { pg8::Gemm g{H, W13, MROWS, 2 * FF, D, D / 64}; CtxFirstOrder S; S.init(G, bid, cnt, (LAS unsigned*)(lds + LDS_BYTES - 64 + 16));
              EpiSwiglu E{GP};
              pg8::gemm_phase<EpiSwiglu, CtxFirstOrder, true, true>(lds, g, S, E); }
            if (bid >= G - 24) {
                if (tid == 0) { while (__hip_atomic_load(cnt, __ATOMIC_RELAXED, __HIP_MEMORY_SCOPE_AGENT) < 44u * 8u) __builtin_amdgcn_s_sleep(4); }
                __builtin_amdgcn_fence(__ATOMIC_ACQUIRE, "agent");
                asm volatile("s_waitcnt vmcnt(0)" ::: "memory");
                __syncthreads();
                const int qd = bid - (G - 24), part3 = qd % 3, tile = qd / 3, k0 = part3 == 0 ? 0 : (part3 == 1 ? 16 * 64 : 30 * 64);
                pg8::Gemm g{GP + (size_t)NLAT * FF + k0, W2 + k0, NCTX, D, FF, part3 == 0 ? 16 : 14}; OneUnit S{tile >> 2, tile & 3};
                EpiCtxAtomic E{(float*)(ws + WS_SR) + (size_t)part3 * NCTX * D, mods};
                pg8::gemm_phase<EpiCtxAtomic, OneUnit, true, true>(lds, g, S, E);
            }
        } else if (ph == 11 && (PHM & 4)) {
            pg8::Gemm g{H, W13, NLAT, 2 * FF, D, D / 64}; pg8::StaticOrder S; S.init(NLAT, 2 * FF, G, bid);
            EpiSwiglu E{GP};
            pg8::gemm_phase<EpiSwiglu, pg8::StaticOrder, true, true>(lds, g, S, E);
        } else if (ph == 12 && (PHM & 8)) {
            pg8::Gemm g{GP, W2, NLAT, D, FF, FF / 64}; pg8::StaticOrder S; S.init(NLAT, D, G, bid);
            EpiResidNorm<0> E{};
            pg8::gemm_phase<EpiResidNorm<0>, pg8::StaticOrder, false, true>(lds, g, S, E);
        } else if (ph == 3 && (PHM & 8)) {
            norm_phase<false, false>(lds, out, INP(I_CTX), MROWS, INP(I_N2W), part, INP(I_ADAB), mods, 3, 4, H, nullptr, gw, NGW, tid, lane, NLAT, (const float*)(ws + WS_SR));
            __syncthreads();
            pg8::Gemm g{GP, W2, NLAT, D, FF, FF / 64}; pg8::StaticOrder S; S.init(NLAT, D, G, bid);
            EpiResidNorm<1> E{};
            pg8::gemm_phase<EpiResidNorm<1>, pg8::StaticOrder, false, true>(lds, g, S, E);
        } else if (ph == 9 && (PHM & 8)) {
            pg8::Gemm g{H, WOUT, NLAT, D, D, D / 64}; pg8::StaticOrder S; S.init(NLAT, D, G, bid);
            EpiResidNorm<2> E{};
            pg8::gemm_phase<EpiResidNorm<2>, pg8::StaticOrder, false, true>(lds, g, S, E);
        } else if (ph == 4 && (PHM & 16)) {
            norm_phase<false, false>(lds, out, X1C, MROWS, INP(I_N2W), part, INP(I_ADAB), mods, 3, 4, H, nullptr, gw, NGW, tid, lane);
        } else if (ph == 5 && (PHM & 32)) {
            pg8::Gemm g{H, WIN, MROWS, NINP, D, D / 64}; pg8::StaticOrder S; S.init(MROWS, NINP, G, bid);
            EpiWin E{GP, LR};
            pg8::gemm_phase<EpiWin, pg8::StaticOrder, true, true>(lds, g, S, E);
        } else if (ph == 6 && (PHM & 64)) {
            if (tid < 8) ((LAS float*)(lds + LDS_BYTES - 128))[tid] = -log1pf(expf(-(tid < 4 ? INP(I_RDF)[tid] : INP(I_RDB)[tid - 4])));
            __syncthreads();
            unsigned* qctr = (unsigned*)(ws + WS_CNT + 768);
            volatile LAS int* nx = (volatile LAS int*)(lds + LDS_BYTES - 64 + 32);
            int it = bid, k = 0;
            while (it < 1056) {
                if (tid == 0) nx[k & 1] = G + (int)__hip_atomic_fetch_add(qctr, 1u, __ATOMIC_RELAXED, __HIP_MEMORY_SCOPE_AGENT);
                if (it < 528) { if (!(P6SKIP & 2)) p6_gla_item(lds, GP, LR, SG, DG, INP(I_GWF), INP(I_GBF), INP(I_GWB), INP(I_GBB), it, tid, wave, lane); }
                else if (!(P6SKIP & 1)) p6_ret_item(lds, GP, SR, INP(I_RDF), INP(I_RDB), it - 528, tid, wave, lane);
                it = nx[k & 1]; ++k;
            }
        } else if (ph == 7 && (PHM & 128)) {
            p7_scan(SR, SG, DG, INP(I_RDF), INP(I_RDB), bid * NTHREADS + tid, G * NTHREADS);
            { LAS float* scr = (LAS float*)(lds + wave * 16384); convert_ffn(INP(I_F2W1), INP(I_F2W3), INP(I_F2W2), W13, W2, scr, gw, NGW, lane); }
        } else if (ph == 8 && (PHM & 256)) {
            if (tid < 8) ((LAS float*)(lds + LDS_BYTES - 128))[tid] = -log1pf(expf(-(tid < 4 ? INP(I_RDF)[tid] : INP(I_RDB)[tid - 4])));
            __syncthreads();
            for (int idx = tid; idx < 1024; idx += NTHREADS) { const int hh = idx >> 8; const float dd = (float)((idx & 255) - 127);
                const float lf = ((const LAS float*)(lds + LDS_BYTES - 128))[hh], lb = ((const LAS float*)(lds + LDS_BYTES - 128))[4 + hh];
                ((LAS float*)(lds + DTAB_OFF))[idx] = __expf(fmaxf(dd, 0.f) * lf + fmaxf(-dd, 0.f) * lb) * (2.0f - fminf(fabsf(dd), 1.0f)); }
            __syncthreads();
            for (int it = bid; it < 1024; it += G) for (int rep = 0; rep < (PROBE == 14 ? 2 : 1); ++rep) {
                if (it < 512) p8_ret_item(lds, GP, SR, H, INP(I_RDF), INP(I_RDB), INP(I_RNW), it, tid, wave, lane);
                else p8_gla_item(lds, GP, LR, SG, H, INP(I_GWF), INP(I_GBF), INP(I_GWB), INP(I_GBB), INP(I_GNW), it - 512, tid, wave, lane);
            }
        } else if (ph == 10 && (PHM & 512)) {
            norm_phase<false, false>(lds, out, X1C, NLAT, INP(I_N3W), part, INP(I_ADAB), mods, 6, 7, H, nullptr, gw, NGW, tid, lane);
        } else if (ph == 13 && (PHM & 1024)) {
            norm_phase<false, true>(lds, out, X1C, NLAT, INP(I_FNW), part, INP(I_ADAB), mods, 0, 0, nullptr, probe_dst ? (float*)(ws + WS_SR) : out, gw, NGW, tid, lane);
        }
}

__global__ void __launch_bounds__(NTHREADS, 2) mk_fwd(Args a) {
    extern __shared__ __attribute__((aligned(16))) unsigned char lds_raw[];
    LAS unsigned char* lds = (LAS unsigned char*)lds_raw;
    cg::grid_group grid = cg::this_grid();
    const int G = gridDim.x, NGW = G * 8;
#ifndef PROBE
#define PROBE 0
#endif
#ifndef PROBE
#define PROBE 0
#endif
    if (gridDim.y == 4242u) grid.sync();
    unsigned* barw = (unsigned*)(a.ws + WS_BAR);
    volatile LAS unsigned* bst = (volatile LAS unsigned*)(lds + LDS_BYTES - 64);
    if (threadIdx.x < 8) bst[threadIdx.x] = 0u;
    __syncthreads();
    XcdBarrier bar = xcd_barrier_post(barw, bst);
#define SEAM() xcd_barrier_ool(bar.bar, bar.x, bar.st)
    run_phase<0>(lds, G, NGW); SEAM();
    run_phase<1>(lds, G, NGW); SEAM();
    run_phase<2>(lds, G, NGW); SEAM();
    run_phase<3>(lds, G, NGW); SEAM();
    run_phase<5>(lds, G, NGW); SEAM();
    run_phase<6>(lds, G, NGW); SEAM();
    run_phase<7>(lds, G, NGW); SEAM();
    run_phase<8>(lds, G, NGW); SEAM();
    run_phase<9>(lds, G, NGW); SEAM();
    run_phase<11>(lds, G, NGW); SEAM();
    run_phase<12>(lds, G, NGW);
}

extern "C" void kernel_launch(void* const* d_in, const int* in_sizes, int n_in, void* d_out, int out_size, void* d_ws, size_t ws_size, hipStream_t stream) {
    static int grid = 0;
    if (grid == 0) {
        if (n_in != 26 || ws_size < WS_END) { fprintf(stderr, "kernel_launch: unexpected n_in %d or ws_size %zu (< %zu)\n", n_in, ws_size, (size_t)WS_END); grid = -1; return; }
        int dev = 0, cus = 0, per_cu = 0;
        hipGetDevice(&dev);
        hipDeviceGetAttribute(&cus, hipDeviceAttributeMultiprocessorCount, dev);
        hipFuncSetAttribute((const void*)mk_fwd, hipFuncAttributeMaxDynamicSharedMemorySize, LDS_BYTES);
        hipOccupancyMaxActiveBlocksPerMultiprocessor(&per_cu, (const void*)mk_fwd, NTHREADS, LDS_BYTES);
        if (per_cu < 1) { fprintf(stderr, "kernel_launch: occupancy query reports %d blocks per CU\n", per_cu); per_cu = 1; }
        grid = cus;
        (void)hipGetLastError();
    }
    if (grid < 0) return;
    if (hipMemsetAsync((char*)d_ws + WS_BAR, 0, 128 * 1024, stream) != hipSuccess) { fprintf(stderr, "kernel_launch: memset of the barrier words failed\n"); return; }
    Args a{};
    for (int i = 0; i < 26; ++i) a.in[i] = (const float*)d_in[i];
    a.out = (float*)d_out; a.ws = (unsigned char*)d_ws;
    void* args[] = {&a};
    hipError_t e = hipLaunchCooperativeKernel((const void*)mk_fwd, dim3(grid), dim3(NTHREADS), args, LDS_BYTES, stream);
    if (e != hipSuccess) fprintf(stderr, "cooperative launch failed: %s (grid %d)\n", hipGetErrorString(e), grid);
}
```

```cpp
#include <hip/hip_runtime.h>
#include <hip/hip_cooperative_groups.h>
#include <cstdio>
#include <cstdint>
namespace cg = cooperative_groups;
namespace pg8 {
#define PG8_LAS __attribute__((address_space(3)))
typedef unsigned short bf16_t;
typedef short bf16x8 __attribute__((ext_vector_type(8)));
typedef float f32x4 __attribute__((ext_vector_type(4)));
typedef unsigned u32x4 __attribute__((ext_vector_type(4)));
constexpr int BM = 256, BK = 64, HALF = 128, HTB = HALF * BK * 2  , STAGE_BYTES = 8 * HTB, NXCD = 8, WGM = 8;

__host__ __device__ __forceinline__ int lds_byte(int r, int c) { const int st = (r >> 4) * 2 + (c >> 5), rr = r & 15, cc = c & 31, ob = rr * 64 + cc * 2; return st * 1024 + (ob ^ (((ob >> 9) & 1) << 5)); }
__host__ __device__ __forceinline__ void stage_rc(int b, int& R, int& C) { const int st = b / 1024, sb = b % 1024, swz = sb ^ (((sb >> 9) & 1) << 5); R = (st >> 1) * 16 + swz / 64; C = (st & 1) * 32 + (swz % 64) / 2; }
__host__ __device__ __forceinline__ int perm32(int rho) { const int n = rho >> 4, i = rho & 15; return 8 * (i >> 2) + 4 * n + (i & 3); }

struct Unit { int pm, pn; };
struct Gemm { const bf16_t* A; const bf16_t* Bt; int M, N, K, KT; };

struct StaticOrder {
    int nM, nN, nwg, G, c;
    __host__ __device__ void init(int M, int N, int G_, int c_) { nM = M / BM; nN = N / BM; nwg = nM * nN; G = G_; c = c_; }
    __host__ __device__ bool next(int i, Unit& u) const {
        const long L = (long)i * G + c; if (L >= nwg) return false;
        int wgid = (int)L; { const int q = nwg / NXCD, r = nwg % NXCD, xcd = wgid % NXCD, off = wgid / NXCD; wgid = (xcd < r ? xcd * (q + 1) : r * (q + 1) + (xcd - r) * q) + off; }
        const int nig = WGM * nN, gid = wgid / nig, fm = gid * WGM, gsz = (nM - fm) < WGM ? (nM - fm) : WGM;
        u.pm = fm + ((wgid % nig) % gsz); u.pn = (wgid % nig) / gsz; return true;
    }
    __device__ __forceinline__ void a_ready(const Unit&) const {}
    __device__ __forceinline__ void done(const Unit&) const {}
};

__device__ __forceinline__ unsigned cvt_pk_bf16(float lo, float hi) { unsigned r; asm volatile("v_cvt_pk_bf16_f32 %0, %1, %2" : "=v"(r) : "v"(lo), "v"(hi)); return r; }
template <class Epi, class Sched, bool ALIGN_EPI = false, bool SP2 = false>
__device__ __forceinline__ void gemm_phase(PG8_LAS unsigned char* lds, const Gemm g, const Sched& S, const Epi& E) {
    const int tid = threadIdx.x, wid = __builtin_amdgcn_readfirstlane(tid >> 6), lane = tid & 63, wr = wid >> 2, wc = wid & 3, fr = lane & 15, fq = lane >> 4;
    const int K = g.K, nt = g.KT;
    unsigned voffA[2], voffB[2];
#pragma unroll
    for (int i = 0; i < 2; ++i) { int R, C; stage_rc(tid * 16 + i * 8192, R, C); const int Rb = Epi::PERM ? ((R & ~31) + perm32(R & 31)) : R;
        voffA[i] = (unsigned)(R * K + C) * 2u; voffB[i] = (unsigned)(Rb * K + C) * 2u; }
    const size_t kstep = (size_t)(BK * 2);
    const size_t hstep = (size_t)HALF * K * 2;
    const size_t tstep = 2 * hstep;
    const unsigned ldsw = (unsigned)wid * 1024u;
    const int aoff = lds_byte(wr * 64 + fr, fq * 8), boff = lds_byte(wc * 32 + fr, fq * 8);
#define PG8_SA(b, h) (((b) * 2 + (h)) * HTB)
#define PG8_SB(b, h) ((4 + (b) * 2 + (h)) * HTB)
#define PG8_STAGE(bufoff, gbase, voff) do { _Pragma("unroll") for (int _i = 0; _i < 2; ++_i) \
        __builtin_amdgcn_global_load_lds((const unsigned*)((const char*)(gbase) + (voff)[_i]), (PG8_LAS unsigned*)(lds + (bufoff) + ldsw + _i * 8192), 16, 0, 0); } while (0)
#define PG8_LDA(dst, b, h) do { _Pragma("unroll") for (int m = 0; m < 4; ++m) _Pragma("unroll") for (int k = 0; k < 2; ++k) dst[m][k] = *(const PG8_LAS bf16x8*)(lds + PG8_SA(b, h) + aoff + m * 2048 + k * 1024); } while (0)
#define PG8_LDB(dst, b, h) do { _Pragma("unroll") for (int n = 0; n < 2; ++n) _Pragma("unroll") for (int k = 0; k < 2; ++k) dst[n][k] = *(const PG8_LAS bf16x8*)(lds + PG8_SB(b, h) + boff + n * 2048 + k * 1024); } while (0)
#define PG8_MMA(ai, bj, At, Bt) do { __builtin_amdgcn_s_setprio(1); _Pragma("unroll") for (int m = 0; m < 4; ++m) _Pragma("unroll") for (int n = 0; n < 2; ++n) _Pragma("unroll") for (int k = 0; k < 2; ++k) \
        acc[ai][bj][m][n] = __builtin_amdgcn_mfma_f32_16x16x32_bf16(Bt[n][k], At[m][k], acc[ai][bj][m][n], 0, 0, 0); __builtin_amdgcn_s_setprio(0); } while (0)
#define PG8_WAIT_V(n) asm volatile("s_waitcnt vmcnt(" #n ")" ::: "memory")
#define PG8_WAIT_L(n) asm volatile("s_waitcnt lgkmcnt(" #n ")" ::: "memory")
#define PG8_BAR __builtin_amdgcn_s_barrier()
#define PG8_SCHED __builtin_amdgcn_sched_barrier(0)
    Unit cur, nxt; int ui = 0;
    if (!S.next(0, cur)) return;
    f32x4 acc[2][2][4][2];
#pragma unroll
    for (int a = 0; a < 2; ++a)
#pragma unroll
        for (int b = 0; b < 2; ++b)
#pragma unroll
            for (int m = 0; m < 4; ++m)
#pragma unroll
                for (int n = 0; n < 2; ++n) acc[a][b][m][n] = (f32x4){0.f, 0.f, 0.f, 0.f};
    bf16x8 At[4][2], B0[2][2], B1[2][2];
    const char* cA = (const char*)g.A + (size_t)cur.pm * tstep; const char* cB = (const char*)g.Bt + (size_t)cur.pn * tstep;
    S.a_ready(cur);
    if constexpr (SP2) {
        PG8_STAGE(PG8_SB(0, 0), cB, voffB); PG8_STAGE(PG8_SB(0, 1), cB + hstep, voffB); PG8_STAGE(PG8_SA(0, 0), cA, voffA); PG8_STAGE(PG8_SA(0, 1), cA + hstep, voffA);
        if (wr == 1) PG8_BAR;
        PG8_WAIT_V(2); PG8_BAR;
        PG8_STAGE(PG8_SB(1, 0), cB + kstep, voffB); PG8_STAGE(PG8_SA(1, 0), cA + kstep, voffA); PG8_STAGE(PG8_SB(1, 1), cB + hstep + kstep, voffB);
        PG8_WAIT_V(6); PG8_BAR;
    } else {
        PG8_STAGE(PG8_SB(0, 0), cB, voffB); PG8_STAGE(PG8_SA(0, 0), cA, voffA); PG8_STAGE(PG8_SB(0, 1), cB + hstep, voffB); PG8_STAGE(PG8_SA(0, 1), cA + hstep, voffA);
        if (wr == 1) PG8_BAR;
        PG8_WAIT_V(4); PG8_BAR;
        PG8_STAGE(PG8_SB(1, 0), cB + kstep, voffB); PG8_STAGE(PG8_SA(1, 0), cA + kstep, voffA); PG8_STAGE(PG8_SB(1, 1), cB + hstep + kstep, voffB);
        PG8_WAIT_V(6); PG8_BAR;
    }
    for (;;) {
        const bool has_next = S.next(ui + 1, nxt);
        const char* nA = has_next ? (const char*)g.A + (size_t)nxt.pm * tstep : cA; const char* nB = has_next ? (const char*)g.Bt + (size_t)nxt.pn * tstep : cB;
        for (int t = 0; t < nt; t += 2) {
            const bool last = (t == nt - 2);
            const char* a1 = cA + (size_t)(t + 1) * kstep;
            const char* a2 = last ? nA : cA + (size_t)(t + 2) * kstep; const char* b2 = last ? nB : cB + (size_t)(t + 2) * kstep;
            const char* a3 = a2 + kstep; const char* b3 = b2 + kstep;
            if (last && has_next) S.a_ready(nxt);
            if constexpr (SP2) {
            PG8_LDB(B0, 0, 0); PG8_LDB(B1, 0, 1); PG8_SCHED; PG8_LDA(At, 0, 0); PG8_STAGE(PG8_SA(1, 1), a1 + hstep, voffA);
            PG8_WAIT_V(8); PG8_WAIT_L(0); PG8_BAR; PG8_MMA(0, 0, At, B0); PG8_MMA(0, 1, At, B1); PG8_BAR; PG8_SCHED;
            PG8_LDA(At, 0, 1); PG8_STAGE(PG8_SB(0, 0), b2, voffB); PG8_STAGE(PG8_SB(0, 1), b2 + hstep, voffB); PG8_STAGE(PG8_SA(0, 0), a2, voffA);
            PG8_WAIT_V(8); PG8_WAIT_L(0); PG8_BAR; PG8_MMA(1, 0, At, B0); PG8_MMA(1, 1, At, B1); PG8_BAR; PG8_SCHED;
            PG8_LDB(B0, 1, 0); PG8_LDB(B1, 1, 1); PG8_SCHED; PG8_LDA(At, 1, 0); PG8_STAGE(PG8_SA(0, 1), a2 + hstep, voffA);
            PG8_WAIT_V(8); PG8_WAIT_L(0); PG8_BAR; PG8_MMA(0, 0, At, B0); PG8_MMA(0, 1, At, B1); PG8_BAR; PG8_SCHED;
            PG8_LDA(At, 1, 1); PG8_STAGE(PG8_SB(1, 0), b3, voffB); PG8_STAGE(PG8_SB(1, 1), b3 + hstep, voffB); PG8_STAGE(PG8_SA(1, 0), a3, voffA);
            PG8_WAIT_V(8); PG8_WAIT_L(0); PG8_BAR; PG8_MMA(1, 0, At, B0); PG8_MMA(1, 1, At, B1); PG8_BAR; PG8_SCHED;
            } else {
            PG8_LDB(B0, 0, 0); PG8_SCHED; PG8_LDA(At, 0, 0); PG8_STAGE(PG8_SA(1, 1), a1 + hstep, voffA);
            PG8_WAIT_L(8); PG8_BAR; PG8_WAIT_L(0); PG8_MMA(0, 0, At, B0); PG8_BAR; PG8_SCHED;
            PG8_LDB(B1, 0, 1); PG8_STAGE(PG8_SB(0, 0), b2, voffB);
            PG8_BAR; PG8_WAIT_L(0); PG8_MMA(0, 1, At, B1); PG8_BAR;
            PG8_LDA(At, 0, 1); PG8_STAGE(PG8_SA(0, 0), a2, voffA);
            PG8_BAR; PG8_WAIT_L(0); PG8_MMA(1, 0, At, B0); PG8_BAR; PG8_SCHED;
            PG8_STAGE(PG8_SB(0, 1), b2 + hstep, voffB);
            PG8_WAIT_V(6); PG8_BAR; PG8_MMA(1, 1, At, B1); PG8_BAR;
            PG8_LDB(B0, 1, 0); PG8_SCHED; PG8_LDA(At, 1, 0); PG8_STAGE(PG8_SA(0, 1), a2 + hstep, voffA);
            PG8_WAIT_L(8); PG8_BAR; PG8_WAIT_L(0); PG8_MMA(0, 0, At, B0); PG8_BAR; PG8_SCHED;
            PG8_LDB(B1, 1, 1); PG8_STAGE(PG8_SB(1, 0), b3, voffB);
            PG8_BAR; PG8_WAIT_L(0); PG8_MMA(0, 1, At, B1); PG8_BAR;
            PG8_LDA(At, 1, 1); PG8_STAGE(PG8_SA(1, 0), a3, voffA);
            PG8_BAR; PG8_WAIT_L(0); PG8_MMA(1, 0, At, B0); PG8_BAR; PG8_SCHED;
            PG8_STAGE(PG8_SB(1, 1), b3 + hstep, voffB);
            PG8_WAIT_V(6); PG8_BAR; PG8_MMA(1, 1, At, B1); PG8_BAR;
            }
        }
        if constexpr (ALIGN_EPI) { if (wr == 0) PG8_BAR; }
        if constexpr (!Epi::AFTER_DRAIN) { E(acc, cur, wr, wc, fr, fq); S.done(cur); }
        if (!has_next) break;
#pragma unroll
        for (int a = 0; a < 2; ++a)
#pragma unroll
            for (int b = 0; b < 2; ++b)
#pragma unroll
                for (int m = 0; m < 4; ++m)
#pragma unroll
                    for (int n = 0; n < 2; ++n) acc[a][b][m][n] = (f32x4){0.f, 0.f, 0.f, 0.f};
        cur = nxt; cA = nA; cB = nB; ++ui;
        if constexpr (ALIGN_EPI) { if (wr == 1) PG8_BAR; }
    }
    PG8_WAIT_V(0);
    if constexpr (!ALIGN_EPI) { if (wr == 0) PG8_BAR; }
    PG8_BAR;
    if constexpr (Epi::AFTER_DRAIN) { E.fused(acc, cur, wr, wc, fr, fq, lds, wid, lane); S.done(cur); }
#undef PG8_SA
#undef PG8_SB
#undef PG8_STAGE
#undef PG8_LDA
#undef PG8_LDB
#undef PG8_MMA
#undef PG8_WAIT_V
#undef PG8_WAIT_L
#undef PG8_BAR
#undef PG8_SCHED
}
}

#define LAS __attribute__((address_space(3)))
#ifndef PROBE
#define PROBE 0
#endif
typedef unsigned short bf16_t;
typedef short bf16x8 __attribute__((ext_vector_type(8)));
typedef float f32x4 __attribute__((ext_vector_type(4)));
typedef unsigned u32x4 __attribute__((ext_vector_type(4)));
typedef unsigned u32x2 __attribute__((ext_vector_type(2)));

constexpr int D = 1024, FF = 2816, NLAT = 16384, NCTX = 512, MROWS = NLAT + NCTX, NIN = 3616, NINP = 3840, PP = 3584  ;
constexpr int NMODS = 9 * D;
constexpr float EPS = 1e-6f;
constexpr int NTHREADS = 512;
constexpr int LDS_BYTES = 144 * 1024;

constexpr size_t MiB = 1u << 20;
constexpr size_t WS_PART = 0;
constexpr size_t WS_BAR  = WS_PART + 1792 * 1024;
constexpr size_t WS_CNT  = WS_BAR + 64 * 1024;
constexpr size_t WS_MODS = WS_PART + 2 * MiB;
constexpr size_t WS_LR   = WS_MODS + 128 * 1024;
constexpr size_t WS_X1C  = WS_LR + (size_t)MROWS * 32 * 4 + 0;
constexpr size_t WS_DG   = WS_X1C + 2 * MiB;
constexpr size_t WS_W13  = WS_DG + 1 * MiB;
constexpr size_t WS_W2   = WS_W13 + (size_t)2 * FF * D * 2;
constexpr size_t WS_WIN  = WS_W2 + (size_t)FF * D * 2;
constexpr size_t WS_WOUT = WS_WIN + (size_t)NINP * D * 2;
constexpr size_t WS_H    = WS_WOUT + (size_t)D * D * 2;
constexpr size_t WS_GP   = WS_H + (size_t)MROWS * D * 2;
constexpr size_t WS_SR   = WS_GP + (size_t)MROWS * PP * 2;
constexpr size_t WS_SG   = WS_SR + (size_t)16 * 66 * 16384 * 2;
constexpr size_t WS_END  = WS_SG + (size_t)16 * 132 * 8192 * 2;
static_assert(WS_END <= 256 * MiB, "workspace over 256 MiB");
static_assert(WS_LR % 256 == 0 && WS_X1C % 256 == 0 && WS_W13 % 256 == 0 && WS_H % 256 == 0 && WS_GP % 256 == 0 && WS_SR % 256 == 0 && WS_SG % 256 == 0, "align");

__device__ __forceinline__ unsigned f2bf(float f) { unsigned u = __builtin_bit_cast(unsigned, f); return (u + 0x7fffu + ((u >> 16) & 1u)) >> 16; }
__device__ __forceinline__ unsigned pk2(float lo, float hi) { return f2bf(lo) | (f2bf(hi) << 16); }
__device__ __forceinline__ unsigned cvtpk(float lo, float hi) { unsigned r; asm("v_cvt_pk_bf16_f32 %0, %1, %2" : "=v"(r) : "v"(lo), "v"(hi)); return r; }
__device__ __forceinline__ float bflo(unsigned u) { return __builtin_bit_cast(float, u << 16); }
__device__ __forceinline__ float bfhi(unsigned u) { return __builtin_bit_cast(float, u & 0xffff0000u); }
__device__ __forceinline__ float bf2f(bf16_t h) { return __builtin_bit_cast(float, (unsigned)h << 16); }
__device__ __forceinline__ float silu_f(float v) { return v * __builtin_amdgcn_rcpf(1.0f + __expf(-v)); }
__device__ __forceinline__ float wave_sum(float v) {
#pragma unroll
    for (int o = 1; o < 64; o <<= 1) v += __shfl_xor(v, o);
    return v;
}
#define LDS_WAIT() asm volatile("s_waitcnt lgkmcnt(0)" ::: "memory")

typedef float f32x2 __attribute__((ext_vector_type(2)));
__device__ __forceinline__ f32x2 swiglu2(f32x2 g, f32x2 u) {
    const f32x2 t = g * (-1.4426950408889634f);
    f32x2 e; e.x = __builtin_amdgcn_exp2f(t.x); e.y = __builtin_amdgcn_exp2f(t.y);
    const f32x2 dn = e + 1.0f;
    f32x2 r; r.x = __builtin_amdgcn_rcpf(dn.x); r.y = __builtin_amdgcn_rcpf(dn.y);
    return (g * u) * r;
}
struct EpiSwiglu {
    static constexpr bool PERM = true, AFTER_DRAIN = false;
    bf16_t* G;
    __device__ __forceinline__ void operator()(const f32x4 (&acc)[2][2][4][2], const pg8::Unit& u, int wr, int wc, int fr, int fq) const {
        const int row0 = u.pm * 256 + wr * 64 + fr, col0 = u.pn * 128 + wc * 32 + 8 * fq;
#pragma unroll
        for (int ai = 0; ai < 2; ++ai)
#pragma unroll
            for (int m = 0; m < 4; ++m) {
                bf16_t* p = G + (size_t)(row0 + ai * 128 + m * 16) * FF + col0;
                const f32x4 g0 = acc[ai][0][m][0], g1 = acc[ai][0][m][1], u0 = acc[ai][1][m][0], u1 = acc[ai][1][m][1];
                const f32x2 a = swiglu2((f32x2){g0[0], g0[1]}, (f32x2){u0[0], u0[1]}), b = swiglu2((f32x2){g0[2], g0[3]}, (f32x2){u0[2], u0[3]});
                const f32x2 c = swiglu2((f32x2){g1[0], g1[1]}, (f32x2){u1[0], u1[1]}), d = swiglu2((f32x2){g1[2], g1[3]}, (f32x2){u1[2], u1[3]});
                u32x4 w;
                w.x = pg8::cvt_pk_bf16(a.x, a.y); w.y = pg8::cvt_pk_bf16(b.x, b.y); w.z = pg8::cvt_pk_bf16(c.x, c.y); w.w = pg8::cvt_pk_bf16(d.x, d.y);
                *(u32x4*)p = w;
            }
    }
};
struct EpiResid {
    static constexpr bool PERM = false, AFTER_DRAIN = false;
    const float* src_lat; const float* src_ctx; float* dst_lat; float* dst_ctx; const float* mods; int midx; float scale;
    __device__ __forceinline__ void operator()(const f32x4 (&acc)[2][2][4][2], const pg8::Unit& u, int wr, int wc, int fr, int fq) const {
        const int cond = u.pm < 32 ? 0 : (u.pm < 64 ? 1 : 2);
        const int col0 = u.pn * 256 + wc * 32 + 4 * fq;
        const float* mrow = mods + cond * NMODS + midx * D + col0;
        f32x4 mv[2][2];
#pragma unroll
        for (int bj = 0; bj < 2; ++bj)
#pragma unroll
            for (int n = 0; n < 2; ++n) mv[bj][n] = *(const f32x4*)(mrow + bj * 128 + n * 16) * scale;
        const bool lat = u.pm < 64;
        const int rbase = (lat ? u.pm * 256 : (u.pm - 64) * 256) + wr * 64 + fr;
        const float* sb = lat ? src_lat : src_ctx; float* db = lat ? dst_lat : dst_ctx;
#pragma unroll
        for (int ai = 0; ai < 2; ++ai)
#pragma unroll
            for (int m = 0; m < 4; ++m) {
                const size_t ro = (size_t)(rbase + ai * 128 + m * 16) * D + col0;
#pragma unroll
                for (int bj = 0; bj < 2; ++bj)
#pragma unroll
                    for (int n = 0; n < 2; ++n) {
                        const f32x4 s = *(const f32x4*)(sb + ro + bj * 128 + n * 16);
                        *(f32x4*)(db + ro + bj * 128 + n * 16) = s + mv[bj][n] * acc[ai][bj][m][n];
                    }
                asm volatile("" ::: "memory");
            }
    }
};
struct EpiWin {
    static constexpr bool PERM = true, AFTER_DRAIN = false;
    bf16_t* P; float* LR;
    __device__ __forceinline__ void operator()(const f32x4 (&acc)[2][2][4][2], const pg8::Unit& u, int wr, int wc, int fr, int fq) const {
        const int pn = u.pn; const int rowb = u.pm * 256 + wr * 64 + fr;
        if (pn == 14) {
            if (wc == 0) {
#pragma unroll
                for (int ai = 0; ai < 2; ++ai)
#pragma unroll
                    for (int m = 0; m < 4; ++m) { float* p = LR + (size_t)(rowb + ai * 128 + m * 16) * 32 + 8 * fq; *(f32x4*)p = acc[ai][0][m][0]; *(f32x4*)(p + 4) = acc[ai][0][m][1]; }
            }
            return;
        }
        const bool rope = (pn < 4) && (u.pm < 64);
        const bool dosilu = (pn == 6) || (pn == 7) || (pn == 12) || (pn == 13);
        const float sc = pn < 2 ? 0.08838834764831845f : (pn == 8 ? 0.125f : 1.0f);
        const int col0 = pn * 256 + wc * 32 + 8 * fq;
        float frq[4];
#pragma unroll
        for (int j = 0; j < 4; ++j) frq[j] = exp2f(-(float)(16 * (wc & 1) + 4 * fq + j) * (13.287712379549449f / 32.0f));
#pragma unroll
        for (int ai = 0; ai < 2; ++ai)
#pragma unroll
            for (int m = 0; m < 4; ++m) {
                const int row = rowb + ai * 128 + m * 16;
                const int tok = row & 8191;
                const float pos = (float)((wc < 2) ? (tok >> 6) : (tok & 63));
#pragma unroll
                for (int bj = 0; bj < 2; ++bj) {
                    f32x4 v0 = acc[ai][bj][m][0] * sc, v1 = acc[ai][bj][m][1] * sc;
                    if (rope) {
#pragma unroll
                        for (int j = 0; j < 4; ++j) { const float ang = pos * frq[j]; const float sn = __sinf(ang), cs = __cosf(ang); const float a = v0[j], b = v1[j]; v0[j] = a * cs - b * sn; v1[j] = a * sn + b * cs; }
                    }
                    if (dosilu) {
#pragma unroll
                        for (int j = 0; j < 4; ++j) { v0[j] = silu_f(v0[j]); v1[j] = silu_f(v1[j]); }
                    }
                    u32x4 w; w.x = pg8::cvt_pk_bf16(v0[0], v0[1]); w.y = pg8::cvt_pk_bf16(v0[2], v0[3]); w.z = pg8::cvt_pk_bf16(v1[0], v1[1]); w.w = pg8::cvt_pk_bf16(v1[2], v1[3]);
                    *(u32x4*)(P + (size_t)row * PP + col0 + bj * 128) = w;
                }
            }
    }
};

struct CtxFirstOrder {
    int nN, nwg, G, c; unsigned* cnt; LAS unsigned* lcnt;
    __device__ void init(int G_, int c_, unsigned* cnt_, LAS unsigned* lcnt_) { nN = 22; nwg = 64 * 22; G = G_; c = c_; cnt = cnt_; lcnt = lcnt_; }
    __device__ bool next(int i, pg8::Unit& u) const {
        long L = (long)i * G + c;
        if (L < 44) { u.pm = 64 + (L >= 22 ? 1 : 0); u.pn = (int)(L % 22); return true; }
        L -= 44; if (L >= nwg) return false;
        int wgid = (int)L; { const int q = nwg / pg8::NXCD, r = nwg % pg8::NXCD, xcd = wgid % pg8::NXCD, off = wgid / pg8::NXCD; wgid = (xcd < r ? xcd * (q + 1) : r * (q + 1) + (xcd - r) * q) + off; }
        const int nig = pg8::WGM * nN, gid = wgid / nig, fm = gid * pg8::WGM, gsz = (64 - fm) < pg8::WGM ? (64 - fm) : pg8::WGM;
        u.pm = fm + ((wgid % nig) % gsz); u.pn = (wgid % nig) / gsz; return true;
    }
    __device__ __forceinline__ void a_ready(const pg8::Unit&) const {}
    __device__ __forceinline__ void done(const pg8::Unit& u) const {
        if (u.pm >= 64) {
            asm volatile("s_waitcnt vmcnt(0)" ::: "memory");
            unsigned old = 0u;
            if ((threadIdx.x & 63) == 0) old = __hip_atomic_fetch_add((LAS unsigned*)lcnt, 1u, __ATOMIC_RELAXED, __HIP_MEMORY_SCOPE_WORKGROUP);
            old = (unsigned)__builtin_amdgcn_readfirstlane((int)old);
            if ((old & 7u) == 7u) { __builtin_amdgcn_fence(__ATOMIC_RELEASE, "agent"); asm volatile("s_waitcnt vmcnt(0)" ::: "memory");
                if ((threadIdx.x & 63) == 0) __hip_atomic_fetch_add(cnt, 8u, __ATOMIC_RELAXED, __HIP_MEMORY_SCOPE_AGENT); }
        }
    }
};
struct OneUnit { int pm, pn;
    __device__ bool next(int i, pg8::Unit& u) const { if (i != 0) return false; u.pm = pm; u.pn = pn; return true; }
    __device__ __forceinline__ void a_ready(const pg8::Unit&) const {}
    __device__ __forceinline__ void done(const pg8::Unit&) const {}
};
struct EpiCtxAtomic {
    static constexpr bool PERM = false, AFTER_DRAIN = false;
    float* slab; const float* mods;
    __device__ __forceinline__ void operator()(const f32x4 (&acc)[2][2][4][2], const pg8::Unit& u, int wr, int wc, int fr, int fq) const {
        const int col0 = u.pn * 256 + wc * 32 + 4 * fq;
        const float* mrow = mods + 2 * NMODS + 2 * D + col0;
        f32x4 mv[2][2];
#pragma unroll
        for (int bj = 0; bj < 2; ++bj)
#pragma unroll
            for (int n = 0; n < 2; ++n) mv[bj][n] = *(const f32x4*)(mrow + bj * 128 + n * 16) * 0.5f;
#pragma unroll
        for (int ai = 0; ai < 2; ++ai)
#pragma unroll
            for (int m = 0; m < 4; ++m) {
                float* rp = slab + (size_t)(u.pm * 256 + ai * 128 + wr * 64 + m * 16 + fr) * D + col0;
#pragma unroll
                for (int bj = 0; bj < 2; ++bj)
#pragma unroll
                    for (int n = 0; n < 2; ++n) *(f32x4*)(rp + bj * 128 + n * 16) = mv[bj][n] * acc[ai][bj][m][n];
            }
    }
};

template <int MODE> struct EpiResidNorm {
    static constexpr bool PERM = false, AFTER_DRAIN = true;
    static constexpr int RMIDX = MODE == 0 ? 8 : (MODE == 1 ? 2 : 5), SH = MODE == 1 ? 3 : 6, SC = MODE == 1 ? 4 : 7, NWI = MODE == 0 ? 25 : (MODE == 1 ? 10 : 21);
    static constexpr float scale = MODE == 2 ? 1.0f : 0.5f;
    __device__ __forceinline__ void operator()(const f32x4 (&)[2][2][4][2], const pg8::Unit&, int, int, int, int) const {}
    __device__ __forceinline__ void fused(f32x4 (&acc)[2][2][4][2], const pg8::Unit& u, int wr, int wc, int fr, int fq, PG8_LAS unsigned char* lds, int wid, int lane) const {
        const __attribute__((address_space(4))) char* ka = (const __attribute__((address_space(4))) char*)__builtin_amdgcn_kernarg_segment_ptr();
        float* dst = *(float* const __attribute__((address_space(4)))*)(ka + 8 * 26);
        const float* src = *(const float* const __attribute__((address_space(4)))*)(ka + 8 * 0);
        unsigned char* wsb = *(unsigned char* const __attribute__((address_space(4)))*)(ka + 8 * 27);
        const bf16_t* srcb = MODE == 2 ? (const bf16_t*)dst : (const bf16_t*)(wsb + WS_SR);
        bf16_t* dstb = MODE == 1 ? (bf16_t*)dst : (bf16_t*)(wsb + WS_SR);
        const float* nw = *(const float* const __attribute__((address_space(4)))*)(ka + 8 * NWI);
        const float* mods = (const float*)(wsb + WS_MODS); float* xbuf = (float*)(wsb + WS_PART) + MODE * 65536; unsigned* pcnt = (unsigned*)(wsb + WS_CNT + 1024) + MODE * 4096;
        const int cond = u.pm < 32 ? 0 : 1;
        const int col0 = u.pn * 256 + wc * 32 + 4 * fq;
        const float* mrow = mods + cond * NMODS + RMIDX * D + col0;
        PG8_LAS float* P = (PG8_LAS float*)lds;
        PG8_LAS float* S = (PG8_LAS float*)(lds + 8192);
        {
            f32x4 mv[2][2];
#pragma unroll
            for (int bj = 0; bj < 2; ++bj)
#pragma unroll
                for (int n = 0; n < 2; ++n) mv[bj][n] = *(const f32x4*)(mrow + bj * 128 + n * 16) * scale;
#pragma unroll
            for (int ai = 0; ai < 2; ++ai)
#pragma unroll
                for (int m = 0; m < 4; ++m) {
                    const int r = ai * 128 + wr * 64 + m * 16 + fr;
                    const size_t ro = (size_t)(u.pm * 256 + r) * D + col0;
                    float sq = 0.f;
#pragma unroll
                    for (int bj = 0; bj < 2; ++bj)
#pragma unroll
                        for (int n = 0; n < 2; ++n) {
                            f32x4 xin;
                            if (MODE == 1) xin = __builtin_nontemporal_load((const f32x4*)(src + ro + bj * 128 + n * 16));
                            else { const u32x2 t = *(const u32x2*)(srcb + ro + bj * 128 + n * 16); xin = (f32x4){bflo(t.x), bfhi(t.x), bflo(t.y), bfhi(t.y)}; }
                            const f32x4 x = xin + mv[bj][n] * acc[ai][bj][m][n]; acc[ai][bj][m][n] = x; sq += (x[0] * x[0] + x[1] * x[1]) + (x[2] * x[2] + x[3] * x[3]);
                            if (MODE != 0) { u32x2 o; o.x = cvtpk(x[0], x[1]); o.y = cvtpk(x[2], x[3]); *(u32x2*)(dstb + ro + bj * 128 + n * 16) = o; } }
                    sq += __shfl_xor(sq, 16); sq += __shfl_xor(sq, 32);
                    if (fq == 0) P[r * 4 + wc] = sq;
                    asm volatile("" ::: "memory");
                }
        }
        asm volatile("s_waitcnt lgkmcnt(0)" ::: "memory"); __builtin_amdgcn_s_barrier(); asm volatile("" ::: "memory");
        const int row = wid * 32 + (lane & 31);
        if (lane < 32) {
            const float t = (P[row * 4 + 0] + P[row * 4 + 1]) + (P[row * 4 + 2] + P[row * 4 + 3]);
            __hip_atomic_store(xbuf + ((size_t)(u.pm * 256 + row) * 4 + u.pn), t, __ATOMIC_RELAXED, __HIP_MEMORY_SCOPE_AGENT);
        }
        asm volatile("s_waitcnt vmcnt(0)" ::: "memory");
        if (lane == 0) __hip_atomic_fetch_add(pcnt + 64 * u.pm, 1u, __ATOMIC_RELAXED, __HIP_MEMORY_SCOPE_AGENT);
        if (wid == 0) {
            unsigned spins = 0;
            while ((unsigned)__builtin_amdgcn_readfirstlane((int)__hip_atomic_load(pcnt + 64 * u.pm, __ATOMIC_RELAXED, __HIP_MEMORY_SCOPE_AGENT)) < 32u) { __builtin_amdgcn_s_sleep(2); if (++spins > (1u << 22)) break; }
            __builtin_amdgcn_fence(__ATOMIC_ACQUIRE, "agent");
        }
        asm volatile("s_waitcnt vmcnt(0) lgkmcnt(0)" ::: "memory"); __builtin_amdgcn_s_barrier(); asm volatile("" ::: "memory");
        if (lane < 32) {
            const unsigned long long* slot = (const unsigned long long*)(xbuf + (size_t)(u.pm * 256 + row) * 4);
            const unsigned long long s01 = __hip_atomic_load(slot, __ATOMIC_RELAXED, __HIP_MEMORY_SCOPE_AGENT), s23 = __hip_atomic_load(slot + 1, __ATOMIC_RELAXED, __HIP_MEMORY_SCOPE_AGENT);
            const float ss = (__builtin_bit_cast(float, (unsigned)s01) + __builtin_bit_cast(float, (unsigned)(s01 >> 32))) + (__builtin_bit_cast(float, (unsigned)s23) + __builtin_bit_cast(float, (unsigned)(s23 >> 32)));
            S[row] = 1.0f / sqrtf(ss * (1.0f / D) + EPS);
        }
        asm volatile("s_waitcnt lgkmcnt(0)" ::: "memory"); __builtin_amdgcn_s_barrier(); asm volatile("" ::: "memory");
        f32x4 wv[2][2], shv[2][2];
#pragma unroll
        for (int bj = 0; bj < 2; ++bj)
#pragma unroll
            for (int n = 0; n < 2; ++n) { wv[bj][n] = *(const f32x4*)(nw + col0 + bj * 128 + n * 16);
                if (MODE != 0) { wv[bj][n] = wv[bj][n] * (*(const f32x4*)(mods + cond * NMODS + SC * D + col0 + bj * 128 + n * 16) + 1.0f); shv[bj][n] = *(const f32x4*)(mods + cond * NMODS + SH * D + col0 + bj * 128 + n * 16); } }
        bf16_t* Hb = (bf16_t*)(wsb + WS_H);
#pragma unroll
        for (int ai = 0; ai < 2; ++ai)
#pragma unroll
            for (int m = 0; m < 4; ++m) {
                const int r = ai * 128 + wr * 64 + m * 16 + fr; const float rs = S[r];
                const size_t ro = (size_t)(u.pm * 256 + r) * D + col0;
#pragma unroll
                for (int bj = 0; bj < 2; ++bj)
#pragma unroll
                    for (int n = 0; n < 2; ++n) {
                        if (MODE == 0) __builtin_nontemporal_store(acc[ai][bj][m][n] * rs * wv[bj][n], (f32x4*)(dst + ro + bj * 128 + n * 16));
                        else { const f32x4 hh = acc[ai][bj][m][n] * rs * wv[bj][n] + shv[bj][n]; u32x2 o; o.x = pk2(hh[0], hh[1]); o.y = pk2(hh[2], hh[3]); *(u32x2*)(Hb + ro + bj * 128 + n * 16) = o; }
                    }
            }
    }
};

template <int MODE> __device__ __forceinline__ int dest_row(int n, int row_off) {
    if (MODE == 0) return n + row_off;
    if (MODE == 1) return (n >> 7) * 256 + (n & 127) + row_off;
    if (n >= 1024) return n;
    const int d = n & 127, half = d >> 6, x = (d >> 5) & 1, i = d & 31;
    const int wc = 2 * half + (i >> 4), fq = (i >> 2) & 3, j = i & 3;
    return (n & ~127) + 32 * wc + 8 * fq + 4 * x + j;
}
template <int MODE> __device__ __forceinline__ void transpose_item(const float* W, int K, int N, bf16_t* WT, int row_off, LAS float* scr, int item, int lane) {
    const int nblk = N / 32, kb = item / nblk, nb = item % nblk, k0 = 64 * kb, n0 = 32 * nb;
    float wv[32];
#pragma unroll
    for (int i = 0; i < 32; ++i) { const int kk = 2 * i + (lane >> 5); wv[i] = __builtin_nontemporal_load(W + (size_t)(k0 + kk) * N + n0 + (lane & 31)); }
#pragma unroll
    for (int i = 0; i < 32; ++i) { const int kk = 2 * i + (lane >> 5); scr[kk * 33 + (lane & 31)] = wv[i]; }
    LDS_WAIT();
    const int c = lane & 7;
#pragma unroll
    for (int j = 0; j < 4; ++j) { const int n = (lane >> 3) + 8 * j; const LAS float* s = scr + (8 * c) * 33 + n;
        u32x4 o; o.x = pk2(s[0 * 33], s[1 * 33]); o.y = pk2(s[2 * 33], s[3 * 33]); o.z = pk2(s[4 * 33], s[5 * 33]); o.w = pk2(s[6 * 33], s[7 * 33]);
        *(u32x4*)(WT + (size_t)dest_row<MODE>(n0 + n, row_off) * K + k0 + 8 * c) = o; }
    LDS_WAIT();
}
__device__ __forceinline__ void convert_ffn(const float* w1, const float* w3, const float* w2, bf16_t* W13, bf16_t* W2, LAS float* scr, int gw, int NGW, int lane) {
    constexpr int I13 = (D / 64) * (FF / 32), I2 = (FF / 64) * (D / 32);
    for (int it = gw; it < 2 * I13 + I2; it += NGW) {
        int r = it;
        if (r < I13) { transpose_item<1>(w1, D, FF, W13, 0, scr, r, lane); continue; } r -= I13;
        if (r < I13) { transpose_item<1>(w3, D, FF, W13, 128, scr, r, lane); continue; } r -= I13;
        transpose_item<0>(w2, FF, D, W2, 0, scr, r, lane);
    }
}

template <bool FROM_PART, bool FINAL>
__device__ __forceinline__ void norm_phase(LAS unsigned char* lds, const float* src_lat, const float* src_ctx, int nrows, const float* nw, const float* part, const float* ada_b, const float* mods,
                                           int shift_idx, int scale_idx, bf16_t* H, float* outf, int gw, int NGW, int tid, int lane, int row_begin = 0, const float* slabs = nullptr) {
    LAS float* tab = (LAS float*)lds;
    if (!FINAL) {
        for (int i4 = tid; i4 < 1536; i4 += NTHREADS) {
            const int idx = 4 * i4, cond = idx >> 11, which = (idx >> 10) & 1, col = idx & 1023, mi = which ? scale_idx : shift_idx;
            if (row_begin >= NLAT && cond != 2) continue;
            f32x4 v;
            if (FROM_PART) { v = *(const f32x4*)(ada_b + mi * D + col);
#pragma unroll
                for (int s = 0; s < 16; ++s) v += *(const f32x4*)(part + (size_t)(s * 3 + cond) * NMODS + mi * D + col); }
            else v = *(const f32x4*)(mods + cond * NMODS + mi * D + col);
            *(LAS f32x4*)(tab + idx) = v;
        }
        __syncthreads();
    }
    f32x4 wv[4];
#pragma unroll
    for (int j = 0; j < 4; ++j) wv[j] = *((const f32x4*)nw + 64 * j + lane);
    for (int row = row_begin + gw; row < nrows; row += 2 * NGW) {
        const int row2 = row + NGW; const bool has2 = row2 < nrows; const int r2 = has2 ? row2 : row;
        const float* xr = row < NLAT ? src_lat + (size_t)row * D : src_ctx + (size_t)(row - NLAT) * D;
        const float* xr2 = r2 < NLAT ? src_lat + (size_t)r2 * D : src_ctx + (size_t)(r2 - NLAT) * D;
        f32x4 v[2][4]; float s[2] = {0.f, 0.f};
#pragma unroll
        for (int j = 0; j < 4; ++j) { v[0][j] = __builtin_nontemporal_load((const f32x4*)xr + 64 * j + lane); v[1][j] = __builtin_nontemporal_load((const f32x4*)xr2 + 64 * j + lane); }
        if (slabs) {
#pragma unroll
            for (int q = 0; q < 2; ++q) { const size_t ro = (size_t)((q ? r2 : row) - NLAT) * D;
#pragma unroll
                for (int j = 0; j < 4; ++j)
#pragma unroll
                    for (int pt = 0; pt < 3; ++pt) v[q][j] += *((const f32x4*)(slabs + (size_t)pt * NCTX * D + ro) + 64 * j + lane); }
        }
#pragma unroll
        for (int q = 0; q < 2; ++q)
#pragma unroll
            for (int j = 0; j < 4; ++j) s[q] += (v[q][j].x * v[q][j].x + v[q][j].y * v[q][j].y) + (v[q][j].z * v[q][j].z + v[q][j].w * v[q][j].w);
#pragma unroll
        for (int q = 0; q < 2; ++q) {
            if (q == 1 && !has2) break;
            const int rr = q ? row2 : row;
            const float rstd = 1.0f / sqrtf(wave_sum(s[q]) * (1.0f / D) + EPS);
            if (FINAL) {
#pragma unroll
                for (int j = 0; j < 4; ++j) *((f32x4*)(outf + (size_t)rr * D) + 64 * j + lane) = v[q][j] * rstd * wv[j];
            } else {
                const int cond = rr < 8192 ? 0 : (rr < NLAT ? 1 : 2);
#pragma unroll
                for (int j = 0; j < 4; ++j) {
                    const f32x4 sh = *((const LAS f32x4*)(tab + (cond * 2 + 0) * 1024) + 64 * j + lane), scl = *((const LAS f32x4*)(tab + (cond * 2 + 1) * 1024) + 64 * j + lane);
                    const f32x4 hh = v[q][j] * rstd * wv[j] * (scl + 1.0f) + sh;
                    u32x2 o; o.x = pk2(hh.x, hh.y); o.y = pk2(hh.z, hh.w);
                    *((u32x2*)(H + (size_t)rr * D) + 64 * j + lane) = o;
                }
            }
        }
    }
}

__device__ __forceinline__ bf16x8 mk8(u32x2 lo, u32x2 hi) { u32x4 t; t.x = lo.x; t.y = lo.y; t.z = hi.x; t.w = hi.y; return __builtin_bit_cast(bf16x8, t); }
__device__ __forceinline__ bf16x8 row_frag(const LAS unsigned char* img, int pitch, int r0, int k0, int fr, int fq) { return *(const LAS bf16x8*)(img + (r0 + fr) * pitch + (k0 + 8 * fq) * 2); }
__device__ __forceinline__ void tr1(unsigned a0, unsigned a1, bf16x8& o) {
    u32x2 l0, h0;
    asm volatile("ds_read_b64_tr_b16 %0, %2\n\tds_read_b64_tr_b16 %1, %3\n\ts_waitcnt lgkmcnt(0)" : "=&v"(l0), "=&v"(h0) : "v"(a0), "v"(a1) : "memory");
    o = mk8(l0, h0);
}
__device__ __forceinline__ void tr2(unsigned a0, unsigned a1, bf16x8 (&o)[2]) {
    u32x2 l0, l1, h0, h1;
    asm volatile("ds_read_b64_tr_b16 %0, %4\n\tds_read_b64_tr_b16 %1, %4 offset:32\n\tds_read_b64_tr_b16 %2, %5\n\tds_read_b64_tr_b16 %3, %5 offset:32\n\ts_waitcnt lgkmcnt(0)"
                 : "=&v"(l0), "=&v"(l1), "=&v"(h0), "=&v"(h1) : "v"(a0), "v"(a1) : "memory");
    o[0] = mk8(l0, h0); o[1] = mk8(l1, h1);
}
__device__ __forceinline__ void tr4(unsigned a0, unsigned a1, bf16x8 (&o)[4]) {
    u32x2 l0, l1, l2, l3, h0, h1, h2, h3;
    asm volatile("ds_read_b64_tr_b16 %0, %8\n\tds_read_b64_tr_b16 %1, %8 offset:32\n\tds_read_b64_tr_b16 %2, %8 offset:64\n\tds_read_b64_tr_b16 %3, %8 offset:96\n\t"
                 "ds_read_b64_tr_b16 %4, %9\n\tds_read_b64_tr_b16 %5, %9 offset:32\n\tds_read_b64_tr_b16 %6, %9 offset:64\n\tds_read_b64_tr_b16 %7, %9 offset:96\n\ts_waitcnt lgkmcnt(0)"
                 : "=&v"(l0), "=&v"(l1), "=&v"(l2), "=&v"(l3), "=&v"(h0), "=&v"(h1), "=&v"(h2), "=&v"(h3) : "v"(a0), "v"(a1) : "memory");
    o[0] = mk8(l0, h0); o[1] = mk8(l1, h1); o[2] = mk8(l2, h2); o[3] = mk8(l3, h3);
}
__device__ __forceinline__ void tr8(unsigned a0, unsigned a1, bf16x8 (&o)[8]) {
    u32x2 l0, l1, l2, l3, l4, l5, l6, l7, h0, h1, h2, h3, h4, h5, h6, h7;
    asm volatile("ds_read_b64_tr_b16 %0, %16\n\tds_read_b64_tr_b16 %1, %16 offset:32\n\tds_read_b64_tr_b16 %2, %16 offset:64\n\tds_read_b64_tr_b16 %3, %16 offset:96\n\t"
                 "ds_read_b64_tr_b16 %4, %16 offset:128\n\tds_read_b64_tr_b16 %5, %16 offset:160\n\tds_read_b64_tr_b16 %6, %16 offset:192\n\tds_read_b64_tr_b16 %7, %16 offset:224\n\t"
                 "ds_read_b64_tr_b16 %8, %17\n\tds_read_b64_tr_b16 %9, %17 offset:32\n\tds_read_b64_tr_b16 %10, %17 offset:64\n\tds_read_b64_tr_b16 %11, %17 offset:96\n\t"
                 "ds_read_b64_tr_b16 %12, %17 offset:128\n\tds_read_b64_tr_b16 %13, %17 offset:160\n\tds_read_b64_tr_b16 %14, %17 offset:192\n\tds_read_b64_tr_b16 %15, %17 offset:224\n\ts_waitcnt lgkmcnt(0)"
                 : "=&v"(l0), "=&v"(l1), "=&v"(l2), "=&v"(l3), "=&v"(l4), "=&v"(l5), "=&v"(l6), "=&v"(l7), "=&v"(h0), "=&v"(h1), "=&v"(h2), "=&v"(h3), "=&v"(h4), "=&v"(h5), "=&v"(h6), "=&v"(h7)
                 : "v"(a0), "v"(a1) : "memory");
    o[0] = mk8(l0, h0); o[1] = mk8(l1, h1); o[2] = mk8(l2, h2); o[3] = mk8(l3, h3); o[4] = mk8(l4, h4); o[5] = mk8(l5, h5); o[6] = mk8(l6, h6); o[7] = mk8(l7, h7);
}
#define MFMA16(a, b, c) __builtin_amdgcn_mfma_f32_16x16x32_bf16((a), (b), (c), 0, 0, 0)

constexpr int PT128 = 288;
constexpr int PT64 = 160;
constexpr int IMG128 = 128 * PT128;
constexpr int IMG64 = 128 * PT64;

__device__ __forceinline__ float logsig(float z) { return fminf(z, 0.f) - __logf(1.0f + __expf(-fabsf(z))); }
__device__ __forceinline__ u32x4 scale8(u32x4 v, float s) {
    u32x4 o;
    o.x = cvtpk(bflo(v.x) * s, bfhi(v.x) * s); o.y = cvtpk(bflo(v.y) * s, bfhi(v.y) * s);
    o.z = cvtpk(bflo(v.z) * s, bfhi(v.z) * s); o.w = cvtpk(bflo(v.w) * s, bfhi(v.w) * s);
    return o;
}
__device__ __forceinline__ void stage128(LAS unsigned char* img, const bf16_t* src, int tid) {
#pragma unroll
    for (int i = 0; i < 4; ++i) { const int v = tid + NTHREADS * i, tok = v >> 4, ch = v & 15;
        *(LAS u32x4*)(img + tok * PT128 + ch * 16) = *(const u32x4*)(src + (size_t)tok * PP + ch * 8); }
}

__device__ __forceinline__ void p6_ret_item(LAS unsigned char* lds, const bf16_t* P, bf16_t* SR, const float* dec_f, const float* dec_b, int item, int tid, int wave, int lane) {
    asm volatile("" : "+v"(tid), "+v"(lane));
    const int tc = item % 66, bh = item / 66, h = bh & 3, b = bh >> 2;
    const int row0 = tc < 2 ? (NLAT + b * 256 + tc * 128) : (b * 8192 + (tc - 2) * 128);
    const float lgf = ((const LAS float*)(lds + LDS_BYTES - 128))[h], lgb = ((const LAS float*)(lds + LDS_BYTES - 128))[4 + h];
    LAS unsigned char* KF = lds; LAS unsigned char* KB = lds + IMG128; LAS unsigned char* V = lds + 2 * IMG128;
    for (int rep1 = 0; rep1 < (PROBE == 19 ? 2 : 1); ++rep1) {
    u32x4 kvr[4], vvr[4];
#pragma unroll
    for (int i = 0; i < 4; ++i) { const int v = tid + NTHREADS * i, tok = v >> 4, ch = v & 15;
        const bf16_t* prow = P + (size_t)(row0 + tok) * PP + h * 128 + ch * 8;
        kvr[i] = *(const u32x4*)(prow + 512); vvr[i] = *(const u32x4*)(prow + 1024); }
#pragma unroll
    for (int i = 0; i < 4; ++i) { const int v = tid + NTHREADS * i, tok = v >> 4, ch = v & 15;
        const float sf = __expf((float)(127 - tok) * lgf), sb = __expf((float)tok * lgb);
        *(LAS u32x4*)(KF + tok * PT128 + ch * 16) = scale8(kvr[i], sf);
        *(LAS u32x4*)(KB + tok * PT128 + ch * 16) = scale8(kvr[i], sb);
        *(LAS u32x4*)(V + tok * PT128 + ch * 16) = vvr[i]; }
    __syncthreads();
    }
    const int g = lane >> 4, q = (lane & 15) >> 2, p = lane & 3, fr = lane & 15, fq = g;
    const int rb = wave >> 1, cb = wave & 1;
    const unsigned base = (unsigned)(size_t)lds;
    f32x4 af[2][4], ab[2][4];
#pragma unroll
    for (int x = 0; x < 2; ++x)
#pragma unroll
        for (int y = 0; y < 4; ++y) { af[x][y] = (f32x4){0.f, 0.f, 0.f, 0.f}; ab[x][y] = (f32x4){0.f, 0.f, 0.f, 0.f}; }
    for (int rep2 = 0; rep2 < (PROBE == 20 ? 2 : 1); ++rep2)
#pragma unroll
    for (int ks = 0; ks < 4; ++ks) {
        const unsigned rofs = (unsigned)((32 * ks + 8 * g + q) * PT128 + 8 * p);
        bf16x8 vf[4], kf[2], kb[2];
        tr4(base + 2 * IMG128 + rofs + 128 * cb, base + 2 * IMG128 + rofs + 128 * cb + 4 * PT128, vf);
        tr2(base + rofs + 64 * rb, base + rofs + 64 * rb + 4 * PT128, kf);
        tr2(base + IMG128 + rofs + 64 * rb, base + IMG128 + rofs + 64 * rb + 4 * PT128, kb);
#pragma unroll
        for (int x = 0; x < 2; ++x)
#pragma unroll
            for (int y = 0; y < 4; ++y) { af[x][y] = MFMA16(kf[x], vf[y], af[x][y]); ab[x][y] = MFMA16(kb[x], vf[y], ab[x][y]); }
    }
    if (PROBE == 20) {
#pragma unroll
        for (int x = 0; x < 2; ++x)
#pragma unroll
            for (int y = 0; y < 4; ++y) { af[x][y] *= 0.5f; ab[x][y] *= 0.5f; } }
    bf16_t* Uf = SR + ((size_t)((0 * 2 + b) * 4 + h) * 66 + tc) * 16384;
    bf16_t* Ub = SR + ((size_t)((1 * 2 + b) * 4 + h) * 66 + tc) * 16384;
    for (int rep3 = 0; rep3 < (PROBE == 21 ? 2 : 1); ++rep3)
#pragma unroll
    for (int x = 0; x < 2; ++x)
#pragma unroll
        for (int y = 0; y < 4; ++y) {
            const int dk = 32 * rb + 16 * x + 4 * fq, dv = 64 * cb + 16 * y + fr;
#ifdef TEST_CLAMP
#pragma unroll
            for (int e = 0; e < 4; ++e) { af[x][y][e] = fminf(fmaxf(af[x][y][e], -1e4f), 1e4f); ab[x][y][e] = fminf(fmaxf(ab[x][y][e], -1e4f), 1e4f); }
#endif
            u32x2 o; o.x = pk2(af[x][y][0], af[x][y][1]); o.y = pk2(af[x][y][2], af[x][y][3]);
            *(u32x2*)(Uf + dv * 128 + dk) = o;
            o.x = pk2(ab[x][y][0], ab[x][y][1]); o.y = pk2(ab[x][y][2], ab[x][y][3]);
            *(u32x2*)(Ub + dv * 128 + dk) = o;
        }
    __syncthreads();
}

constexpr int LRS_OFF = 122880;
constexpr int DTAB_OFF = LRS_OFF + 16384;
__device__ __forceinline__ void gla_gates(LAS unsigned char* lds, LAS float* tot, const float* LR, const float* wf, const float* bfv, const float* wb, const float* bbv, int row0, int h, int tid, int wave,
                                          float (&bf)[16], float (&bb)[16], float& totf, float& totb) {
    const int d = tid & 63, col = h * 64 + d;
    LAS float* lrs = (LAS float*)(lds + LRS_OFF);
    { const f32x4* srcv = (const f32x4*)(LR + (size_t)row0 * 32); const f32x4 v0 = srcv[tid], v1 = srcv[tid + NTHREADS]; *((LAS f32x4*)lrs + tid) = v0; *((LAS f32x4*)lrs + tid + NTHREADS) = v1; }
    f32x2 wf2[8], wb2[8];
#pragma unroll
    for (int r = 0; r < 8; ++r) { wf2[r] = (f32x2){wf[(2 * r) * 256 + col], wf[(2 * r + 1) * 256 + col]}; wb2[r] = (f32x2){wb[(2 * r) * 256 + col], wb[(2 * r + 1) * 256 + col]}; }
    const float biasf = bfv[col], biasb = bbv[col];
    __syncthreads();
#pragma unroll
    for (int t = 0; t < 16; ++t) {
        const LAS float* lr = lrs + (16 * wave + t) * 32;
        f32x2 zf = (f32x2){biasf, 0.f}, zb = (f32x2){biasb, 0.f};
#pragma unroll
        for (int r4 = 0; r4 < 4; ++r4) { const f32x4 a = *(const LAS f32x4*)(lr + 4 * r4), c = *(const LAS f32x4*)(lr + 16 + 4 * r4);
            zf = __builtin_elementwise_fma((f32x2){a.x, a.y}, wf2[2 * r4], zf); zf = __builtin_elementwise_fma((f32x2){a.z, a.w}, wf2[2 * r4 + 1], zf);
            zb = __builtin_elementwise_fma((f32x2){c.x, c.y}, wb2[2 * r4], zb); zb = __builtin_elementwise_fma((f32x2){c.z, c.w}, wb2[2 * r4 + 1], zb); }
        bf[t] = logsig(zf.x + zf.y) * (1.0f / 16.0f); bb[t] = logsig(zb.x + zb.y) * (1.0f / 16.0f);
    }
#pragma unroll
    for (int t = 1; t < 16; ++t) bf[t] += bf[t - 1];
#pragma unroll
    for (int t = 14; t >= 0; --t) bb[t] += bb[t + 1];
    tot[wave * 64 + d] = bf[15]; tot[512 + wave * 64 + d] = bb[0];
    __syncthreads();
    const int sub = wave >> 2, gi = wave & 3;
    float pf = 0.f, sb = 0.f; totf = 0.f; totb = 0.f;
#pragma unroll
    for (int g2 = 0; g2 < 4; ++g2) { const float a = tot[(sub * 4 + g2) * 64 + d], c = tot[512 + (sub * 4 + g2) * 64 + d]; totf += a; totb += c; if (g2 < gi) pf += a; if (g2 > gi) sb += c; }
#pragma unroll
    for (int t = 0; t < 16; ++t) { bf[t] += pf; bb[t] += sb; }
}

__device__ __forceinline__ void p6_gla_item(LAS unsigned char* lds, const bf16_t* P, const float* LR, bf16_t* SG, float* DG, const float* wf, const float* bfv, const float* wb, const float* bbv,
                                            int item, int tid, int wave, int lane) {
    asm volatile("" : "+v"(tid), "+v"(lane));
    const int tc = item % 66, bh = item / 66, h = bh & 3, b = bh >> 2;
    const int row0 = tc < 2 ? (NLAT + b * 256 + tc * 128) : (b * 8192 + (tc - 2) * 128);
    LAS unsigned char* KF = lds; LAS unsigned char* KB = lds + IMG64; LAS unsigned char* V = lds + 2 * IMG64; LAS float* tot = (LAS float*)(lds + 2 * IMG64 + IMG128);
    stage128(V, P + (size_t)row0 * PP + 2560 + h * 128, tid);
    const int d = tid & 63, sub = wave >> 2;
    bf16_t kraw[16];
#pragma unroll
    for (int t = 0; t < 16; ++t) kraw[t] = P[(size_t)(row0 + 16 * wave + t) * PP + 2304 + h * 64 + d];
    float bf[16], bb[16], totf, totb;
    gla_gates(lds, tot, LR, wf, bfv, wb, bbv, row0, h, tid, wave, bf, bb, totf, totb);
    const int chf = (0 * 2 + b) * 4 + h, chb = (1 * 2 + b) * 4 + h, tc64 = 2 * tc + sub;
#pragma unroll
    for (int t = 0; t < 16; ++t) {
        const int tok = 16 * wave + t;
        const float kv = bf2f(kraw[t]);
        *(LAS bf16_t*)(KF + tok * PT64 + d * 2) = (bf16_t)cvtpk(kv * __expf(totf - bf[t]), 0.f);
        *(LAS bf16_t*)(KB + tok * PT64 + d * 2) = (bf16_t)cvtpk(kv * __expf(totb - bb[t]), 0.f);
    }
    if ((wave & 3) == 0) { DG[((size_t)chf * 132 + tc64) * 64 + d] = __expf(totf); DG[((size_t)chb * 132 + tc64) * 64 + d] = __expf(totb); }
    __syncthreads();
    const int g = lane >> 4, q = (lane & 15) >> 2, p = lane & 3, fr = lane & 15, fq = g, wl = wave & 3;
    const unsigned base = (unsigned)(size_t)lds;
    f32x4 af[8], ab[8];
#pragma unroll
    for (int y = 0; y < 8; ++y) { af[y] = (f32x4){0.f, 0.f, 0.f, 0.f}; ab[y] = (f32x4){0.f, 0.f, 0.f, 0.f}; }
#pragma unroll
    for (int ks = 0; ks < 2; ++ks) {
        const int r = sub * 64 + 32 * ks + 8 * g + q;
        bf16x8 vf[8], xf, xb;
        tr8(base + 2 * IMG64 + r * PT128 + 8 * p, base + 2 * IMG64 + (r + 4) * PT128 + 8 * p, vf);
        tr1(base + r * PT64 + 32 * wl + 8 * p, base + (r + 4) * PT64 + 32 * wl + 8 * p, xf);
        tr1(base + IMG64 + r * PT64 + 32 * wl + 8 * p, base + IMG64 + (r + 4) * PT64 + 32 * wl + 8 * p, xb);
#pragma unroll
        for (int y = 0; y < 8; ++y) { af[y] = MFMA16(xf, vf[y], af[y]); ab[y] = MFMA16(xb, vf[y], ab[y]); }
    }
    bf16_t* Uf = SG + ((size_t)chf * 132 + tc64) * 8192;
    bf16_t* Ub = SG + ((size_t)chb * 132 + tc64) * 8192;
#pragma unroll
    for (int y = 0; y < 8; ++y) {
        const int dk = 16 * wl + 4 * fq, dv = 16 * y + fr;
        u32x2 o; o.x = pk2(af[y][0], af[y][1]); o.y = pk2(af[y][2], af[y][3]);
        *(u32x2*)(Uf + dv * 64 + dk) = o;
        o.x = pk2(ab[y][0], ab[y][1]); o.y = pk2(ab[y][2], ab[y][3]);
        *(u32x2*)(Ub + dv * 64 + dk) = o;
    }
    __syncthreads();
}

__device__ __forceinline__ void p7_scan(bf16_t* SR, bf16_t* SG, const float* DG, const float* dec_f, const float* dec_b, int gtid, int gthreads) {
    for (int task = gtid; task < 65536 + 32768; task += gthreads) {
        if (task < 65536) {
            const int chain = task >> 12, e4 = task & 4095, dir = chain >> 3, h = chain & 3;
            const float lg = -log1pf(expf(-(dir ? dec_b[h] : dec_f[h])));
            const float dec = expf(128.0f * lg);
            bf16_t* basep = SR + (size_t)chain * 66 * 16384 + e4 * 4;
            f32x4 s = (f32x4){0.f, 0.f, 0.f, 0.f};
            for (int n0 = 0; n0 < 66; n0 += 11) {
                u32x2 u[11];
#pragma unroll
                for (int i = 0; i < 11; ++i) { const int n = n0 + i; const int tc = dir ? (n < 2 ? 1 - n : 67 - n) : n; u[i] = __builtin_nontemporal_load((const u32x2*)(basep + (size_t)tc * 16384)); }
#pragma unroll
                for (int i = 0; i < 11; ++i) { const int n = n0 + i; const int tc = dir ? (n < 2 ? 1 - n : 67 - n) : n;
                    u32x2 o; o.x = pk2(s.x, s.y); o.y = pk2(s.z, s.w);
                    *(u32x2*)(basep + (size_t)tc * 16384) = o;
                    s.x = dec * s.x + bflo(u[i].x); s.y = dec * s.y + bfhi(u[i].x); s.z = dec * s.z + bflo(u[i].y); s.w = dec * s.w + bfhi(u[i].y); }
            }
        } else {
            const int t2 = task - 65536, chain = t2 >> 11, e4 = t2 & 2047, dir = chain >> 3, dk0 = (e4 * 4) & 63;
            bf16_t* basep = SG + (size_t)chain * 132 * 8192 + e4 * 4;
            const float* dgp = DG + (size_t)chain * 132 * 64 + dk0;
            f32x4 s = (f32x4){0.f, 0.f, 0.f, 0.f};
            for (int n0 = 0; n0 < 132; n0 += 11) {
                u32x2 u[11]; f32x4 dc[11];
#pragma unroll
                for (int i = 0; i < 11; ++i) { const int n = n0 + i; const int tc = dir ? (n < 4 ? 3 - n : 135 - n) : n; u[i] = __builtin_nontemporal_load((const u32x2*)(basep + (size_t)tc * 8192)); dc[i] = *(const f32x4*)(dgp + tc * 64); }
#pragma unroll
                for (int i = 0; i < 11; ++i) { const int n = n0 + i; const int tc = dir ? (n < 4 ? 3 - n : 135 - n) : n;
                    u32x2 o; o.x = pk2(s.x, s.y); o.y = pk2(s.z, s.w);
                    *(u32x2*)(basep + (size_t)tc * 8192) = o;
                    s.x = dc[i].x * s.x + bflo(u[i].x); s.y = dc[i].y * s.y + bfhi(u[i].x); s.z = dc[i].z * s.z + bflo(u[i].y); s.w = dc[i].w * s.w + bfhi(u[i].y); }
            }
        }
    }
}

__device__ __forceinline__ void p8_ret_item(LAS unsigned char* lds, const bf16_t* P, const bf16_t* SR, bf16_t* Hm, const float* dec_f, const float* dec_b, const float* normw,
                                            int item, int tid, int wave, int lane) {
    asm volatile("" : "+v"(tid), "+v"(lane));
    const int c = item & 63, bh = item >> 6, h = bh & 3, b = bh >> 2;
    const int row0 = b * 8192 + c * 128, tc = c + 2;
    const float lgf = ((const LAS float*)(lds + LDS_BYTES - 128))[h], lgb = ((const LAS float*)(lds + LDS_BYTES - 128))[4 + h];
    LAS unsigned char* Q = lds; LAS unsigned char* K = lds + IMG128; LAS unsigned char* V = lds + 2 * IMG128;
    const LAS float* dtab = (const LAS float*)(lds + DTAB_OFF) + h * 256 + 127;
    stage128(Q, P + (size_t)row0 * PP + h * 128, tid);
    stage128(K, P + (size_t)row0 * PP + 512 + h * 128, tid);
    stage128(V, P + (size_t)row0 * PP + 1024 + h * 128, tid);
    const bf16_t* Sf = SR + ((size_t)((0 * 2 + b) * 4 + h) * 66 + tc) * 16384;
    const bf16_t* Sb = SR + ((size_t)((1 * 2 + b) * 4 + h) * 66 + tc) * 16384;
    u32x4 sfr[4], sbr[4];
#pragma unroll
    for (int i = 0; i < 4; ++i) { sfr[i] = *(const u32x4*)(Sf + (size_t)(tid + NTHREADS * i) * 8); sbr[i] = *(const u32x4*)(Sb + (size_t)(tid + NTHREADS * i) * 8); }
    __syncthreads();
    const int g = lane >> 4, q = (lane & 15) >> 2, p = lane & 3, fr = lane & 15, fq = g;
    const int i0 = 16 * wave;
    const unsigned base = (unsigned)(size_t)lds;
    bf16x8 qf[4];
#pragma unroll
    for (int ks = 0; ks < 4; ++ks) qf[ks] = row_frag(Q, PT128, i0, 32 * ks, fr, fq);
    u32x2 scp[8];
#pragma unroll
    for (int jb = 0; jb < 8; ++jb) {
        f32x4 a = (f32x4){0.f, 0.f, 0.f, 0.f};
#pragma unroll
        for (int ks = 0; ks < 4; ++ks) a = MFMA16(row_frag(K, PT128, 16 * jb, 32 * ks, fr, fq), qf[ks], a);
        const int i = i0 + fr;
#pragma unroll
        for (int e = 0; e < 4; ++e) a[e] *= dtab[i - (16 * jb + 4 * fq + e)];
        scp[jb].x = pg8::cvt_pk_bf16(a[0], a[1]); scp[jb].y = pg8::cvt_pk_bf16(a[2], a[3]);
        asm volatile("" ::: "memory");
    }
    f32x4 ao[8];
#pragma unroll
    for (int y = 0; y < 8; ++y) ao[y] = (f32x4){0.f, 0.f, 0.f, 0.f};
#pragma unroll
    for (int s2 = 0; s2 < 4; ++s2) {
        const bf16x8 xs = mk8(scp[2 * s2], scp[2 * s2 + 1]);
        const int r = 32 * s2 + 4 * g + q;
        bf16x8 vf[8];
        tr8(base + 2 * IMG128 + r * PT128 + 8 * p, base + 2 * IMG128 + (r + 16) * PT128 + 8 * p, vf);
#pragma unroll
        for (int y = 0; y < 8; ++y) ao[y] = MFMA16(vf[y], xs, ao[y]);
    }
    __syncthreads();
#pragma unroll
    for (int i = 0; i < 4; ++i) { const int v = tid + NTHREADS * i, dv = v >> 4, ch = v & 15;
        *(LAS u32x4*)(Q + dv * PT128 + ch * 16) = sfr[i]; *(LAS u32x4*)(K + dv * PT128 + ch * 16) = sbr[i]; }
    __syncthreads();
    const float qsf = __expf((float)(i0 + fr + 1) * lgf), qsb = __expf((float)(128 - i0 - fr) * lgb);
#pragma unroll
    for (int ks = 0; ks < 4; ++ks) {
        const bf16x8 xf = __builtin_bit_cast(bf16x8, scale8(__builtin_bit_cast(u32x4, qf[ks]), qsf)), xb = __builtin_bit_cast(bf16x8, scale8(__builtin_bit_cast(u32x4, qf[ks]), qsb));
#pragma unroll
        for (int y = 0; y < 8; ++y) ao[y] = MFMA16(row_frag(Q, PT128, 16 * y, 32 * ks, fr, fq), xf, ao[y]);
#pragma unroll
        for (int y = 0; y < 8; ++y) ao[y] = MFMA16(row_frag(K, PT128, 16 * y, 32 * ks, fr, fq), xb, ao[y]);
        asm volatile("" ::: "memory");
    }
    float s1 = 0.f, sq = 0.f;
#pragma unroll
    for (int y = 0; y < 8; ++y) s1 += (ao[y][0] + ao[y][1]) + (ao[y][2] + ao[y][3]);
    s1 += __shfl_xor(s1, 16); s1 += __shfl_xor(s1, 32);
    const float mu = s1 * (1.0f / 128.0f);
#pragma unroll
    for (int y = 0; y < 8; ++y)
#pragma unroll
        for (int e = 0; e < 4; ++e) { const float dlt = ao[y][e] - mu; sq += dlt * dlt; }
    sq += __shfl_xor(sq, 16); sq += __shfl_xor(sq, 32);
    const float rstd = 1.0f / sqrtf(sq * (1.0f / 128.0f) + EPS);
    const int row = row0 + i0 + fr;
    const bf16_t* gp = P + (size_t)row * PP + 1536 + h * 128 + 4 * fq;
    bf16_t* op = Hm + (size_t)row * D + h * 128 + 4 * fq;
    const float* wp = normw + h * 128 + 4 * fq;
#pragma unroll
    for (int y = 0; y < 8; ++y) {
        const u32x2 gt = *(const u32x2*)(gp + 16 * y); const f32x4 w = *(const f32x4*)(wp + 16 * y);
        u32x2 o;
        o.x = cvtpk((ao[y][0] - mu) * rstd * w.x * bflo(gt.x), (ao[y][1] - mu) * rstd * w.y * bfhi(gt.x));
        o.y = cvtpk((ao[y][2] - mu) * rstd * w.z * bflo(gt.y), (ao[y][3] - mu) * rstd * w.w * bfhi(gt.y));
        *(u32x2*)(op + 16 * y) = o;
    }
    __syncthreads();
}

__device__ __forceinline__ void p8_gla_item(LAS unsigned char* lds, const bf16_t* P, const float* LR, const bf16_t* SG, bf16_t* Hm, const float* wf, const float* bfv, const float* wb, const float* bbv,
                                            const float* normw, int item, int tid, int wave, int lane) {
    asm volatile("" : "+v"(tid), "+v"(lane));
    const int c = item & 63, bh = item >> 6, h = bh & 3, b = bh >> 2;
    const int row0 = b * 8192 + c * 128;
    LAS unsigned char* QF = lds; LAS unsigned char* KF = lds + IMG64; LAS unsigned char* QB = lds + 2 * IMG64; LAS unsigned char* KB = lds + 3 * IMG64; LAS unsigned char* V = lds + 4 * IMG64;
    LAS float* tot = (LAS float*)(lds + 4 * IMG64 + IMG128);
    stage128(V, P + (size_t)row0 * PP + 2560 + h * 128, tid);
    const bf16_t* Sf = SG + ((size_t)((0 * 2 + b) * 4 + h) * 132 + 4 + 2 * c) * 8192;
    const bf16_t* Sb = SG + ((size_t)((1 * 2 + b) * 4 + h) * 132 + 4 + 2 * c) * 8192;
    u32x4 sfr[4], sbr[4];
#pragma unroll
    for (int i = 0; i < 4; ++i) { sfr[i] = *(const u32x4*)(Sf + (size_t)(tid + NTHREADS * i) * 8); sbr[i] = *(const u32x4*)(Sb + (size_t)(tid + NTHREADS * i) * 8); }
    const int d = tid & 63, sub = wave >> 2, wl = wave & 3;
    bf16_t qraw[16], kraw[16];
#pragma unroll
    for (int t = 0; t < 16; ++t) { const bf16_t* pr = P + (size_t)(row0 + 16 * wave + t) * PP + h * 64 + d; qraw[t] = pr[2048]; kraw[t] = pr[2304]; }
    float bf[16], bb[16], totf, totb;
    gla_gates(lds, tot, LR, wf, bfv, wb, bbv, row0, h, tid, wave, bf, bb, totf, totb);
#pragma unroll
    for (int t = 0; t < 16; ++t) {
        const int tok = 16 * wave + t;
        const float qv = bf2f(qraw[t]), kv = bf2f(kraw[t]);
        const float ef = __expf(bf[t]), eb = __expf(bb[t]);
        *(LAS bf16_t*)(QF + tok * PT64 + d * 2) = (bf16_t)cvtpk(qv * ef, 0.f);
        *(LAS bf16_t*)(KF + tok * PT64 + d * 2) = (bf16_t)cvtpk(kv * __builtin_amdgcn_rcpf(ef), 0.f);
        *(LAS bf16_t*)(QB + tok * PT64 + d * 2) = (bf16_t)cvtpk(qv * eb, 0.f);
        *(LAS bf16_t*)(KB + tok * PT64 + d * 2) = (bf16_t)cvtpk(kv * __builtin_amdgcn_rcpf(eb), 0.f);
    }
    __syncthreads();
    const int g = lane >> 4, q = (lane & 15) >> 2, p = lane & 3, fr = lane & 15, fq = g;
    const int i0 = sub * 64 + 16 * wl;
    const unsigned base = (unsigned)(size_t)lds;
    bf16x8 qff[2], qbf[2];
#pragma unroll
    for (int ks = 0; ks < 2; ++ks) { qff[ks] = row_frag(QF, PT64, i0, 32 * ks, fr, fq); qbf[ks] = row_frag(QB, PT64, i0, 32 * ks, fr, fq); }
    u32x2 scp[4];
#pragma unroll
    for (int jb = 0; jb < 4; ++jb) {
        f32x4 a = (f32x4){0.f, 0.f, 0.f, 0.f}, a2 = (f32x4){0.f, 0.f, 0.f, 0.f};
#pragma unroll
        for (int ks = 0; ks < 2; ++ks) { a = MFMA16(row_frag(KF, PT64, sub * 64 + 16 * jb, 32 * ks, fr, fq), qff[ks], a); a2 = MFMA16(row_frag(KB, PT64, sub * 64 + 16 * jb, 32 * ks, fr, fq), qbf[ks], a2); }
        const int il = 16 * wl + fr;
        float v[4];
#pragma unroll
        for (int e = 0; e < 4; ++e) { const float dd = (float)(il - (16 * jb + 4 * fq + e)); v[e] = a[e] * fminf(fmaxf(dd + 1.0f, 0.f), 1.0f) + a2[e] * fminf(fmaxf(1.0f - dd, 0.f), 1.0f); }
        scp[jb].x = pg8::cvt_pk_bf16(v[0], v[1]); scp[jb].y = pg8::cvt_pk_bf16(v[2], v[3]);
        asm volatile("" ::: "memory");
    }
    f32x4 ao[8];
#pragma unroll
    for (int y = 0; y < 8; ++y) ao[y] = (f32x4){0.f, 0.f, 0.f, 0.f};
#pragma unroll
    for (int s2 = 0; s2 < 2; ++s2) {
        const bf16x8 xs = mk8(scp[2 * s2], scp[2 * s2 + 1]);
        const int r = sub * 64 + 32 * s2 + 4 * g + q;
        bf16x8 vf[8];
        tr8(base + 4 * IMG64 + r * PT128 + 8 * p, base + 4 * IMG64 + (r + 16) * PT128 + 8 * p, vf);
#pragma unroll
        for (int y = 0; y < 8; ++y) ao[y] = MFMA16(vf[y], xs, ao[y]);
    }
    __syncthreads();
#pragma unroll
    for (int i = 0; i < 4; ++i) { const int v = tid + NTHREADS * i, m = v >> 10, dv = (v >> 3) & 127, ch = v & 7;
        *(LAS u32x4*)(lds + m * IMG64 + dv * PT64 + ch * 16) = sfr[i]; *(LAS u32x4*)(lds + (2 + m) * IMG64 + dv * PT64 + ch * 16) = sbr[i]; }
    __syncthreads();
    const LAS unsigned char* SFI = lds + sub * IMG64; const LAS unsigned char* SBI = lds + (2 + sub) * IMG64;
#pragma unroll
    for (int ks = 0; ks < 2; ++ks) {
#pragma unroll
        for (int y = 0; y < 8; ++y) ao[y] = MFMA16(row_frag(SFI, PT64, 16 * y, 32 * ks, fr, fq), qff[ks], ao[y]);
#pragma unroll
        for (int y = 0; y < 8; ++y) ao[y] = MFMA16(row_frag(SBI, PT64, 16 * y, 32 * ks, fr, fq), qbf[ks], ao[y]);
        asm volatile("" ::: "memory");
    }
    float ss = 0.f;
#pragma unroll
    for (int y = 0; y < 8; ++y)
#pragma unroll
        for (int e = 0; e < 4; ++e) ss += ao[y][e] * ao[y][e];
    ss += __shfl_xor(ss, 16); ss += __shfl_xor(ss, 32);
    const float rstd = 1.0f / sqrtf(ss * (1.0f / 128.0f) + EPS);
    const int row = row0 + i0 + fr;
    const bf16_t* gp = P + (size_t)row * PP + 3072 + h * 128 + 4 * fq;
    bf16_t* op = Hm + (size_t)row * D + 512 + h * 128 + 4 * fq;
    const float* wp = normw + h * 128 + 4 * fq;
#pragma unroll
    for (int y = 0; y < 8; ++y) {
        const u32x2 gt = *(const u32x2*)(gp + 16 * y); const f32x4 w = *(const f32x4*)(wp + 16 * y);
        u32x2 o;
        o.x = cvtpk(ao[y][0] * rstd * w.x * bflo(gt.x), ao[y][1] * rstd * w.y * bfhi(gt.x));
        o.y = cvtpk(ao[y][2] * rstd * w.z * bflo(gt.y), ao[y][3] * rstd * w.w * bfhi(gt.y));
        *(u32x2*)(op + 16 * y) = o;
    }
    __syncthreads();
}

#define XB_TMO      128
#define XB_XCNT(j)  (256  + 64 * (j))
#define XB_XSUB(j)  (1280 + 64 * (j))
#define XB_XGEN(j)  (2304 + 64 * (j))
#define XB_TOP      3328
#define XB_TOPGEN   3392
#define XCD_BAR_WORDS 3456
#define XB_SPIN_CAP (1u << 18)

__device__ __forceinline__ unsigned xb_ld(unsigned* p)              { return __hip_atomic_load(p, __ATOMIC_RELAXED, __HIP_MEMORY_SCOPE_AGENT); }
__device__ __forceinline__ unsigned xb_add(unsigned* p, unsigned v) { return __hip_atomic_fetch_add(p, v, __ATOMIC_RELAXED, __HIP_MEMORY_SCOPE_AGENT); }
__device__ __forceinline__ unsigned xb_xcc_id() { return (unsigned)__builtin_amdgcn_s_getreg((3 << 11) | 20) & 0xFu; }
#define XB_SPIN(cond, bar) do { unsigned _sp = 0; while (cond) { __builtin_amdgcn_s_sleep(1); \
    if ((++_sp & 255u) == 0u) { if (xb_ld(&(bar)[XB_TMO])) break; if (_sp > XB_SPIN_CAP) { atomicAdd(&(bar)[XB_TMO], 1u); break; } } } } while (0)

struct XcdBarrier {
    unsigned* bar; unsigned x;
    volatile LAS unsigned* st;
};

__device__ __forceinline__ XcdBarrier xcd_barrier_post(unsigned* bar, volatile LAS unsigned* st) {
    XcdBarrier b; b.bar = bar; b.x = xb_xcc_id(); b.st = st;
    if (threadIdx.x == 0) (void)xb_add(&bar[XB_XCNT(b.x)], 1u);
    return b;
}
__device__ __forceinline__ void xcd_barrier_complete(unsigned* bar, unsigned x, unsigned& nloc, unsigned& nx) {
    const unsigned G = gridDim.x * gridDim.y * gridDim.z;
    unsigned sum, cnt, mine, sp = 0u;
    for (;;) {
        sum = 0u; cnt = 0u; mine = 0u;
#pragma unroll
        for (unsigned j = 0; j < 16; ++j) { const unsigned c = xb_ld(&bar[XB_XCNT(j)]); sum += c; cnt += (c > 0u) ? 1u : 0u; mine = (j == x) ? c : mine; }
        if (sum == G) break;
        __builtin_amdgcn_s_sleep(1);
        if ((++sp & 255u) == 0u) { if (xb_ld(&bar[XB_TMO])) break; if (sp > XB_SPIN_CAP) { atomicAdd(&bar[XB_TMO], 1u); break; } }
    }
    nloc = mine > 0u ? mine : 1u; nx = cnt > 0u ? cnt : 1u;
}

__device__ __forceinline__ void xcd_barrier(const XcdBarrier& b) {
    asm volatile("s_waitcnt vmcnt(0)" ::: "memory");
    __syncthreads();
    if (threadIdx.x == 0) {
        unsigned* bar = b.bar;
        __builtin_amdgcn_s_waitcnt(0);
        unsigned nloc = b.st[0], nx = b.st[1];
        if (nloc == 0u) { xcd_barrier_complete(bar, b.x, nloc, nx); b.st[0] = nloc; b.st[1] = nx; }
        const unsigned old = xb_add(&bar[XB_XSUB(b.x)], 1u);
        const unsigned gen = old / nloc;
        if (old + 1u == (gen + 1u) * nloc) {
            __builtin_amdgcn_fence(__ATOMIC_RELEASE, "agent");
            asm volatile("s_waitcnt vmcnt(0)" ::: "memory");
            const unsigned og = xb_add(&bar[XB_TOP], 1u);
            const unsigned tg = og / nx;
            if (og + 1u == (tg + 1u) * nx) xb_add(&bar[XB_TOPGEN], 1u);
            else XB_SPIN(xb_ld(&bar[XB_TOPGEN]) == tg, bar);
            __builtin_amdgcn_fence(__ATOMIC_ACQUIRE, "agent");
            xb_add(&bar[XB_XGEN(b.x)], 1u);
            asm volatile("s_waitcnt vmcnt(0)" ::: "memory");
        } else {
            XB_SPIN(xb_ld(&bar[XB_XGEN(b.x)]) == gen, bar);
            __builtin_amdgcn_fence(__ATOMIC_ACQUIRE, "agent");
            asm volatile("s_waitcnt vmcnt(0)" ::: "memory");
        }
    }
    __syncthreads();
}


__device__ __attribute__((noinline)) void xcd_barrier_ool(unsigned* barp, unsigned x, volatile LAS unsigned* st) { XcdBarrier b; b.bar = barp; b.x = x; b.st = st; xcd_barrier(b); }

#ifndef PHM
#define PHM 0xffff
#endif
struct Args { const float* in[26]; float* out; unsigned char* ws; };
enum { I_X = 0, I_C, I_CTX, I_CCTX, I_ADAW, I_ADAB, I_N1W, I_F1W1, I_F1W3, I_F1W2, I_N2W, I_WIN, I_RDF, I_RDB, I_RNW, I_GWF, I_GBF, I_GWB, I_GBB, I_GNW, I_WOUT, I_N3W, I_F2W1, I_F2W3, I_F2W2, I_FNW };

#ifndef P6SKIP
#define P6SKIP 0
#endif
#ifndef PROBE
#define PROBE 0
#endif
#ifndef PHSKIP
#define PHSKIP 0
#endif
template <int ph> __device__ __forceinline__ void run_phase(LAS unsigned char* lds, const int G, const int NGW, const bool probe_dst = false) {
    if (PHSKIP & (1 << ph)) return;
        int tid = threadIdx.x; asm volatile("" : "+v"(tid));
        int bid = blockIdx.x; asm volatile("" : "+s"(bid));
        const int lane = tid & 63, wave = __builtin_amdgcn_readfirstlane(tid >> 6), gw = bid * 8 + wave;
        const __attribute__((address_space(4))) char* kargs = (const __attribute__((address_space(4))) char*)__builtin_amdgcn_kernarg_segment_ptr(); asm volatile("" : "+s"(kargs));
        unsigned char* ws = *(unsigned char* const __attribute__((address_space(4)))*)(kargs + 8 * 27);
        float* out = *(float* const __attribute__((address_space(4)))*)(kargs + 8 * 26);
#define INP(i) (*(const float* const __attribute__((address_space(4)))*)(kargs + 8 * (i)))
        float* part = (float*)(ws + WS_PART); float* mods = (float*)(ws + WS_MODS); float* LR = (float*)(ws + WS_LR); float* X1C = (float*)(ws + WS_X1C); float* DG = (float*)(ws + WS_DG);
        bf16_t* W13 = (bf16_t*)(ws + WS_W13); bf16_t* W2 = (bf16_t*)(ws + WS_W2); bf16_t* WIN = (bf16_t*)(ws + WS_WIN); bf16_t* WOUT = (bf16_t*)(ws + WS_WOUT);
        bf16_t* H = (bf16_t*)(ws + WS_H); bf16_t* GP = (bf16_t*)(ws + WS_GP); bf16_t* SR = (bf16_t*)(ws + WS_SR); bf16_t* SG = (bf16_t*)(ws + WS_SG);
        if (ph == 0 && (PHM & 1)) {
            LAS float* scv = (LAS float*)lds;
            LAS f32x4* red = (LAS f32x4*)(lds + 1024);
            for (int it = bid; it < 288; it += G) {
                const int s = it / 18, cc = it % 18;
                if (tid < 192) { const int cond = tid >> 6, k = s * 64 + (tid & 63); const float v = cond < 2 ? INP(I_C)[cond * D + k] : INP(I_CCTX)[k]; scv[tid] = v / (1.0f + expf(-v)); }
                __syncthreads();
                const int cg4 = tid & 127, ks = tid >> 7;
                f32x4 acc[3] = {(f32x4){0.f, 0.f, 0.f, 0.f}, (f32x4){0.f, 0.f, 0.f, 0.f}, (f32x4){0.f, 0.f, 0.f, 0.f}};
                const float* wp = INP(I_ADAW) + (size_t)(s * 64 + ks * 16) * NMODS + cc * 512 + cg4 * 4;
#pragma unroll
                for (int kk = 0; kk < 16; ++kk) { const f32x4 w = __builtin_nontemporal_load((const f32x4*)(wp + (size_t)kk * NMODS));
#pragma unroll
                    for (int cnd = 0; cnd < 3; ++cnd) acc[cnd] += w * scv[cnd * 64 + ks * 16 + kk]; }
#pragma unroll
                for (int cnd = 0; cnd < 3; ++cnd) red[(ks * 3 + cnd) * 128 + cg4] = acc[cnd];
                __syncthreads();
                if (tid < 384) { const int cnd = tid >> 7, g4 = tid & 127;
                    const f32x4 r = (red[(0 * 3 + cnd) * 128 + g4] + red[(1 * 3 + cnd) * 128 + g4]) + (red[(2 * 3 + cnd) * 128 + g4] + red[(3 * 3 + cnd) * 128 + g4]);
                    *(f32x4*)(part + (size_t)(s * 3 + cnd) * NMODS + cc * 512 + g4 * 4) = r; }
                __syncthreads();
            }
            LAS float* scr = (LAS float*)(lds + wave * 16384);
            convert_ffn(INP(I_F1W1), INP(I_F1W3), INP(I_F1W2), W13, W2, scr, gw, NGW, lane);
            constexpr int IIN = (D / 64) * (NIN / 32), IOUT = (D / 64) * (D / 32);
            for (int it = gw; it < IIN + IOUT; it += NGW) {
                if (it < IIN) transpose_item<2>(INP(I_WIN), D, NIN, WIN, 0, scr, it, lane);
                else transpose_item<0>(INP(I_WOUT), D, D, WOUT, 0, scr, it - IIN, lane);
            }
            for (int v = bid * NTHREADS + tid; v < (NINP - NIN) * D / 8; v += G * NTHREADS) *((u32x4*)(WIN + (size_t)NIN * D) + v) = (u32x4){0u, 0u, 0u, 0u};
        } else if (ph == 1 && (PHM & 2)) {
            for (int g4 = bid * NTHREADS + tid; g4 < 3 * NMODS / 4; g4 += G * NTHREADS) { const int gid = 4 * g4, cond = gid / NMODS, rem = gid % NMODS; f32x4 v = *(const f32x4*)(INP(I_ADAB) + rem);
#pragma unroll
                for (int s = 0; s < 16; ++s) v += *(const f32x4*)(part + (size_t)(s * 3 + cond) * NMODS + rem);
                *(f32x4*)(mods + gid) = v; }
            norm_phase<true, false>(lds, INP(I_X), INP(I_CTX), MROWS, INP(I_N1W), part, INP(I_ADAB), mods, 0, 1, H, nullptr, gw, NGW, tid, lane);
        } else if (ph == 2 && (PHM & 4)) {
            unsigned* cnt = (unsigned*)(ws + WS_CNT);
            { pg8::Gemm g{H, W13, MROWS, 2 * FF, D, D / 64}; CtxFirstOrder S; S.init(G, bid, cnt, (LAS unsigned*)(lds + LDS_BYTES - 64 + 16));
              EpiSwiglu E{GP};
              pg8::gemm_phase<EpiSwiglu, CtxFirstOrder, true, true>(lds, g, S, E); }
            if (bid >= G - 24) {
                if (tid == 0) { while (__hip_atomic_load(cnt, __ATOMIC_RELAXED, __HIP_MEMORY_SCOPE_AGENT) < 44u * 8u) __builtin_amdgcn_s_sleep(4); }
                __builtin_amdgcn_fence(__ATOMIC_ACQUIRE, "agent");
                asm volatile("s_waitcnt vmcnt(0)" ::: "memory");
                __syncthreads();
                const int qd = bid - (G - 24), part3 = qd % 3, tile = qd / 3, k0 = part3 == 0 ? 0 : (part3 == 1 ? 16 * 64 : 30 * 64);
                pg8::Gemm g{GP + (size_t)NLAT * FF + k0, W2 + k0, NCTX, D, FF, part3 == 0 ? 16 : 14}; OneUnit S{tile >> 2, tile & 3};
                EpiCtxAtomic E{(float*)(ws + WS_SR) + (size_t)part3 * NCTX * D, mods};
                pg8::gemm_phase<EpiCtxAtomic, OneUnit, true, true>(lds, g, S, E);
            }
        } else if (ph == 11 && (PHM & 4)) {
            pg8::Gemm g{H, W13, NLAT, 2 * FF, D, D / 64}; pg8::StaticOrder S; S.init(NLAT, 2 * FF, G, bid);
            EpiSwiglu E{GP};
            pg8::gemm_phase<EpiSwiglu, pg8::StaticOrder, true, true>(lds, g, S, E);
        } else if (ph == 12 && (PHM & 8)) {
            pg8::Gemm g{GP, W2, NLAT, D, FF, FF / 64}; pg8::StaticOrder S; S.init(NLAT, D, G, bid);
            EpiResidNorm<0> E{};
            pg8::gemm_phase<EpiResidNorm<0>, pg8::StaticOrder, false, true>(lds, g, S, E);
        } else if (ph == 3 && (PHM & 8)) {
            norm_phase<false, false>(lds, out, INP(I_CTX), MROWS, INP(I_N2W), part, INP(I_ADAB), mods, 3, 4, H, nullptr, gw, NGW, tid, lane, NLAT, (const float*)(ws + WS_SR));
            __syncthreads();
            pg8::Gemm g{GP, W2, NLAT, D, FF, FF / 64}; pg8::StaticOrder S; S.init(NLAT, D, G, bid);
            EpiResidNorm<1> E{};
            pg8::gemm_phase<EpiResidNorm<1>, pg8::StaticOrder, false, true>(lds, g, S, E);
        } else if (ph == 9 && (PHM & 8)) {
            pg8::Gemm g{H, WOUT, NLAT, D, D, D / 64}; pg8::StaticOrder S; S.init(NLAT, D, G, bid);
            EpiResidNorm<2> E{};
            pg8::gemm_phase<EpiResidNorm<2>, pg8::StaticOrder, false, true>(lds, g, S, E);
        } else if (ph == 4 && (PHM & 16)) {
            norm_phase<false, false>(lds, out, X1C, MROWS, INP(I_N2W), part, INP(I_ADAB), mods, 3, 4, H, nullptr, gw, NGW, tid, lane);
        } else if (ph == 5 && (PHM & 32)) {
            pg8::Gemm g{H, WIN, MROWS, NINP, D, D / 64}; pg8::StaticOrder S; S.init(MROWS, NINP, G, bid);
            EpiWin E{GP, LR};
            pg8::gemm_phase<EpiWin, pg8::StaticOrder, true, true>(lds, g, S, E);
        } else if (ph == 6 && (PHM & 64)) {
            if (tid < 8) ((LAS float*)(lds + LDS_BYTES - 128))[tid] = -log1pf(expf(-(tid < 4 ? INP(I_RDF)[tid] : INP(I_RDB)[tid - 4])));
            __syncthreads();
            unsigned* qctr = (unsigned*)(ws + WS_CNT + 768);
            volatile LAS int* nx = (volatile LAS int*)(lds + LDS_BYTES - 64 + 32);
            int it = bid, k = 0;
            while (it < 1056) {
                if (tid == 0) nx[k & 1] = G + (int)__hip_atomic_fetch_add(qctr, 1u, __ATOMIC_RELAXED, __HIP_MEMORY_SCOPE_AGENT);
                if (it < 528) { if (!(P6SKIP & 2)) p6_gla_item(lds, GP, LR, SG, DG, INP(I_GWF), INP(I_GBF), INP(I_GWB), INP(I_GBB), it, tid, wave, lane); }
                else if (!(P6SKIP & 1)) p6_ret_item(lds, GP, SR, INP(I_RDF), INP(I_RDB), it - 528, tid, wave, lane);
                it = nx[k & 1]; ++k;
            }
        } else if (ph == 7 && (PHM & 128)) {
            p7_scan(SR, SG, DG, INP(I_RDF), INP(I_RDB), bid * NTHREADS + tid, G * NTHREADS);
            { LAS float* scr = (LAS float*)(lds + wave * 16384); convert_ffn(INP(I_F2W1), INP(I_F2W3), INP(I_F2W2), W13, W2, scr, gw, NGW, lane); }
        } else if (ph == 8 && (PHM & 256)) {
            if (tid < 8) ((LAS float*)(lds + LDS_BYTES - 128))[tid] = -log1pf(expf(-(tid < 4 ? INP(I_RDF)[tid] : INP(I_RDB)[tid - 4])));
            __syncthreads();
            for (int idx = tid; idx < 1024; idx += NTHREADS) { const int hh = idx >> 8; const float dd = (float)((idx & 255) - 127);
                const float lf = ((const LAS float*)(lds + LDS_BYTES - 128))[hh], lb = ((const LAS float*)(lds + LDS_BYTES - 128))[4 + hh];
                ((LAS float*)(lds + DTAB_OFF))[idx] = __expf(fmaxf(dd, 0.f) * lf + fmaxf(-dd, 0.f) * lb) * (2.0f - fminf(fabsf(dd), 1.0f)); }
            __syncthreads();
            for (int it = bid; it < 1024; it += G) for (int rep = 0; rep < (PROBE == 14 ? 2 : 1); ++rep) {
                if (it < 512) p8_ret_item(lds, GP, SR, H, INP(I_RDF), INP(I_RDB), INP(I_RNW), it, tid, wave, lane);
                else p8_gla_item(lds, GP, LR, SG, H, INP(I_GWF), INP(I_GBF), INP(I_GWB), INP(I_GBB), INP(I_GNW), it - 512, tid, wave, lane);
            }
        } else if (ph == 10 && (PHM & 512)) {
            norm_phase<false, false>(lds, out, X1C, NLAT, INP(I_N3W), part, INP(I_ADAB), mods, 6, 7, H, nullptr, gw, NGW, tid, lane);
        } else if (ph == 13 && (PHM & 1024)) {
            norm_phase<false, true>(lds, out, X1C, NLAT, INP(I_FNW), part, INP(I_ADAB), mods, 0, 0, nullptr, probe_dst ? (float*)(ws + WS_SR) : out, gw, NGW, tid, lane);
        }
}

__global__ void __launch_bounds__(NTHREADS, 2) mk_fwd(Args a) {
    extern __shared__ __attribute__((aligned(16))) unsigned char lds_raw[];
    LAS unsigned char* lds = (LAS unsigned char*)lds_raw;
    cg::grid_group grid = cg::this_grid();
    const int G = gridDim.x, NGW = G * 8;
#ifndef PROBE
#define PROBE 0
#endif
#ifndef PROBE
#define PROBE 0
#endif
    if (gridDim.y == 4242u) grid.sync();
    unsigned* barw = (unsigned*)(a.ws + WS_BAR);
    volatile LAS unsigned* bst = (volatile LAS unsigned*)(lds + LDS_BYTES - 64);
    if (threadIdx.x < 8) bst[threadIdx.x] = 0u;
    __syncthreads();
    XcdBarrier bar = xcd_barrier_post(barw, bst);
#define SEAM() xcd_barrier_ool(bar.bar, bar.x, bar.st)
    run_phase<0>(lds, G, NGW); SEAM();
    run_phase<1>(lds, G, NGW); SEAM();
    run_phase<2>(lds, G, NGW); SEAM();
    run_phase<3>(lds, G, NGW); SEAM();
    run_phase<5>(lds, G, NGW); SEAM();
    run_phase<6>(lds, G, NGW); SEAM();
    run_phase<7>(lds, G, NGW); SEAM();
    run_phase<8>(lds, G, NGW); SEAM();
    run_phase<9>(lds, G, NGW); SEAM();
    run_phase<11>(lds, G, NGW); SEAM();
    run_phase<12>(lds, G, NGW);
}

extern "C" void kernel_launch(void* const* d_in, const int* in_sizes, int n_in, void* d_out, int out_size, void* d_ws, size_t ws_size, hipStream_t stream) {
    static int grid = 0;
    if (grid == 0) {
        if (n_in != 26 || ws_size < WS_END) { fprintf(stderr, "kernel_launch: unexpected n_in %d or ws_size %zu (< %zu)\n", n_in, ws_size, (size_t)WS_END); grid = -1; return; }
        int dev = 0, cus = 0, per_cu = 0;
        hipGetDevice(&dev);
        hipDeviceGetAttribute(&cus, hipDeviceAttributeMultiprocessorCount, dev);
        hipFuncSetAttribute((const void*)mk_fwd, hipFuncAttributeMaxDynamicSharedMemorySize, LDS_BYTES);
        hipOccupancyMaxActiveBlocksPerMultiprocessor(&per_cu, (const void*)mk_fwd, NTHREADS, LDS_BYTES);
        if (per_cu < 1) { fprintf(stderr, "kernel_launch: occupancy query reports %d blocks per CU\n", per_cu); per_cu = 1; }
        grid = cus;
        (void)hipGetLastError();
    }
    if (grid < 0) return;
    if (hipMemsetAsync((char*)d_ws + WS_BAR, 0, 128 * 1024, stream) != hipSuccess) { fprintf(stderr, "kernel_launch: memset of the barrier words failed\n"); return; }
    Args a{};
    for (int i = 0; i < 26; ++i) a.in[i] = (const float*)d_in[i];
    a.out = (float*)d_out; a.ws = (unsigned char*)d_ws;
    void* args[] = {&a};
    hipError_t e = hipLaunchCooperativeKernel((const void*)mk_fwd, dim3(grid), dim3(NTHREADS), args, LDS_BYTES, stream);
    if (e != hipSuccess) fprintf(stderr, "cooperative launch failed: %s (grid %d)\n", hipGetErrorString(e), grid);
}
```
